# Optimizing an MI355X kernel written in HIP

```python
import math
import jax, jax.numpy as jnp
from jax import lax
import numpy as np

D_MODEL = 1024
BATCH = 32
SEQ = 2048
DEPTH = 2

N_MEM = 256
EPS = 1e-6
NEG = -1e30
F_MIN = 1e-12
ATT_HEADS = 8
ATT_HEAD_DIM = 64
ATT_W = ATT_HEADS * ATT_HEAD_DIM
DILATED_PATTERNS = ((128, 1), (512, 4), (2048, 16))
BLK = 128
HG_HEADS = 4
HG_HEAD_DIM = 128
HG_W = HG_HEADS * HG_HEAD_DIM
HG_CHUNK = 32
MIX_W = ATT_W + HG_W
IN_W = 3 * ATT_W + 4 * HG_W
MEM_HEADS = 4
MEM_HEAD_DIM = D_MODEL // MEM_HEADS
D_FF = 4 * D_MODEL

kernel_name = "hybrid_dilated_attn_hgrn2_block"


def rms_norm(x, g):
    xf = x.astype(jnp.float32)
    y = xf * lax.rsqrt(jnp.mean(xf * xf, axis=-1, keepdims=True) + EPS)
    return (y * g.astype(jnp.float32)).astype(x.dtype)


def dilated_branch(q, k, v, window, dilation, slopes):
    B_, S_, H_, E_ = q.shape
    steps = window // dilation
    L = S_ // dilation
    nb = -(-L // BLK)
    Lp = nb * BLK

    def split(t):
        t = t.reshape(B_, L, dilation, H_, E_).transpose(0, 2, 3, 1, 4)
        t = jnp.pad(t, ((0, 0), (0, 0), (0, 0), (0, Lp - L), (0, 0)))
        return t.reshape(B_, dilation, H_, nb, BLK, E_)

    def with_prev(t):
        prev = jnp.pad(t, ((0, 0), (0, 0), (0, 0), (1, 0), (0, 0), (0, 0)))[:, :, :, :-1]
        return jnp.concatenate([prev, t], axis=-2)

    qb = split(q)
    kx = with_prev(split(k))
    vx = with_prev(split(v))
    s = jnp.einsum('bdhnqe,bdhnke->bdhnqk', qb, kx) * (1.0 / math.sqrt(E_))
    qi = jnp.arange(BLK)[:, None]
    kj = jnp.arange(2 * BLK)[None, :]
    step = qi + BLK - kj
    blk = jnp.arange(nb)[:, None, None]
    valid = (step >= 0) & (step <= steps) & (blk * BLK + kj - BLK >= 0)
    bias = -slopes[:, None, None, None] * (step * dilation).astype(jnp.float32)[None, None]
    s = jnp.where(valid, s + bias, NEG)
    lse = jax.nn.logsumexp(s, axis=-1)
    p = jnp.where(valid, jnp.exp(s - lse[..., None]), 0.0)
    o = jnp.einsum('bdhnqk,bdhnke->bdhnqe', p, vx)
    o = o.reshape(B_, dilation, H_, Lp, E_)[:, :, :, :L].transpose(0, 3, 1, 2, 4).reshape(B_, S_, H_, E_)
    lse = lse.reshape(B_, dilation, H_, Lp)[..., :L].transpose(0, 3, 1, 2).reshape(B_, S_, H_)
    return o, lse


def hgrn2_recurrence(q, f_logit, i, lb):
    B_, S_, H_, K_ = q.shape
    q = jax.nn.silu(q.astype(jnp.float32))
    i = i.astype(jnp.float32)
    fl = f_logit.astype(jnp.float32)
    f = lb + (1.0 - lb) * jax.nn.sigmoid(fl)
    log_f = jnp.log(jnp.maximum(f, F_MIN))
    k = (1.0 - lb) * jax.nn.sigmoid(-fl)
    n = S_ // HG_CHUNK

    def chunks(t):
        return t.reshape(B_, n, HG_CHUNK, H_, K_).transpose(1, 0, 3, 2, 4)

    qc, kc, vc, gc = chunks(q), chunks(k), chunks(i), chunks(log_f)
    bc = jnp.cumsum(gc, axis=-2)
    causal = jnp.tril(jnp.ones((HG_CHUNK, HG_CHUNK), dtype=bool))[:, :, None]

    def step(state, inp):
        qt, kt, vt, bt = inp
        diff = bt[..., :, None, :] - bt[..., None, :, :]
        decay = jnp.where(causal, jnp.exp(jnp.where(causal, diff, 0.0)), 0.0)
        scores = jnp.einsum('bhtk,bhsk,bhtsk->bhts', qt, kt, decay)
        o = jnp.einsum('bhts,bhsv->bhtv', scores, vt) + jnp.einsum('bhtk,bhkv->bhtv', qt * jnp.exp(bt), state)
        b_last = bt[..., -1:, :]
        state = jnp.exp(b_last[..., 0, :])[..., None] * state + jnp.einsum('bhsk,bhsv->bhkv', kt * jnp.exp(b_last - bt), vt)
        return state, o

    state0 = jnp.zeros((B_, H_, K_, K_), jnp.float32)
    _, o = lax.scan(step, state0, (qc, kc, vc, bc))
    return o.transpose(1, 0, 3, 2, 4).reshape(B_, S_, H_, K_)


def setup_inputs(seed: int = 0) -> dict:
    key = jax.random.key(seed)
    ks = jax.random.split(key, 20)
    f32 = jnp.float32

    def w(k, shape, fan_in):
        return jax.random.normal(k, shape, f32) * fan_in ** -0.5

    def gain(k, shape):
        return 1.0 + 0.02 * jax.random.normal(k, shape, f32)

    return {
        "x": jax.random.normal(ks[0], (BATCH, SEQ, D_MODEL), f32),
        "mem": jax.random.normal(ks[1], (BATCH, N_MEM, D_MODEL), f32),
        "norm1_g": gain(ks[2], (DEPTH, D_MODEL)),
        "w_in": w(ks[3], (DEPTH, D_MODEL, IN_W), D_MODEL),
        "attn_qn_g": gain(ks[4], (DEPTH, ATT_HEAD_DIM)),
        "attn_kn_g": gain(ks[5], (DEPTH, ATT_HEAD_DIM)),
        "hg_lb": 0.1 * jax.random.normal(ks[6], (DEPTH, HG_W), f32),
        "hg_onorm_g": gain(ks[7], (DEPTH, HG_W)),
        "w_out": w(ks[8], (DEPTH, MIX_W, D_MODEL), MIX_W),
        "norm2_g": gain(ks[9], (DEPTH, D_MODEL)),
        "mem_norm_g": gain(ks[10], (DEPTH, D_MODEL)),
        "w_mq": w(ks[11], (DEPTH, D_MODEL, D_MODEL), D_MODEL),
        "w_mkv": w(ks[12], (DEPTH, D_MODEL, 2 * D_MODEL), D_MODEL),
        "mq_norm_g": gain(ks[13], (DEPTH, MEM_HEAD_DIM)),
        "mk_norm_g": gain(ks[14], (DEPTH, MEM_HEAD_DIM)),
        "w_mo": w(ks[15], (DEPTH, D_MODEL, D_MODEL), D_MODEL),
        "norm3_g": gain(ks[16], (DEPTH, D_MODEL)),
        "w_ff1": w(ks[17], (DEPTH, D_MODEL, D_FF), D_MODEL),
        "w_ff2": w(ks[18], (DEPTH, D_FF, D_MODEL), D_FF),
    }


def reference(x, mem, norm1_g, w_in, attn_qn_g, attn_kn_g, hg_lb, hg_onorm_g, w_out,
              norm2_g, mem_norm_g, w_mq, w_mkv, mq_norm_g, mk_norm_g, w_mo,
              norm3_g, w_ff1, w_ff2):
    B_, S_, _ = x.shape
    f32 = jnp.float32
    slopes = jnp.exp2(-8.0 / ATT_HEADS * jnp.arange(1, ATT_HEADS + 1, dtype=f32))
    p_lb = jax.nn.softmax(hg_lb.astype(f32), axis=0)
    lower_bounds = jnp.cumsum(p_lb, axis=0) - p_lb[0:1]
    cuts = np.cumsum([ATT_W, ATT_W, ATT_W, HG_W, HG_W, HG_W]).tolist()

    for l in range(DEPTH):
        h = rms_norm(x, norm1_g[l])
        z = h @ w_in[l]
        qa, ka, va, qh, fh, ih, gh = jnp.split(z, cuts, axis=-1)
        qa = rms_norm(qa.reshape(B_, S_, ATT_HEADS, ATT_HEAD_DIM), attn_qn_g[l]).astype(f32)
        ka = rms_norm(ka.reshape(B_, S_, ATT_HEADS, ATT_HEAD_DIM), attn_kn_g[l]).astype(f32)
        va = va.reshape(B_, S_, ATT_HEADS, ATT_HEAD_DIM).astype(f32)
        outs, lses = [], []
        for window, dilation in DILATED_PATTERNS:
            o_b, lse_b = dilated_branch(qa, ka, va, window, dilation, slopes)
            outs.append(o_b)
            lses.append(lse_b)
        wts = jax.nn.softmax(jnp.stack(lses, axis=0), axis=0)
        ya = jnp.sum(wts[..., None] * jnp.stack(outs, axis=0), axis=0).reshape(B_, S_, ATT_W)

        hs = (B_, S_, HG_HEADS, HG_HEAD_DIM)
        oh = hgrn2_recurrence(qh.reshape(hs), fh.reshape(hs), ih.reshape(hs),
                              lower_bounds[l].reshape(HG_HEADS, HG_HEAD_DIM))
        oh = rms_norm(oh, hg_onorm_g[l].reshape(HG_HEADS, HG_HEAD_DIM)).reshape(B_, S_, HG_W)
        yh = oh * jax.nn.silu(gh.astype(f32))

        y = jnp.concatenate([ya, yh], axis=-1).astype(x.dtype) @ w_out[l]
        x = x + y

        h = rms_norm(x, norm2_g[l])
        mn = rms_norm(mem, mem_norm_g[l])
        qm = rms_norm((h @ w_mq[l]).reshape(B_, S_, MEM_HEADS, MEM_HEAD_DIM), mq_norm_g[l]).astype(f32)
        km, vm = jnp.split(mn @ w_mkv[l], 2, axis=-1)
        km = rms_norm(km.reshape(B_, -1, MEM_HEADS, MEM_HEAD_DIM), mk_norm_g[l]).astype(f32)
        vm = vm.reshape(B_, -1, MEM_HEADS, MEM_HEAD_DIM).astype(f32)
        sm = jnp.einsum('bshe,bmhe->bhsm', qm, km) * (1.0 / math.sqrt(MEM_HEAD_DIM))
        pm = jax.nn.softmax(sm, axis=-1)
        om = jnp.einsum('bhsm,bmhe->bshe', pm, vm).reshape(B_, S_, D_MODEL)
        x = x + om.astype(x.dtype) @ w_mo[l]

        h = rms_norm(x, norm3_g[l])
        u = jnp.square(jax.nn.relu(h @ w_ff1[l]))
        x = x + u @ w_ff2[l]
    return x
```

```cpp
#include <hip/hip_runtime.h>
#include <hip/hip_cooperative_groups.h>
#include <cstdio>
#include <cstdint>
namespace cg = cooperative_groups;
namespace pg8 {
#define PG8_LAS __attribute__((address_space(3)))
typedef unsigned short bf16_t;
typedef short bf16x8 __attribute__((ext_vector_type(8)));
typedef float f32x4 __attribute__((ext_vector_type(4)));
typedef unsigned u32x4 __attribute__((ext_vector_type(4)));
constexpr int BM = 256, BK = 64, HALF = 128, HTB = HALF * BK * 2  , STAGE_BYTES = 8 * HTB, NXCD = 8, WGM = 8;

__host__ __device__ __forceinline__ int lds_byte(int r, int c) { const int st = (r >> 4) * 2 + (c >> 5), rr = r & 15, cc = c & 31, ob = rr * 64 + cc * 2; return st * 1024 + (ob ^ (((ob >> 9) & 1) << 5)); }
__host__ __device__ __forceinline__ void stage_rc(int b, int& R, int& C) { const int st = b / 1024, sb = b % 1024, swz = sb ^ (((sb >> 9) & 1) << 5); R = (st >> 1) * 16 + swz / 64; C = (st & 1) * 32 + (swz % 64) / 2; }
__host__ __device__ __forceinline__ int perm32(int rho) { const int n = rho >> 4, i = rho & 15; return 8 * (i >> 2) + 4 * n + (i & 3); }

struct Unit { int pm, pn; };
struct Gemm { const bf16_t* A; const bf16_t* Bt; int M, N, K; };

struct StaticOrder {
    int nM, nN, nwg, G, c;
    __host__ __device__ void init(int M, int N, int G_, int c_) { nM = M / BM; nN = N / BM; nwg = nM * nN; G = G_; c = c_; }
    __host__ __device__ bool next(int i, Unit& u) const {
        const long L = (long)i * G + c; if (L >= nwg) return false;
        int wgid = (int)L; { const int q = nwg / NXCD, r = nwg % NXCD, xcd = wgid % NXCD, off = wgid / NXCD; wgid = (xcd < r ? xcd * (q + 1) : r * (q + 1) + (xcd - r) * q) + off; }
        const int nig = WGM * nN, gid = wgid / nig, fm = gid * WGM, gsz = (nM - fm) < WGM ? (nM - fm) : WGM;
        u.pm = fm + ((wgid % nig) % gsz); u.pn = (wgid % nig) / gsz; return true;
    }
    __device__ __forceinline__ void a_ready(const Unit&) const {}
    __device__ __forceinline__ void done(const Unit&) const {}
};

typedef float f32x2 __attribute__((ext_vector_type(2)));
typedef __bf16 bf16x2_t __attribute__((ext_vector_type(2)));
__device__ __forceinline__ unsigned cvt_pk_bf16(float lo, float hi) { f32x2 v = {lo, hi}; bf16x2_t b = __builtin_convertvector(v, bf16x2_t); return __builtin_bit_cast(unsigned, b); }
typedef unsigned u32x2 __attribute__((ext_vector_type(2)));
struct EpiDyn {
    static constexpr bool AFTER_DRAIN = false;
    int mode; bool perm;
    bf16_t* O; int ldc;
    const float* ssin; float* ssn; float* outf;
    __device__ __forceinline__ void operator()(const f32x4 (&acc)[2][2][4][2], const Unit& u, int wr, int wc, int fr, int fq) const {
        const int row0 = u.pm * BM + wr * 64 + fr; const int col0 = u.pn * BM + wc * 32 + 8 * fq;
        if (mode == 1) {
            const bool nx = ssn != nullptr, fin = outf != nullptr;
#pragma unroll
            for (int ai = 0; ai < 2; ++ai)
#pragma unroll
                for (int m = 0; m < 4; ++m) { const int row = row0 + ai * HALF + m * 16; bf16_t* rowp = O + (size_t)row * ldc + col0; float ssq = 0.f;
#pragma unroll
                    for (int bj = 0; bj < 2; ++bj) { const u32x4 bw = *(const u32x4*)(rowp + bj * HALF);
                        f32x4 v0 = acc[ai][bj][m][0], v1 = acc[ai][bj][m][1];
                        v0[0] += __builtin_bit_cast(float, bw.x << 16); v0[1] += __builtin_bit_cast(float, bw.x & 0xffff0000u); v0[2] += __builtin_bit_cast(float, bw.y << 16); v0[3] += __builtin_bit_cast(float, bw.y & 0xffff0000u);
                        v1[0] += __builtin_bit_cast(float, bw.z << 16); v1[1] += __builtin_bit_cast(float, bw.z & 0xffff0000u); v1[2] += __builtin_bit_cast(float, bw.w << 16); v1[3] += __builtin_bit_cast(float, bw.w & 0xffff0000u);
                        ssq += (v0[0] * v0[0] + v0[1] * v0[1]) + (v0[2] * v0[2] + v0[3] * v0[3]) + (v1[0] * v1[0] + v1[1] * v1[1]) + (v1[2] * v1[2] + v1[3] * v1[3]);
                        if (fin) { float* op = outf + (size_t)row * ldc + col0 + bj * HALF; *(f32x4*)op = v0; *(f32x4*)(op + 4) = v1; }
                        else { u32x4 w; w.x = cvt_pk_bf16(v0[0], v0[1]); w.y = cvt_pk_bf16(v0[2], v0[3]); w.z = cvt_pk_bf16(v1[0], v1[1]); w.w = cvt_pk_bf16(v1[2], v1[3]); *(u32x4*)(rowp + bj * HALF) = w; } }
                    if (nx) { ssq += __shfl_xor(ssq, 16); ssq += __shfl_xor(ssq, 32); if (fq == 0) (void)__hip_atomic_fetch_add(ssn + row, ssq, __ATOMIC_RELAXED, __HIP_MEMORY_SCOPE_AGENT); } }
        } else {
            const bool sq = (mode == 2), scl = ssin != nullptr;
#pragma unroll
            for (int ai = 0; ai < 2; ++ai)
#pragma unroll
                for (int m = 0; m < 4; ++m) { const int row = row0 + ai * HALF + m * 16; bf16_t* rowp = O + (size_t)row * ldc + col0;
                    const float sc = scl ? 1.0f / sqrtf(ssin[row] * (1.f / 1024.f) + 1e-6f) : 1.0f;
#pragma unroll
                    for (int bj = 0; bj < 2; ++bj) { f32x4 v0 = acc[ai][bj][m][0] * sc, v1 = acc[ai][bj][m][1] * sc;
                        if (sq) {
#pragma unroll
                            for (int e = 0; e < 4; ++e) { float a = v0[e] > 0.f ? v0[e] : 0.f; v0[e] = a * a; float b = v1[e] > 0.f ? v1[e] : 0.f; v1[e] = b * b; } }
                        u32x4 w; w.x = cvt_pk_bf16(v0[0], v0[1]); w.y = cvt_pk_bf16(v0[2], v0[3]); w.z = cvt_pk_bf16(v1[0], v1[1]); w.w = cvt_pk_bf16(v1[2], v1[3]);
                        *(u32x4*)(rowp + bj * HALF) = w; } }
        }
    }
};
template <class Epi, class Sched, bool ALIGN_EPI = false, bool SP2 = false>
__device__ __forceinline__ void gemm_phase(PG8_LAS unsigned char* lds, const Gemm g, const Sched& S, const Epi& E) {
    int tid_ = threadIdx.x; asm volatile("" : "+v"(tid_)); const int tid = tid_, wid = __builtin_amdgcn_readfirstlane(tid >> 6), lane = tid & 63, wr = wid >> 2, wc = wid & 3, fr = lane & 15, fq = lane >> 4;
    const int K = g.K, nt = K / BK;
    unsigned voffA[2], voffB[2];
#pragma unroll
    for (int i = 0; i < 2; ++i) { int R, C; stage_rc(tid * 16 + i * 8192, R, C); const int Rb = E.perm ? ((R & ~31) + perm32(R & 31)) : R;
        voffA[i] = (unsigned)(R * K + C) * 2u; voffB[i] = (unsigned)(Rb * K + C) * 2u; }
    const size_t kstep = (size_t)(BK * 2);
    const size_t hstep = (size_t)HALF * K * 2;
    const size_t tstep = 2 * hstep;
    const unsigned ldsw = (unsigned)wid * 1024u;
    const int aoff = lds_byte(wr * 64 + fr, fq * 8), boff = lds_byte(wc * 32 + fr, fq * 8);
#define PG8_SA(b, h) (((b) * 2 + (h)) * HTB)
#define PG8_SB(b, h) ((4 + (b) * 2 + (h)) * HTB)
#define PG8_STAGE(bufoff, gbase, voff) do { _Pragma("unroll") for (int _i = 0; _i < 2; ++_i) \
        __builtin_amdgcn_global_load_lds((const unsigned*)((const char*)(gbase) + (voff)[_i]), (PG8_LAS unsigned*)(lds + (bufoff) + ldsw + _i * 8192), 16, 0, 0); } while (0)
#define PG8_LDA(dst, b, h) do { _Pragma("unroll") for (int m = 0; m < 4; ++m) _Pragma("unroll") for (int k = 0; k < 2; ++k) dst[m][k] = *(const PG8_LAS bf16x8*)(lds + PG8_SA(b, h) + aoff + m * 2048 + k * 1024); } while (0)
#define PG8_LDB(dst, b, h) do { _Pragma("unroll") for (int n = 0; n < 2; ++n) _Pragma("unroll") for (int k = 0; k < 2; ++k) dst[n][k] = *(const PG8_LAS bf16x8*)(lds + PG8_SB(b, h) + boff + n * 2048 + k * 1024); } while (0)
#define PG8_MMA(ai, bj, At, Bt) do { __builtin_amdgcn_s_setprio(1); _Pragma("unroll") for (int m = 0; m < 4; ++m) _Pragma("unroll") for (int n = 0; n < 2; ++n) _Pragma("unroll") for (int k = 0; k < 2; ++k) \
        acc[ai][bj][m][n] = __builtin_amdgcn_mfma_f32_16x16x32_bf16(Bt[n][k], At[m][k], acc[ai][bj][m][n], 0, 0, 0); __builtin_amdgcn_s_setprio(0); } while (0)
#define PG8_WAIT_V(n) asm volatile("s_waitcnt vmcnt(" #n ")" ::: "memory")
#define PG8_WAIT_L(n) asm volatile("s_waitcnt lgkmcnt(" #n ")" ::: "memory")
#define PG8_BAR __builtin_amdgcn_s_barrier()
#define PG8_SCHED __builtin_amdgcn_sched_barrier(0)
    Unit cur, nxt; int ui = 0;
    if (!S.next(0, cur)) return;
    f32x4 acc[2][2][4][2];
#pragma unroll
    for (int a = 0; a < 2; ++a)
#pragma unroll
        for (int b = 0; b < 2; ++b)
#pragma unroll
            for (int m = 0; m < 4; ++m)
#pragma unroll
                for (int n = 0; n < 2; ++n) acc[a][b][m][n] = (f32x4){0.f, 0.f, 0.f, 0.f};
    bf16x8 At[4][2], B0[2][2], B1[2][2];
    const char* cA = (const char*)g.A + (size_t)cur.pm * tstep; const char* cB = (const char*)g.Bt + (size_t)cur.pn * tstep;
    S.a_ready(cur);
    if constexpr (SP2) {
        PG8_STAGE(PG8_SB(0, 0), cB, voffB); PG8_STAGE(PG8_SB(0, 1), cB + hstep, voffB); PG8_STAGE(PG8_SA(0, 0), cA, voffA); PG8_STAGE(PG8_SA(0, 1), cA + hstep, voffA);
        if (wr == 1) PG8_BAR;
        PG8_WAIT_V(2); PG8_BAR;
        PG8_STAGE(PG8_SB(1, 0), cB + kstep, voffB); PG8_STAGE(PG8_SA(1, 0), cA + kstep, voffA); PG8_STAGE(PG8_SB(1, 1), cB + hstep + kstep, voffB);
        PG8_WAIT_V(6); PG8_BAR;
    } else {
        PG8_STAGE(PG8_SB(0, 0), cB, voffB); PG8_STAGE(PG8_SA(0, 0), cA, voffA); PG8_STAGE(PG8_SB(0, 1), cB + hstep, voffB); PG8_STAGE(PG8_SA(0, 1), cA + hstep, voffA);
        if (wr == 1) PG8_BAR;
        PG8_WAIT_V(4); PG8_BAR;
        PG8_STAGE(PG8_SB(1, 0), cB + kstep, voffB); PG8_STAGE(PG8_SA(1, 0), cA + kstep, voffA); PG8_STAGE(PG8_SB(1, 1), cB + hstep + kstep, voffB);
        PG8_WAIT_V(6); PG8_BAR;
    }
    for (;;) {
        const bool has_next = S.next(ui + 1, nxt);
        const char* nA = has_next ? (const char*)g.A + (size_t)nxt.pm * tstep : cA; const char* nB = has_next ? (const char*)g.Bt + (size_t)nxt.pn * tstep : cB;
        for (int t = 0; t < nt; t += 2) {
            const bool last = (t == nt - 2);
            const char* a1 = cA + (size_t)(t + 1) * kstep;
            const char* a2 = last ? nA : cA + (size_t)(t + 2) * kstep; const char* b2 = last ? nB : cB + (size_t)(t + 2) * kstep;
            const char* a3 = a2 + kstep; const char* b3 = b2 + kstep;
            if (last && has_next) S.a_ready(nxt);
            if constexpr (SP2) {
            PG8_LDB(B0, 0, 0); PG8_LDB(B1, 0, 1); PG8_SCHED; PG8_LDA(At, 0, 0); PG8_STAGE(PG8_SA(1, 1), a1 + hstep, voffA);
            PG8_WAIT_V(8); PG8_WAIT_L(0); PG8_BAR; PG8_MMA(0, 0, At, B0); PG8_MMA(0, 1, At, B1); PG8_BAR; PG8_SCHED;
            PG8_LDA(At, 0, 1); PG8_STAGE(PG8_SB(0, 0), b2, voffB); PG8_STAGE(PG8_SB(0, 1), b2 + hstep, voffB); PG8_STAGE(PG8_SA(0, 0), a2, voffA);
            PG8_WAIT_V(8); PG8_WAIT_L(0); PG8_BAR; PG8_MMA(1, 0, At, B0); PG8_MMA(1, 1, At, B1); PG8_BAR; PG8_SCHED;
            PG8_LDB(B0, 1, 0); PG8_LDB(B1, 1, 1); PG8_SCHED; PG8_LDA(At, 1, 0); PG8_STAGE(PG8_SA(0, 1), a2 + hstep, voffA);
            PG8_WAIT_V(8); PG8_WAIT_L(0); PG8_BAR; PG8_MMA(0, 0, At, B0); PG8_MMA(0, 1, At, B1); PG8_BAR; PG8_SCHED;
            PG8_LDA(At, 1, 1); PG8_STAGE(PG8_SB(1, 0), b3, voffB); PG8_STAGE(PG8_SB(1, 1), b3 + hstep, voffB); PG8_STAGE(PG8_SA(1, 0), a3, voffA);
            PG8_WAIT_V(8); PG8_WAIT_L(0); PG8_BAR; PG8_MMA(1, 0, At, B0); PG8_MMA(1, 1, At, B1); PG8_BAR; PG8_SCHED;
            } else {
            PG8_LDB(B0, 0, 0); PG8_SCHED; PG8_LDA(At, 0, 0); PG8_STAGE(PG8_SA(1, 1), a1 + hstep, voffA);
            PG8_WAIT_L(8); PG8_BAR; PG8_WAIT_L(0); PG8_MMA(0, 0, At, B0); PG8_BAR; PG8_SCHED;
            PG8_LDB(B1, 0, 1); PG8_STAGE(PG8_SB(0, 0), b2, voffB);
            PG8_BAR; PG8_WAIT_L(0); PG8_MMA(0, 1, At, B1); PG8_BAR;
            PG8_LDA(At, 0, 1); PG8_STAGE(PG8_SA(0, 0), a2, voffA);
            PG8_BAR; PG8_WAIT_L(0); PG8_MMA(1, 0, At, B0); PG8_BAR; PG8_SCHED;
            PG8_STAGE(PG8_SB(0, 1), b2 + hstep, voffB);
            PG8_WAIT_V(6); PG8_BAR; PG8_MMA(1, 1, At, B1); PG8_BAR;
            PG8_LDB(B0, 1, 0); PG8_SCHED; PG8_LDA(At, 1, 0); PG8_STAGE(PG8_SA(0, 1), a2 + hstep, voffA);
            PG8_WAIT_L(8); PG8_BAR; PG8_WAIT_L(0); PG8_MMA(0, 0, At, B0); PG8_BAR; PG8_SCHED;
            PG8_LDB(B1, 1, 1); PG8_STAGE(PG8_SB(1, 0), b3, voffB);
            PG8_BAR; PG8_WAIT_L(0); PG8_MMA(0, 1, At, B1); PG8_BAR;
            PG8_LDA(At, 1, 1); PG8_STAGE(PG8_SA(1, 0), a3, voffA);
            PG8_BAR; PG8_WAIT_L(0); PG8_MMA(1, 0, At, B0); PG8_BAR; PG8_SCHED;
            PG8_STAGE(PG8_SB(1, 1), b3 + hstep, voffB);
            PG8_WAIT_V(6); PG8_BAR; PG8_MMA(1, 1, At, B1); PG8_BAR;
            }
        }
        if constexpr (ALIGN_EPI) { if (wr == 0) PG8_BAR; }
        if constexpr (!Epi::AFTER_DRAIN) { E(acc, cur, wr, wc, fr, fq); S.done(cur); }
        if (!has_next) break;
#pragma unroll
        for (int a = 0; a < 2; ++a)
#pragma unroll
            for (int b = 0; b < 2; ++b)
#pragma unroll
                for (int m = 0; m < 4; ++m)
#pragma unroll
                    for (int n = 0; n < 2; ++n) acc[a][b][m][n] = (f32x4){0.f, 0.f, 0.f, 0.f};
        cur = nxt; cA = nA; cB = nB; ++ui;
        if constexpr (ALIGN_EPI) { if (wr == 1) PG8_BAR; }
    }
    PG8_WAIT_V(0);
    if constexpr (!ALIGN_EPI) { if (wr == 0) PG8_BAR; }
    PG8_BAR;
    if constexpr (Epi::AFTER_DRAIN) { E.fused(acc, cur, wr, wc, fr, fq, lds, wid, lane); S.done(cur); }
#undef PG8_SA
#undef PG8_SB
#undef PG8_STAGE
#undef PG8_LDA
#undef PG8_LDB
#undef PG8_MMA
#undef PG8_WAIT_V
#undef PG8_WAIT_L
#undef PG8_BAR
#undef PG8_SCHED
}
}

#define LAS __attribute__((address_space(3)))
typedef unsigned short bf16_t;
typedef short bf16x8 __attribute__((ext_vector_type(8)));
typedef float f32x4 __attribute__((ext_vector_type(4)));
typedef unsigned u32x4 __attribute__((ext_vector_type(4)));
typedef unsigned u32x2 __attribute__((ext_vector_type(2)));

constexpr int T = 65536, DM = 1024, SEQ = 2048, NBATCH = 32, ZW = 3584, DFF = 4096, NMEMROWS = 8192;
constexpr float EPS = 1e-6f, LOG2E = 1.4426950408889634f, LN2 = 0.6931471805599453f;
constexpr size_t MiB = 1u << 20;
constexpr size_t WS_CTL = 0, CTL_BYTES = 2 * MiB;
constexpr size_t WS_SS = 256 * 1024;
constexpr int CW_BAR = 2048;
constexpr size_t WS_WB = 2 * MiB, WB_LAYER = 36 * MiB;
constexpr size_t WB_IN = 0, WB_OUT = 7 * MiB, WB_MQ = 9 * MiB, WB_MKV = 11 * MiB, WB_MO = 15 * MiB, WB_FF1 = 17 * MiB, WB_FF2 = 25 * MiB;
constexpr size_t WS_KM = 74 * MiB, KM_LAYER = 32 * MiB, VT_OFF = 16 * MiB;
constexpr size_t WS_YM = 138 * MiB, WS_ZU = 266 * MiB, WS_H = 778 * MiB;
constexpr size_t WS_MN = WS_YM, WS_KVT = WS_ZU + 448 * MiB;
constexpr size_t WS_QM = WS_ZU;
constexpr size_t WS_END = WS_H + 128 * MiB;
constexpr size_t OUT_OP = 0, OUT_LSE = 192 * MiB;
constexpr int LDS_BYTES = 147456;
constexpr int N_ATT_UNITS = NBATCH * 8 * 48;

#ifndef SKIP_HGRN
#define SKIP_HGRN 0
#endif
#ifndef SKIP_ATTN
#define SKIP_ATTN 0
#endif
#ifndef SKIP_XATTN
#define SKIP_XATTN 0
#endif
struct Params { const float* in[19]; float* out; unsigned char* ws; };

__device__ __forceinline__ unsigned f2bf(float f) { unsigned u = __builtin_bit_cast(unsigned, f); return (u + 0x7fffu + ((u >> 16) & 1u)) >> 16; }
__device__ __forceinline__ unsigned pk2(float lo, float hi) { return pg8::cvt_pk_bf16(lo, hi); }
__device__ __forceinline__ float bflo(unsigned w) { return __builtin_bit_cast(float, w << 16); }
__device__ __forceinline__ float bfhi(unsigned w) { return __builtin_bit_cast(float, w & 0xffff0000u); }
__device__ __forceinline__ void unpack8(const u32x4 w, float (&f)[8]) {
    f[0] = bflo(w.x); f[1] = bfhi(w.x); f[2] = bflo(w.y); f[3] = bfhi(w.y); f[4] = bflo(w.z); f[5] = bfhi(w.z); f[6] = bflo(w.w); f[7] = bfhi(w.w);
}
__device__ __forceinline__ u32x4 pack8(const float (&f)[8]) { u32x4 w; w.x = pk2(f[0], f[1]); w.y = pk2(f[2], f[3]); w.z = pk2(f[4], f[5]); w.w = pk2(f[6], f[7]); return w; }
__device__ __forceinline__ float wave_sum(float v) {
#pragma unroll
    for (int o = 1; o < 64; o <<= 1) v += __shfl_xor(v, o);
    return v;
}
#define DPPF(v, ctrl) __builtin_bit_cast(float, __builtin_amdgcn_mov_dpp(__builtin_bit_cast(int, (v)), (ctrl), 0xF, 0xF, true))
__device__ __forceinline__ float sum8_dpp(float v) { v += DPPF(v, 0xB1); v += DPPF(v, 0x4E); v += DPPF(v, 0x141); return v; }
__device__ __forceinline__ float sum16_dpp(float v) { v = sum8_dpp(v); v += DPPF(v, 0x128); return v; }
#define MFMA16(a, b, c) __builtin_amdgcn_mfma_f32_16x16x32_bf16((a), (b), (c), 0, 0, 0)
#define LDS_WAIT() asm volatile("s_waitcnt lgkmcnt(0)" ::: "memory")
#define LDS_BARRIER() do { asm volatile("s_waitcnt lgkmcnt(0)" ::: "memory"); __builtin_amdgcn_s_barrier(); asm volatile("" ::: "memory"); } while (0)

__device__ __forceinline__ void transpose_item(const float* W, int K, int N, bf16_t* WT, LAS float* scr, int item, int lane, const float* g = nullptr) {
    const int nblk = N / 32, kb = item / nblk, nb = item % nblk, k0 = 64 * kb, n0 = 32 * nb;
#pragma unroll 8
    for (int i = 0; i < 32; ++i) { const int kk = 2 * i + (lane >> 5); scr[kk * 33 + (lane & 31)] = W[(size_t)(k0 + kk) * N + n0 + (lane & 31)] * (g ? g[k0 + kk] : 1.0f); }
    LDS_WAIT();
    const int c = lane & 7;
#pragma unroll
    for (int j = 0; j < 4; ++j) { const int n = (lane >> 3) + 8 * j; const LAS float* s = scr + (8 * c) * 33 + n;
        u32x4 o; o.x = pk2(s[0 * 33], s[1 * 33]); o.y = pk2(s[2 * 33], s[3 * 33]); o.z = pk2(s[4 * 33], s[5 * 33]); o.w = pk2(s[6 * 33], s[7 * 33]);
        *(u32x4*)(WT + (size_t)(n0 + n) * K + k0 + 8 * c) = o; }
    LDS_WAIT();
}
__device__ __forceinline__ void rms_row_1024(const float* xrow, const float* g, bf16_t* orow, int lane) {
    const f32x4* xr = (const f32x4*)xrow + lane; const f32x4* gr = (const f32x4*)g + lane;
    f32x4 v[4]; float s = 0.f;
#pragma unroll
    for (int j = 0; j < 4; ++j) { v[j] = xr[64 * j]; s += (v[j].x * v[j].x + v[j].y * v[j].y) + (v[j].z * v[j].z + v[j].w * v[j].w); }
    const float rstd = 1.0f / sqrtf(wave_sum(s) * (1.f / 1024.f) + EPS);
    u32x2* o8 = (u32x2*)orow + lane;
#pragma unroll
    for (int j = 0; j < 4; ++j) { const f32x4 gv = gr[64 * j]; u32x2 w; w.x = pk2(v[j].x * rstd * gv.x, v[j].y * rstd * gv.y); w.y = pk2(v[j].z * rstd * gv.z, v[j].w * rstd * gv.w); o8[64 * j] = w; }
}

__device__ __forceinline__ void prep_row_1024(const float* xrow, bf16_t* orow, float* ssp, int lane) {
    const f32x4* xr = (const f32x4*)xrow + lane;
    float s = 0.f; u32x2* o8 = (u32x2*)orow + lane;
#pragma unroll
    for (int j = 0; j < 4; ++j) { const f32x4 v = xr[64 * j]; s += (v.x * v.x + v.y * v.y) + (v.z * v.z + v.w * v.w);
        u32x2 w; w.x = pk2(v.x, v.y); w.y = pk2(v.z, v.w); o8[64 * j] = w; }
    s = wave_sum(s);
    if (lane == 0) *ssp = s;
}

struct AttnU { int b, h, p, d, r, n; };
__device__ __forceinline__ AttnU attn_decode(int u) {
    AttnU U; const int bh = u / 48, s48 = u % 48, idx = s48 & 15; U.b = bh >> 3; U.h = bh & 7; U.p = s48 >> 4;
    if (U.p == 0) { U.d = 1; U.r = 0; U.n = idx; } else if (U.p == 1) { U.d = 4; U.r = idx & 3; U.n = idx >> 2; } else { U.d = 16; U.r = idx; U.n = 0; }
    return U;
}
struct AttnRegs { u32x4 kw[4], vw[4], q0, q1; };
__device__ __forceinline__ void attn_load(AttnRegs& R, const bf16_t* Z, const AttnU& U, int tid) {
    const int wave = tid >> 6, lane = tid & 63, fr = lane & 15, fq = lane >> 4;
    const size_t rowbase = (size_t)U.b * SEQ;
#pragma unroll
    for (int it = 0; it < 4; ++it) {
        const int c = tid + 512 * it, row = c >> 3, ch = c & 7, lk = 128 * (U.n - 1) + row;
        R.kw[it] = (u32x4){0u, 0u, 0u, 0u}; R.vw[it] = (u32x4){0u, 0u, 0u, 0u};
        if (lk >= 0) { const bf16_t* zr = Z + (rowbase + (size_t)(lk * U.d + U.r)) * ZW + U.h * 64 + ch * 8; R.kw[it] = *(const u32x4*)(zr + 512); R.vw[it] = *(const u32x4*)(zr + 1024); }
    }
    const int qi = 16 * wave + fr, posq = (128 * U.n + qi) * U.d + U.r;
    const bf16_t* zq = Z + (rowbase + (size_t)posq) * ZW + U.h * 64;
    R.q0 = *(const u32x4*)(zq + fq * 8); R.q1 = *(const u32x4*)(zq + 32 + fq * 8);
}
__device__ __forceinline__ void attn_stage(LAS unsigned char* lds, const AttnRegs& R, const float* gq, const float* gk, int tid, bf16x8& Q0, bf16x8& Q1) {
    const int lane = tid & 63, fq = lane >> 4;
    LAS bf16_t* Ks = (LAS bf16_t*)lds; LAS bf16_t* Vt = (LAS bf16_t*)(lds + 36864);
#pragma unroll
    for (int it = 0; it < 4; ++it) {
        const int c = tid + 512 * it, row = c >> 3, ch = c & 7;
        const u32x4 vw = R.vw[it];
        float kf[8]; unpack8(R.kw[it], kf);
        float ss = 0.f;
#pragma unroll
        for (int e = 0; e < 8; ++e) ss += kf[e] * kf[e];
        ss = sum8_dpp(ss);
        const float rstd = __builtin_amdgcn_rsqf(ss * (1.f / 64.f) + EPS);
        const f32x4 g0 = *(const f32x4*)(gk + ch * 8), g1 = *(const f32x4*)(gk + ch * 8 + 4);
        kf[0] *= rstd * g0.x; kf[1] *= rstd * g0.y; kf[2] *= rstd * g0.z; kf[3] *= rstd * g0.w; kf[4] *= rstd * g1.x; kf[5] *= rstd * g1.y; kf[6] *= rstd * g1.z; kf[7] *= rstd * g1.w;
        *(LAS u32x4*)(Ks + row * 72 + ch * 8) = pack8(kf);
        LAS bf16_t* vt = Vt + (ch * 8) * 264 + 8 * ch + row;
        vt[0 * 264] = (bf16_t)(vw.x & 0xffffu); vt[1 * 264] = (bf16_t)(vw.x >> 16); vt[2 * 264] = (bf16_t)(vw.y & 0xffffu); vt[3 * 264] = (bf16_t)(vw.y >> 16);
        vt[4 * 264] = (bf16_t)(vw.z & 0xffffu); vt[5 * 264] = (bf16_t)(vw.z >> 16); vt[6 * 264] = (bf16_t)(vw.w & 0xffffu); vt[7 * 264] = (bf16_t)(vw.w >> 16);
    }
    float a[8], c[8]; unpack8(R.q0, a); unpack8(R.q1, c);
    float ss = 0.f;
#pragma unroll
    for (int e = 0; e < 8; ++e) ss += a[e] * a[e] + c[e] * c[e];
    ss += __shfl_xor(ss, 16); ss += __shfl_xor(ss, 32);
    const float sc = __builtin_amdgcn_rsqf(ss * (1.f / 64.f) + EPS) * (0.125f * LOG2E);
#pragma unroll
    for (int e = 0; e < 8; ++e) { a[e] *= sc * gq[fq * 8 + e]; c[e] *= sc * gq[32 + fq * 8 + e]; }
    Q0 = __builtin_bit_cast(bf16x8, pack8(a)); Q1 = __builtin_bit_cast(bf16x8, pack8(c));
}
__device__ __forceinline__ void attn_compute(LAS unsigned char* lds, const AttnU& U, const bf16x8 Q0, const bf16x8 Q1, bf16_t* OP, float* LSE, int tid) {
    const int wave = __builtin_amdgcn_readfirstlane(tid >> 6), lane = tid & 63, fr = lane & 15, fq = lane >> 4;
    const int b = U.b, h = U.h, p = U.p, d = U.d, r = U.r, n = U.n;
    LAS bf16_t* Ks = (LAS bf16_t*)lds;
    LAS bf16_t* Vt = (LAS bf16_t*)(lds + 36864);
    LAS bf16_t* Ps = (LAS bf16_t*)(lds + 70784) + wave * (16 * 168);
    const size_t rowbase = (size_t)b * SEQ;
    const int qi = 16 * wave + fr, posq = (128 * n + qi) * d + r;
    const int start = wave < 6 ? 16 * wave : 96, i0 = 16 * wave;
    const float slope2 = exp2f(-(float)(h + 1)) * (float)d * LOG2E;
    const float fbase = (float)(qi + 128 - start - 4 * fq);
    f32x4 S[10]; bool dead[10];
    float m = -1e30f;
#pragma unroll
    for (int t = 0; t < 10; ++t) {
        const int k0 = start + 16 * t;
        dead[t] = (k0 > i0 + 143) || (k0 + 15 < i0) || (n == 0 && k0 + 15 < 128);
        const bool full = (k0 >= i0 + 15) && (k0 + 15 <= i0 + 128) && (n > 0 || k0 >= 128);
        if (dead[t]) { S[t] = (f32x4){-1e30f, -1e30f, -1e30f, -1e30f}; }
        else {
            const LAS bf16_t* kp = Ks + (k0 + fr) * 72 + fq * 8;
            const bf16x8 a0 = *(const LAS bf16x8*)kp, a1 = *(const LAS bf16x8*)(kp + 32);
            f32x4 acc = (f32x4){0.f, 0.f, 0.f, 0.f};
            acc = MFMA16(a0, Q0, acc); acc = MFMA16(a1, Q1, acc);
            if (full) {
#pragma unroll
                for (int j = 0; j < 4; ++j) { const float v = acc[j] - slope2 * (fbase - (float)(16 * t + j)); acc[j] = v; m = fmaxf(m, v); }
            } else {
#pragma unroll
                for (int j = 0; j < 4; ++j) {
                    const int kj = k0 + 4 * fq + j, step = qi + 128 - kj, lk = 128 * (n - 1) + kj;
                    const bool valid = (step >= 0) && (step <= 128) && (lk >= 0);
                    const float v = valid ? acc[j] - slope2 * (float)step : -1e30f;
                    acc[j] = v; m = fmaxf(m, v);
                }
            }
            S[t] = acc;
        }
    }
    m = fmaxf(m, __shfl_xor(m, 16)); m = fmaxf(m, __shfl_xor(m, 32));
    float sum = 0.f;
#pragma unroll
    for (int t = 0; t < 10; ++t) {
        u32x2 w = (u32x2){0u, 0u};
        if (!dead[t]) {
            float pe[4];
#pragma unroll
            for (int j = 0; j < 4; ++j) { pe[j] = __builtin_amdgcn_exp2f(S[t][j] - m); sum += pe[j]; }
            w.x = pk2(pe[0], pe[1]); w.y = pk2(pe[2], pe[3]);
        }
        *(LAS u32x2*)(Ps + fr * 168 + 16 * t + 4 * fq) = w;
    }
    sum += __shfl_xor(sum, 16); sum += __shfl_xor(sum, 32);
    LDS_WAIT();
    f32x4 O[4];
#pragma unroll
    for (int dt = 0; dt < 4; ++dt) O[dt] = (f32x4){0.f, 0.f, 0.f, 0.f};
#pragma unroll
    for (int kc = 0; kc < 5; ++kc) {
        if (dead[2 * kc] && dead[2 * kc + 1]) continue;
        const bf16x8 pb = *(const LAS bf16x8*)(Ps + fr * 168 + 32 * kc + fq * 8);
#pragma unroll
        for (int dt = 0; dt < 4; ++dt) { const bf16x8 va = *(const LAS bf16x8*)(Vt + fr * 264 + 8 * (fr >> 3) + start + fq * 8 + dt * (16 * 264 + 16) + 32 * kc); O[dt] = MFMA16(va, pb, O[dt]); }
    }
    const float inv = __builtin_amdgcn_rcpf(sum);
    const size_t trow = rowbase + (size_t)posq;
    bf16_t* op = OP + ((size_t)p * T + trow) * 512 + h * 64 + 4 * fq;
#pragma unroll
    for (int dt = 0; dt < 4; ++dt) { u32x2 w; w.x = pk2(O[dt][0] * inv, O[dt][1] * inv); w.y = pk2(O[dt][2] * inv, O[dt][3] * inv); *(u32x2*)(op + 16 * dt) = w; }
    if (fq == 0) LSE[((size_t)p * T + trow) * 8 + h] = (m + __builtin_amdgcn_logf(sum)) * LN2;
}
constexpr int ATT_TK = 4;
__device__ __forceinline__ void attn_loop(LAS unsigned char* lds, const bf16_t* Z, bf16_t* OP, float* LSE, const float* gq, const float* gk, unsigned* ctr, int tid) {
    LAS int* sh = (LAS int*)(lds + LDS_BYTES - 64);
    __syncthreads();
    if (tid == 0) { const int a0 = (int)__hip_atomic_fetch_add(ctr, 1u, __ATOMIC_RELAXED, __HIP_MEMORY_SCOPE_AGENT), a1 = (int)__hip_atomic_fetch_add(ctr, 1u, __ATOMIC_RELAXED, __HIP_MEMORY_SCOPE_AGENT); sh[0] = a0; sh[1] = a1; }
    __syncthreads();
    int u_cur = ATT_TK * __builtin_amdgcn_readfirstlane(sh[0]), tk_nxt = __builtin_amdgcn_readfirstlane(sh[1]), tk_nn = 0;
    __syncthreads();
    AttnRegs R;
    if (u_cur < N_ATT_UNITS) { const AttnU U = attn_decode(u_cur); attn_load(R, Z, U, tid); }
    while (u_cur < N_ATT_UNITS) {
        const bool first = (u_cur % ATT_TK) == 0, last = (u_cur % ATT_TK) == ATT_TK - 1;
        const int u_nxt = last ? ATT_TK * tk_nxt : u_cur + 1;
        const AttnU U = attn_decode(u_cur);
        bf16x8 Q0, Q1;
        attn_stage(lds, R, gq, gk, tid, Q0, Q1);
        int nn = 0;
        if (first && tid == 0) nn = (int)__hip_atomic_fetch_add(ctr, 1u, __ATOMIC_RELAXED, __HIP_MEMORY_SCOPE_AGENT);
        if (u_nxt < N_ATT_UNITS) { const AttnU Un = attn_decode(u_nxt); attn_load(R, Z, Un, tid); }
        LDS_BARRIER();
        attn_compute(lds, U, Q0, Q1, OP, LSE, tid);
        if (first && tid == 0) sh[0] = nn;
        LDS_BARRIER();
        if (first) tk_nn = __builtin_amdgcn_readfirstlane(sh[0]);
        if (last) tk_nxt = tk_nn;
        u_cur = u_nxt;
    }
}

__device__ __forceinline__ void hgrn_unit(LAS unsigned char* lds, const bf16_t* Z, bf16_t* YM, const float* hg_lb, const float* gon, int layer, int u, int tid) {
    const int wave = __builtin_amdgcn_readfirstlane(tid >> 6), lane = tid & 63, fr = lane & 15, fq = lane >> 4;
    const int b = u >> 2, hh = u & 3, tt = tid >> 4, kg = (tid & 15) * 8;
    LAS float*  LG  = (LAS float*)lds;
    LAS bf16_t* QdS = (LAS bf16_t*)(lds + 16384);
    LAS bf16_t* KdS = (LAS bf16_t*)(lds + 25088);
    LAS bf16_t* QeS = (LAS bf16_t*)(lds + 33792);
    LAS bf16_t* KlT = (LAS bf16_t*)(lds + 42496);
    LAS bf16_t* iT  = (LAS bf16_t*)(lds + 52736);
    LAS bf16_t* ScS = (LAS bf16_t*)(lds + 62976);
    LAS bf16_t* StS = (LAS bf16_t*)(lds + 65536);
    LAS float*  DEC = (LAS float*)(lds + 100352);
    LAS float*  OS  = (LAS float*)(lds + 100864);
    LAS float*  LBS = (LAS float*)(lds + 117760);
    LAS float*  GOS = (LAS float*)(lds + 118272);
    if (tid < 128) { const int c = hh * 128 + tid; LBS[tid] = layer == 0 ? 0.f : 1.0f / (1.0f + __expf(hg_lb[c] - hg_lb[512 + c])); GOS[tid] = gon[c]; }
    for (int i = tid; i < 34816 / 4; i += 512) ((LAS unsigned*)(lds + 65536))[i] = 0u;
    f32x4 St[8];
#pragma unroll
    for (int kt = 0; kt < 8; ++kt) St[kt] = (f32x4){0.f, 0.f, 0.f, 0.f};
    __syncthreads();
    const bf16_t* zb = Z + ((size_t)b * SEQ) * ZW + hh * 128 + kg;
    u32x4 nq, nf, ni, ng;
    { const bf16_t* zr = zb + (size_t)tt * ZW; nq = *(const u32x4*)(zr + 1536); nf = *(const u32x4*)(zr + 2048); ni = *(const u32x4*)(zr + 2560); ng = *(const u32x4*)(zr + 3072); }
    for (int c = 0; c < 64; ++c) {
        const u32x4 cq = nq, cf = nf, ci = ni, cgt = ng;
        if (c + 1 < 64) { const bf16_t* zr = zb + (size_t)((c + 1) * 32 + tt) * ZW; nq = *(const u32x4*)(zr + 1536); nf = *(const u32x4*)(zr + 2048); ni = *(const u32x4*)(zr + 2560); ng = *(const u32x4*)(zr + 3072); }
        float qs[8], kk[8], bc[8];
        { float qv[8], fv[8]; unpack8(cq, qv); unpack8(cf, fv);
          const f32x4 lb0 = *(const LAS f32x4*)(LBS + kg), lb1 = *(const LAS f32x4*)(LBS + kg + 4);
          const float lbv[8] = {lb0.x, lb0.y, lb0.z, lb0.w, lb1.x, lb1.y, lb1.z, lb1.w};
#pragma unroll
          for (int e = 0; e < 8; ++e) {
              qs[e] = qv[e] * __builtin_amdgcn_rcpf(1.0f + __expf(-qv[e]));
              const float ef = __expf(-fv[e]), sg = __builtin_amdgcn_rcpf(1.0f + ef);
              const float f = lbv[e] + (1.0f - lbv[e]) * sg;
              float v = __logf(fmaxf(f, 1e-12f));
              kk[e] = (1.0f - lbv[e]) * ef * sg;
              const float x1 = __shfl_up(v, 16); if (fq >= 1) v += x1;
              const float x2 = __shfl_up(v, 32); if (fq >= 2) v += x2;
              bc[e] = v;
          } }
        if (fq == 3) { *(LAS f32x4*)(LG + wave * 128 + kg) = (f32x4){bc[0], bc[1], bc[2], bc[3]}; *(LAS f32x4*)(LG + wave * 128 + kg + 4) = (f32x4){bc[4], bc[5], bc[6], bc[7]}; }
        LDS_BARRIER();
        float bl[8], br[8];
#pragma unroll
        for (int e = 0; e < 8; ++e) { bl[e] = 0.f; br[e] = 0.f; }
#pragma unroll 1
        for (int w2 = 0; w2 < 8; ++w2) {
            const f32x4 v0 = *(const LAS f32x4*)(LG + w2 * 128 + kg), v1 = *(const LAS f32x4*)(LG + w2 * 128 + kg + 4);
            const float vv[8] = {v0.x, v0.y, v0.z, v0.w, v1.x, v1.y, v1.z, v1.w};
            const float inc = w2 < wave ? 1.f : 0.f;
#pragma unroll
            for (int e = 0; e < 8; ++e) { bl[e] += vv[e]; bc[e] += inc * vv[e]; }
            if (w2 == 3) {
#pragma unroll
                for (int e = 0; e < 8; ++e) br[e] = bl[e];
            }
        }
        {
            float qd[8], kd[8], qe[8], kl[8];
#pragma unroll
            for (int e = 0; e < 8; ++e) { qd[e] = qs[e] * __expf(bc[e] - br[e]); kd[e] = kk[e] * __expf(br[e] - bc[e]); qe[e] = qs[e] * __expf(bc[e]); kl[e] = kk[e] * __expf(bl[e] - bc[e]); }
            *(LAS u32x4*)(QdS + tt * 136 + kg) = pack8(qd);
            *(LAS u32x4*)(KdS + tt * 136 + kg) = pack8(kd);
            *(LAS u32x4*)(QeS + tt * 136 + kg) = pack8(qe);
            const u32x4 klw = pack8(kl);
            const int tsw = (((tt >> 3) ^ ((kg >> 3) & 3)) << 3) | (tt & 7);
            LAS bf16_t* kp = KlT + kg * 40 + tsw; LAS bf16_t* ip = iT + kg * 40 + tsw;
            kp[0 * 40] = (bf16_t)(klw.x & 0xffffu); kp[1 * 40] = (bf16_t)(klw.x >> 16); kp[2 * 40] = (bf16_t)(klw.y & 0xffffu); kp[3 * 40] = (bf16_t)(klw.y >> 16);
            kp[4 * 40] = (bf16_t)(klw.z & 0xffffu); kp[5 * 40] = (bf16_t)(klw.z >> 16); kp[6 * 40] = (bf16_t)(klw.w & 0xffffu); kp[7 * 40] = (bf16_t)(klw.w >> 16);
            ip[0 * 40] = (bf16_t)(ci.x & 0xffffu); ip[1 * 40] = (bf16_t)(ci.x >> 16); ip[2 * 40] = (bf16_t)(ci.y & 0xffffu); ip[3 * 40] = (bf16_t)(ci.y >> 16);
            ip[4 * 40] = (bf16_t)(ci.z & 0xffffu); ip[5 * 40] = (bf16_t)(ci.z >> 16); ip[6 * 40] = (bf16_t)(ci.w & 0xffffu); ip[7 * 40] = (bf16_t)(ci.w >> 16);
            if (tt == 0) { *(LAS f32x4*)(DEC + kg) = (f32x4){__expf(bl[0]), __expf(bl[1]), __expf(bl[2]), __expf(bl[3])}; *(LAS f32x4*)(DEC + kg + 4) = (f32x4){__expf(bl[4]), __expf(bl[5]), __expf(bl[6]), __expf(bl[7])}; }
        }
        LDS_BARRIER();
        if (wave < 4) {
            const int tr = wave >> 1, sc = wave & 1;
            f32x4 acc = (f32x4){0.f, 0.f, 0.f, 0.f};
#pragma unroll
            for (int ks = 0; ks < 4; ++ks) { const bf16x8 a = *(const LAS bf16x8*)(QdS + (16 * tr + fr) * 136 + 32 * ks + fq * 8), bb = *(const LAS bf16x8*)(KdS + (16 * sc + fr) * 136 + 32 * ks + fq * 8); acc = MFMA16(a, bb, acc); }
#pragma unroll
            for (int j = 0; j < 4; ++j) { const int t = 16 * tr + 4 * fq + j, s = 16 * sc + fr; ScS[t * 40 + s] = (bf16_t)f2bf(s <= t ? acc[j] : 0.f); }
        }
        f32x4 o0 = (f32x4){0.f, 0.f, 0.f, 0.f}, o1 = (f32x4){0.f, 0.f, 0.f, 0.f};
#pragma unroll
        for (int ks = 0; ks < 4; ++ks) {
            const bf16x8 bb = *(const LAS bf16x8*)(StS + (16 * wave + fr) * 136 + 32 * ks + fq * 8);
            const bf16x8 a0 = *(const LAS bf16x8*)(QeS + fr * 136 + 32 * ks + fq * 8), a1 = *(const LAS bf16x8*)(QeS + (16 + fr) * 136 + 32 * ks + fq * 8);
            o0 = MFMA16(a0, bb, o0); o1 = MFMA16(a1, bb, o1);
        }
        LDS_BARRIER();
        {
            const bf16x8 bb = *(const LAS bf16x8*)(iT + (16 * wave + fr) * 40 + ((fq ^ (((16 * wave + fr) >> 3) & 3)) << 3));
            const bf16x8 a0 = *(const LAS bf16x8*)(ScS + fr * 40 + fq * 8), a1 = *(const LAS bf16x8*)(ScS + (16 + fr) * 40 + fq * 8);
            o0 = MFMA16(a0, bb, o0); o1 = MFMA16(a1, bb, o1);
#pragma unroll
            for (int j = 0; j < 4; ++j) { OS[(4 * fq + j) * 132 + 16 * wave + fr] = o0[j]; OS[(16 + 4 * fq + j) * 132 + 16 * wave + fr] = o1[j]; }
#pragma unroll
            for (int kt = 0; kt < 8; ++kt) {
                const bf16x8 a = *(const LAS bf16x8*)(KlT + (16 * kt + fr) * 40 + ((fq ^ (((16 * kt + fr) >> 3) & 3)) << 3));
                const f32x4 dec = *(const LAS f32x4*)(DEC + 16 * kt + 4 * fq);
                f32x4 sv = St[kt] * dec; sv = MFMA16(a, bb, sv); St[kt] = sv;
                u32x2 w; w.x = pk2(sv[0], sv[1]); w.y = pk2(sv[2], sv[3]);
                *(LAS u32x2*)(StS + (16 * wave + fr) * 136 + 16 * kt + 4 * fq) = w;
            }
        }
        LDS_BARRIER();
        {
            const f32x4 x0 = *(const LAS f32x4*)(OS + tt * 132 + kg), x1 = *(const LAS f32x4*)(OS + tt * 132 + kg + 4);
            float ov[8] = {x0.x, x0.y, x0.z, x0.w, x1.x, x1.y, x1.z, x1.w};
            float ss = 0.f;
#pragma unroll
            for (int e = 0; e < 8; ++e) ss += ov[e] * ov[e];
            ss = sum16_dpp(ss);
            const float rstd = __builtin_amdgcn_rsqf(ss * (1.f / 128.f) + EPS);
            float gv[8]; unpack8(cgt, gv);
            const f32x4 go0 = *(const LAS f32x4*)(GOS + kg), go1 = *(const LAS f32x4*)(GOS + kg + 4);
            const float gov[8] = {go0.x, go0.y, go0.z, go0.w, go1.x, go1.y, go1.z, go1.w};
#pragma unroll
            for (int e = 0; e < 8; ++e) ov[e] = ov[e] * rstd * gov[e] * (gv[e] * __builtin_amdgcn_rcpf(1.0f + __expf(-gv[e])));
            *(u32x4*)(YM + ((size_t)b * SEQ + c * 32 + tt) * 1024 + 512 + hh * 128 + kg) = pack8(ov);
        }
    }
    __syncthreads();
}

__device__ __forceinline__ void xattn_ld(u32x4 (&pre)[8], const bf16_t* src, int tid) {
#pragma unroll
    for (int it = 0; it < 8; ++it) { const int c = tid + 512 * it, row = c >> 5, ch = c & 31; pre[it] = *(const u32x4*)(src + row * 256 + ch * 8); }
}
__device__ __forceinline__ void xattn_st(LAS bf16_t* dst, const u32x4 (&pre)[8], int tid) {
    int t_ = tid; asm volatile("" : "+v"(t_));
    LAS bf16_t* p = dst + (t_ >> 5) * 264 + (t_ & 31) * 8;
#pragma unroll
    for (int it = 0; it < 8; ++it) *(LAS u32x4*)(p + it * (16 * 264)) = pre[it];
}
__device__ __forceinline__ void xattn_q_frags(bf16x8 (&Q)[8], const bf16_t* qp, const float* gmq, int fq) {
    u32x4 qw[8]; float ss = 0.f;
#pragma unroll
    for (int ks = 0; ks < 8; ++ks) { qw[ks] = *(const u32x4*)(qp + 32 * ks); float f[8]; unpack8(qw[ks], f);
#pragma unroll
        for (int e = 0; e < 8; ++e) ss += f[e] * f[e]; }
    ss += __shfl_xor(ss, 16); ss += __shfl_xor(ss, 32);
    const float sc = __builtin_amdgcn_rsqf(ss * (1.f / 256.f) + EPS) * (0.0625f * LOG2E);
#pragma unroll
    for (int ks = 0; ks < 8; ++ks) { float f[8]; unpack8(qw[ks], f); const f32x4 g0 = *(const f32x4*)(gmq + 32 * ks + fq * 8), g1 = *(const f32x4*)(gmq + 32 * ks + fq * 8 + 4);
        f[0] *= sc * g0.x; f[1] *= sc * g0.y; f[2] *= sc * g0.z; f[3] *= sc * g0.w; f[4] *= sc * g1.x; f[5] *= sc * g1.y; f[6] *= sc * g1.z; f[7] *= sc * g1.w;
        Q[ks] = __builtin_bit_cast(bf16x8, pack8(f)); }
}
template <bool FIRST>
__device__ __forceinline__ void xattn_sp_stage(bf16x8 (&P0)[4], bf16x8 (&P1)[4], float& sum0, float& sum1, float& m0, float& m1, const LAS bf16_t* SB, const bf16x8 (&Q0)[8], const bf16x8 (&Q1)[8], int fr, int fq) {
#pragma unroll
    for (int kc = 0; kc < 4; ++kc) {
        f32x4 a00 = (f32x4){0.f, 0.f, 0.f, 0.f}, a01 = a00, a10 = a00, a11 = a00;
#pragma unroll
        for (int ks = 0; ks < 8; ++ks) {
            const bf16x8 ka = *(const LAS bf16x8*)(SB + (32 * kc + fr) * 264 + 32 * ks + fq * 8), kb = *(const LAS bf16x8*)(SB + (32 * kc + 16 + fr) * 264 + 32 * ks + fq * 8);
            a00 = MFMA16(ka, Q0[ks], a00); a10 = MFMA16(ka, Q1[ks], a10); a01 = MFMA16(kb, Q0[ks], a01); a11 = MFMA16(kb, Q1[ks], a11);
        }
        if (FIRST && kc == 0) {
            float x0 = fmaxf(fmaxf(a00[0], a00[1]), fmaxf(a00[2], a00[3])), x1 = fmaxf(fmaxf(a10[0], a10[1]), fmaxf(a10[2], a10[3]));
            x0 = fmaxf(x0, __shfl_xor(x0, 16)); x0 = fmaxf(x0, __shfl_xor(x0, 32)); x1 = fmaxf(x1, __shfl_xor(x1, 16)); x1 = fmaxf(x1, __shfl_xor(x1, 32));
            m0 = x0; m1 = x1;
        }
        float pe[8], pf[8];
#pragma unroll
        for (int j = 0; j < 4; ++j) { pe[j] = __builtin_amdgcn_exp2f(a00[j] - m0); pe[4 + j] = __builtin_amdgcn_exp2f(a01[j] - m0); pf[j] = __builtin_amdgcn_exp2f(a10[j] - m1); pf[4 + j] = __builtin_amdgcn_exp2f(a11[j] - m1); }
#pragma unroll
        for (int e = 0; e < 8; ++e) { sum0 += pe[e]; sum1 += pf[e]; }
        P0[kc] = __builtin_bit_cast(bf16x8, pack8(pe)); P1[kc] = __builtin_bit_cast(bf16x8, pack8(pf));
        asm volatile("" ::: "memory");
    }
}
__device__ __forceinline__ void xattn_pv_stage(const LAS bf16_t* SB, const bf16x8 (&P0a)[4], const bf16x8 (&P0b)[4], const bf16x8 (&P1a)[4], const bf16x8 (&P1b)[4], float inv0, float inv1, bf16_t* o0, bf16_t* o1, int fr, int fq) {
    f32x4 O0[8], O1[8];
#pragma unroll
    for (int dt = 0; dt < 8; ++dt) { O0[dt] = (f32x4){0.f, 0.f, 0.f, 0.f}; O1[dt] = (f32x4){0.f, 0.f, 0.f, 0.f}; }
#pragma unroll
    for (int kc = 0; kc < 8; ++kc) {
        const bf16x8 p0 = kc < 4 ? P0a[kc & 3] : P0b[kc & 3], p1 = kc < 4 ? P1a[kc & 3] : P1b[kc & 3];
#pragma unroll
        for (int dt = 0; dt < 8; ++dt) {
            const LAS bf16_t* vp = SB + (16 * dt + fr) * 264 + 32 * kc + 4 * fq;
            const u32x2 lo = *(const LAS u32x2*)vp, hi = *(const LAS u32x2*)(vp + 16);
            const u32x4 w = (u32x4){lo.x, lo.y, hi.x, hi.y};
            const bf16x8 va = __builtin_bit_cast(bf16x8, w);
            O0[dt] = MFMA16(va, p0, O0[dt]); O1[dt] = MFMA16(va, p1, O1[dt]);
            if (dt == 7) asm volatile("" ::: "memory");
        }
    }
#pragma unroll
    for (int dt = 0; dt < 8; ++dt) {
        u32x2 w; w.x = pk2(O0[dt][0] * inv0, O0[dt][1] * inv0); w.y = pk2(O0[dt][2] * inv0, O0[dt][3] * inv0); *(u32x2*)(o0 + 16 * dt) = w;
        u32x2 v; v.x = pk2(O1[dt][0] * inv1, O1[dt][1] * inv1); v.y = pk2(O1[dt][2] * inv1, O1[dt][3] * inv1); *(u32x2*)(o1 + 16 * dt) = v;
    }
}
__device__ __forceinline__ void xattn_phase(LAS unsigned char* lds, const bf16_t* QM, const bf16_t* KM, const bf16_t* VT, bf16_t* OM, const float* gmq, int bid, int G, int tid0) {
    LAS bf16_t* SB0 = (LAS bf16_t*)lds; LAS bf16_t* SB1 = (LAS bf16_t*)(lds + 67584);
    if (bid >= 1024) return;
    u32x4 pre[8];
    { const int u0 = bid; int t0 = tid0; asm volatile("" : "+v"(t0)); xattn_ld(pre, KM + (size_t)((u0 >> 5) * 4 + ((u0 >> 3) & 3)) * 65536, t0); }
    for (int u = bid; u < 1024; u += G) {
        int tid_ = threadIdx.x; asm volatile("" : "+v"(tid_));
        const int tid = tid_, lane = tid & 63, fr = lane & 15, fq = lane >> 4, wave = __builtin_amdgcn_readfirstlane(tid >> 6);
        const int b = u >> 5, h = (u >> 3) & 3, qb = u & 7;
        const bf16_t* KMp = KM + (size_t)(b * 4 + h) * 65536; const bf16_t* VTp = VT + (size_t)(b * 4 + h) * 65536;
        const size_t trow = (size_t)b * SEQ + qb * 256 + 32 * wave + fr;
        xattn_st(SB0, pre, tid);
        bf16x8 Q0[8], Q1[8];
        xattn_q_frags(Q0, QM + trow * 1024 + h * 256 + fq * 8, gmq, fq);
        asm volatile("" ::: "memory");
        xattn_q_frags(Q1, QM + (trow + 16) * 1024 + h * 256 + fq * 8, gmq, fq);
        bf16x8 P0a[4], P0b[4], P1a[4], P1b[4];
        float m0, m1, sum0, sum1;
        LDS_BARRIER();
        m0 = 0.f; m1 = 0.f; sum0 = 0.f; sum1 = 0.f;
        xattn_sp_stage<true>(P0a, P1a, sum0, sum1, m0, m1, SB0, Q0, Q1, fr, fq);
        { u32x4 t1[8]; xattn_ld(t1, KMp + 128 * 256, tid); xattn_st(SB1, t1, tid); } LDS_BARRIER();
        xattn_sp_stage<false>(P0b, P1b, sum0, sum1, m0, m1, SB1, Q0, Q1, fr, fq);
        sum0 += __shfl_xor(sum0, 16); sum0 += __shfl_xor(sum0, 32); sum1 += __shfl_xor(sum1, 16); sum1 += __shfl_xor(sum1, 32);
        const float inv0 = __builtin_amdgcn_rcpf(sum0), inv1 = __builtin_amdgcn_rcpf(sum1);
        bf16_t* o0 = OM + trow * 1024 + h * 256 + 4 * fq; bf16_t* o1 = o0 + 16 * 1024;
        { u32x4 t2[8]; xattn_ld(t2, VTp, tid); xattn_st(SB0, t2, tid); } xattn_ld(pre, VTp + 128 * 256, tid); LDS_BARRIER();
        xattn_pv_stage(SB0, P0a, P0b, P1a, P1b, inv0, inv1, o0, o1, fr, fq);
        xattn_st(SB1, pre, tid);
        { const int un = u + G; if (un < 1024) xattn_ld(pre, KM + (size_t)((un >> 5) * 4 + ((un >> 3) & 3)) * 65536, tid); }
        LDS_BARRIER();
        xattn_pv_stage(SB1, P0a, P0b, P1a, P1b, inv0, inv1, o0 + 128, o1 + 128, fr, fq);
    }
}

#define XB_TMO      128
#define XB_XCNT(j)  (256  + 64 * (j))
#define XB_XSUB(j)  (1280 + 64 * (j))
#define XB_XGEN(j)  (2304 + 64 * (j))
#define XB_TOP      3328
#define XB_TOPGEN   3392
#define XCD_BAR_WORDS 3456
#define XB_SPIN_CAP (1u << 18)

__device__ __forceinline__ unsigned xb_ld(unsigned* p)              { return __hip_atomic_load(p, __ATOMIC_RELAXED, __HIP_MEMORY_SCOPE_AGENT); }
__device__ __forceinline__ unsigned xb_add(unsigned* p, unsigned v) { return __hip_atomic_fetch_add(p, v, __ATOMIC_RELAXED, __HIP_MEMORY_SCOPE_AGENT); }
__device__ __forceinline__ unsigned xb_xcc_id() { return (unsigned)__builtin_amdgcn_s_getreg((3 << 11) | 20) & 0xFu; }
#define XB_SPIN(cond, bar) do { unsigned _sp = 0; while (cond) { __builtin_amdgcn_s_sleep(1); \
    if ((++_sp & 255u) == 0u) { if (xb_ld(&(bar)[XB_TMO])) break; if (_sp > XB_SPIN_CAP) { atomicAdd(&(bar)[XB_TMO], 1u); break; } } } } while (0)

struct XcdBarrier {
    unsigned* bar; unsigned x;
    volatile LAS unsigned* st;
};

__device__ __forceinline__ XcdBarrier xcd_barrier_post(unsigned* bar, volatile LAS unsigned* st) {
    XcdBarrier b; b.bar = bar; b.x = xb_xcc_id(); b.st = st;
    if (threadIdx.x == 0) (void)xb_add(&bar[XB_XCNT(b.x)], 1u);
    return b;
}
__device__ __forceinline__ void xcd_barrier_complete(unsigned* bar, unsigned x, unsigned& nloc, unsigned& nx) {
    const unsigned G = gridDim.x * gridDim.y * gridDim.z;
    unsigned sum, cnt, mine, sp = 0u;
    for (;;) {
        sum = 0u; cnt = 0u; mine = 0u;
#pragma unroll
        for (unsigned j = 0; j < 16; ++j) { const unsigned c = xb_ld(&bar[XB_XCNT(j)]); sum += c; cnt += (c > 0u) ? 1u : 0u; mine = (j == x) ? c : mine; }
        if (sum == G) break;
        __builtin_amdgcn_s_sleep(1);
        if ((++sp & 255u) == 0u) { if (xb_ld(&bar[XB_TMO])) break; if (sp > XB_SPIN_CAP) { atomicAdd(&bar[XB_TMO], 1u); break; } }
    }
    nloc = mine > 0u ? mine : 1u; nx = cnt > 0u ? cnt : 1u;
}

__device__ __forceinline__ void xcd_barrier(const XcdBarrier& b) {
    asm volatile("s_waitcnt vmcnt(0)" ::: "memory");
    __syncthreads();
    if (threadIdx.x == 0) {
        unsigned* bar = b.bar;
        __builtin_amdgcn_s_waitcnt(0);
        unsigned nloc = b.st[0], nx = b.st[1];
        if (nloc == 0u) { xcd_barrier_complete(bar, b.x, nloc, nx); b.st[0] = nloc; b.st[1] = nx; }
        const unsigned old = xb_add(&bar[XB_XSUB(b.x)], 1u);
        const unsigned gen = old / nloc;
        if (old + 1u == (gen + 1u) * nloc) {
            __builtin_amdgcn_fence(__ATOMIC_RELEASE, "agent");
            asm volatile("s_waitcnt vmcnt(0)" ::: "memory");
            const unsigned og = xb_add(&bar[XB_TOP], 1u);
            const unsigned tg = og / nx;
            if (og + 1u == (tg + 1u) * nx) xb_add(&bar[XB_TOPGEN], 1u);
            else XB_SPIN(xb_ld(&bar[XB_TOPGEN]) == tg, bar);
            __builtin_amdgcn_fence(__ATOMIC_ACQUIRE, "agent");
            xb_add(&bar[XB_XGEN(b.x)], 1u);
            asm volatile("s_waitcnt vmcnt(0)" ::: "memory");
        } else {
            XB_SPIN(xb_ld(&bar[XB_XGEN(b.x)]) == gen, bar);
            __builtin_amdgcn_fence(__ATOMIC_ACQUIRE, "agent");
            asm volatile("s_waitcnt vmcnt(0)" ::: "memory");
        }
    }
    __syncthreads();
}

constexpr int N_PHASES = 5 + 16;
__global__ void __launch_bounds__(512, 2) mega_fwd(Params P) {
    extern __shared__ __attribute__((aligned(16))) unsigned char smem[];
    LAS unsigned char* lds = (LAS unsigned char*)smem;
    cg::grid_group grid = cg::this_grid();
    if (threadIdx.x < 8) ((LAS unsigned*)(lds + LDS_BYTES - 32))[threadIdx.x] = 0u;
    __syncthreads();
    const XcdBarrier xbar = xcd_barrier_post((unsigned*)(P.ws + WS_CTL) + CW_BAR, (volatile LAS unsigned*)(lds + LDS_BYTES - 32));
    grid.sync();
    for (int ph = 0; ph < N_PHASES; ++ph) {
        int tid_ = threadIdx.x, bid_ = blockIdx.x; asm volatile("" : "+v"(tid_)); asm volatile("" : "+s"(bid_));
        const int tid = tid_, bid = bid_, lane = tid & 63, wave = __builtin_amdgcn_readfirstlane(tid >> 6);
        const int G = gridDim.x, gw = bid * 8 + wave, NGW = G * 8;
        const int gtid = bid * 512 + tid, NGT = G * 512;
        unsigned char* ws = P.ws;
        bf16_t* Xb = (bf16_t*)(ws + WS_H); bf16_t* ZU = (bf16_t*)(ws + WS_ZU); bf16_t* YM = (bf16_t*)(ws + WS_YM); bf16_t* QM = (bf16_t*)(ws + WS_QM);
        bf16_t* OP = (bf16_t*)((unsigned char*)P.out + OUT_OP); float* LSE = (float*)((unsigned char*)P.out + OUT_LSE);
        bf16_t* MN = (bf16_t*)(ws + WS_MN); bf16_t* KVT = (bf16_t*)(ws + WS_KVT);
        const float* x_in = P.in[0]; float* X = P.out;
        int lyr = 0, kind = -1;
        float* SS = (float*)(ws + WS_SS);
        if (ph == 0) {
            LAS float* scr = (LAS float*)(lds + wave * 16384);
            constexpr int NI_IN = 16 * 112, NI_SQ = 16 * 32, NI_MKV = 16 * 64, NI_FF1 = 16 * 128, NI_FF2 = 64 * 32;
            constexpr int NI_LAYER = NI_IN + 3 * NI_SQ + NI_MKV + NI_FF1 + NI_FF2;
            for (int it = gw; it < 2 * NI_LAYER; it += NGW) {
                const int l = it / NI_LAYER; int r = it % NI_LAYER;
                unsigned char* wb = ws + WS_WB + (size_t)l * WB_LAYER;
                if (r < NI_IN) { transpose_item(P.in[3] + (size_t)l * 1024 * 3584, 1024, 3584, (bf16_t*)(wb + WB_IN), scr, r, lane, P.in[2] + l * 1024); continue; } r -= NI_IN;
                if (r < NI_SQ) { transpose_item(P.in[8] + (size_t)l * 1024 * 1024, 1024, 1024, (bf16_t*)(wb + WB_OUT), scr, r, lane); continue; } r -= NI_SQ;
                if (r < NI_SQ) { transpose_item(P.in[11] + (size_t)l * 1024 * 1024, 1024, 1024, (bf16_t*)(wb + WB_MQ), scr, r, lane, P.in[9] + l * 1024); continue; } r -= NI_SQ;
                if (r < NI_MKV) { transpose_item(P.in[12] + (size_t)l * 1024 * 2048, 1024, 2048, (bf16_t*)(wb + WB_MKV), scr, r, lane); continue; } r -= NI_MKV;
                if (r < NI_SQ) { transpose_item(P.in[15] + (size_t)l * 1024 * 1024, 1024, 1024, (bf16_t*)(wb + WB_MO), scr, r, lane); continue; } r -= NI_SQ;
                if (r < NI_FF1) { transpose_item(P.in[17] + (size_t)l * 1024 * 4096, 1024, 4096, (bf16_t*)(wb + WB_FF1), scr, r, lane, P.in[16] + l * 1024); continue; } r -= NI_FF1;
                transpose_item(P.in[18] + (size_t)l * 4096 * 1024, 4096, 1024, (bf16_t*)(wb + WB_FF2), scr, r, lane);
            }
            for (int it = gw; it < 2 * NMEMROWS; it += NGW) { const int l = it / NMEMROWS, row = it % NMEMROWS; rms_row_1024(P.in[1] + (size_t)row * 1024, P.in[10] + l * 1024, MN + ((size_t)l * NMEMROWS + row) * 1024, lane); }
            for (int row = gw; row < T; row += NGW) prep_row_1024(x_in + (size_t)row * 1024, Xb + (size_t)row * 1024, SS + row, lane);
        } else if (ph <= 2) {
        } else if (ph == 3) {
            lyr = 0; kind = 0;
        } else if (ph == 4) {
            lyr = 0; kind = 1;
            for (int it = gw; it < 2 * NMEMROWS * 4; it += NGW) {
                const int l = it / (NMEMROWS * 4), rem = it % (NMEMROWS * 4), row = rem >> 2, h = rem & 3;
                const bf16_t* src = KVT + ((size_t)l * NMEMROWS + row) * 2048 + h * 256 + lane * 4;
                const u32x2 w = *(const u32x2*)src;
                float f0 = bflo(w.x), f1 = bfhi(w.x), f2 = bflo(w.y), f3 = bfhi(w.y);
                const float rstd = 1.0f / sqrtf(wave_sum(f0 * f0 + f1 * f1 + f2 * f2 + f3 * f3) * (1.f / 256.f) + EPS);
                const f32x4 gv = *(const f32x4*)(P.in[14] + l * 256 + lane * 4);
                u32x2 o; o.x = pk2(f0 * rstd * gv.x, f1 * rstd * gv.y); o.y = pk2(f2 * rstd * gv.z, f3 * rstd * gv.w);
                bf16_t* dst = (bf16_t*)(ws + WS_KM + (size_t)l * KM_LAYER) + ((size_t)((row >> 8) * 4 + h) * 256 + (row & 255)) * 256 + lane * 4;
                *(u32x2*)dst = o;
            }
            for (int it = gtid; it < 2 * 32 * 4 * 32 * 256; it += NGT) {
                const int dd = it & 255, mg = (it >> 8) & 31, h = (it >> 13) & 3, b = (it >> 15) & 31, l = it >> 20;
                const bf16_t* src = KVT + ((size_t)l * NMEMROWS + b * 256 + mg * 8) * 2048 + 1024 + h * 256 + dd;
                u32x4 o;
                o.x = (unsigned)src[0 * 2048] | ((unsigned)src[1 * 2048] << 16); o.y = (unsigned)src[2 * 2048] | ((unsigned)src[3 * 2048] << 16);
                o.z = (unsigned)src[4 * 2048] | ((unsigned)src[5 * 2048] << 16); o.w = (unsigned)src[6 * 2048] | ((unsigned)src[7 * 2048] << 16);
                bf16_t* dst = (bf16_t*)(ws + WS_KM + (size_t)l * KM_LAYER + VT_OFF) + ((size_t)(b * 4 + h) * 256 + dd) * 256 + mg * 8;
                *(u32x4*)dst = o;
            }
        } else {
            const int idx = ph - 5;
            if (idx < 7) { lyr = 0; kind = idx + 2; } else { lyr = 1; kind = idx - 7; }
        }
        if (kind == 1 || kind == 2 || kind == 5) {
            const int l = lyr, k = kind;
            if (k == 0) {
            } else if (k == 1) {
#if SKIP_HGRN
                for (int it = gtid; it < T * 64; it += NGT) { const int t = it >> 6, c8 = it & 63; *(u32x4*)(YM + (size_t)t * 1024 + 512 + c8 * 8) = (u32x4){0u, 0u, 0u, 0u}; }
#else
                for (int u = bid; u < 128; u += G) hgrn_unit(lds, ZU, YM, P.in[6], P.in[7] + l * 512, l, u, tid);
#endif
                int tid2 = tid; asm volatile("" : "+v"(tid2));
                if (!SKIP_ATTN) attn_loop(lds, ZU, OP, LSE, P.in[4] + l * 64, P.in[5] + l * 64, (unsigned*)(ws + WS_CTL) + 64 * (1 + l), tid2);
            } else if (k == 2) {
                for (int it = gtid; it < T * 64; it += NGT) {
                    const int t = it >> 6, c8 = it & 63, h = c8 >> 3;
                    if (SKIP_ATTN) { *(u32x4*)(YM + (size_t)t * 1024 + c8 * 8) = (u32x4){0u, 0u, 0u, 0u}; continue; }
                    const float l0 = LSE[((size_t)0 * T + t) * 8 + h], l1 = LSE[((size_t)1 * T + t) * 8 + h], l2 = LSE[((size_t)2 * T + t) * 8 + h];
                    const float mx = fmaxf(l0, fmaxf(l1, l2));
                    float w0 = __expf(l0 - mx), w1 = __expf(l1 - mx), w2 = __expf(l2 - mx);
                    const float inv = 1.0f / (w0 + w1 + w2); w0 *= inv; w1 *= inv; w2 *= inv;
                    float a[8], bq[8], cq[8];
                    unpack8(*(const u32x4*)(OP + ((size_t)0 * T + t) * 512 + c8 * 8), a);
                    unpack8(*(const u32x4*)(OP + ((size_t)1 * T + t) * 512 + c8 * 8), bq);
                    unpack8(*(const u32x4*)(OP + ((size_t)2 * T + t) * 512 + c8 * 8), cq);
#pragma unroll
                    for (int e = 0; e < 8; ++e) a[e] = w0 * a[e] + w1 * bq[e] + w2 * cq[e];
                    *(u32x4*)(YM + (size_t)t * 1024 + c8 * 8) = pack8(a);
                }
            } else if (k == 5) {
                const bf16_t* KM = (const bf16_t*)(ws + WS_KM + (size_t)l * KM_LAYER); const bf16_t* VT = (const bf16_t*)(ws + WS_KM + (size_t)l * KM_LAYER + VT_OFF);
#if SKIP_XATTN
                for (int it = gtid; it < T * 128; it += NGT) *(u32x4*)(YM + (size_t)it * 8) = (u32x4){0u, 0u, 0u, 0u};
#else
                xattn_phase(lds, QM, KM, VT, YM, P.in[13] + l * 256, bid, G, tid);
                __syncthreads();
#endif
            }
        }
        if (ph == 1 || ph == 2 || (kind >= 0 && kind != 1 && kind != 2 && kind != 5)) {
            const int l = lyr, k = kind;
            const unsigned char* wb = ws + WS_WB + (size_t)l * WB_LAYER;
            float* ssl = SS + (size_t)(3 * l) * T;
            pg8::Gemm gj{nullptr, nullptr, 0, 0, 0};
            pg8::EpiDyn E{0, true, nullptr, 0, nullptr, nullptr, nullptr};
            if (kind < 0) {
                const int lm = ph - 1;
                gj = pg8::Gemm{MN + (size_t)lm * NMEMROWS * 1024, (const bf16_t*)(ws + WS_WB + (size_t)lm * WB_LAYER + WB_MKV), NMEMROWS, 2048, 1024};
                E = pg8::EpiDyn{0, true, KVT + (size_t)lm * NMEMROWS * 2048, 2048, nullptr, nullptr, nullptr};
            } else if (k == 0) {
                gj = pg8::Gemm{Xb, (const bf16_t*)(wb + WB_IN), T, ZW, 1024}; E = pg8::EpiDyn{0, true, ZU, ZW, ssl, nullptr, nullptr};
            } else if (k == 3) {
                gj = pg8::Gemm{YM, (const bf16_t*)(wb + WB_OUT), T, 1024, 1024}; E = pg8::EpiDyn{1, true, Xb, 1024, nullptr, ssl + T, nullptr};
            } else if (k == 4) {
                gj = pg8::Gemm{Xb, (const bf16_t*)(wb + WB_MQ), T, 1024, 1024}; E = pg8::EpiDyn{0, true, QM, 1024, ssl + T, nullptr, nullptr};
            } else if (k == 6) {
                gj = pg8::Gemm{YM, (const bf16_t*)(wb + WB_MO), T, 1024, 1024}; E = pg8::EpiDyn{1, true, Xb, 1024, nullptr, ssl + 2 * T, nullptr};
            } else if (k == 7) {
                gj = pg8::Gemm{Xb, (const bf16_t*)(wb + WB_FF1), T, DFF, 1024}; E = pg8::EpiDyn{2, true, ZU, DFF, ssl + 2 * T, nullptr, nullptr};
            } else {
                gj = pg8::Gemm{ZU, (const bf16_t*)(wb + WB_FF2), T, 1024, DFF};
                E = pg8::EpiDyn{1, true, Xb, 1024, nullptr, l == 0 ? SS + (size_t)3 * T : nullptr, l == 1 ? X : nullptr};
            }
            pg8::StaticOrder S; S.init(gj.M, gj.N, G, bid);
            pg8::gemm_phase<pg8::EpiDyn, pg8::StaticOrder, true, true>(lds, gj, S, E);
        }
        if (ph + 1 < N_PHASES && ph != 1 && ph != 2) {
            asm volatile("s_waitcnt vmcnt(0) lgkmcnt(0)" ::: "memory");
            __syncthreads();
            xcd_barrier(xbar);
        }
    }
}

extern "C" void kernel_launch(void* const* d_in, const int* in_sizes, int n_in, void* d_out, int out_size, void* d_ws, size_t ws_size, hipStream_t stream) {
    static int grid = 0;
    if (grid == 0) {
        if (n_in != 19 || in_sizes[0] != T * DM || out_size != T * DM || ws_size < WS_END) {
            fprintf(stderr, "kernel_launch: unexpected shapes: n_in %d in0 %d out %d ws %zu (need %zu)\n", n_in, n_in > 0 ? in_sizes[0] : -1, out_size, ws_size, (size_t)WS_END);
            grid = -1; return;
        }
        int dev = 0, cus = 0, per_cu = 0;
        hipGetDevice(&dev);
        hipDeviceGetAttribute(&cus, hipDeviceAttributeMultiprocessorCount, dev);
        hipFuncSetAttribute((const void*)mega_fwd, hipFuncAttributeMaxDynamicSharedMemorySize, LDS_BYTES);
        hipOccupancyMaxActiveBlocksPerMultiprocessor(&per_cu, (const void*)mega_fwd, 512, LDS_BYTES);
        if (per_cu < 1) { fprintf(stderr, "kernel_launch: occupancy query returned %d\n", per_cu); per_cu = 1; }
        grid = cus * per_cu;
        (void)hipGetLastError();
    }
    if (grid < 0) return;
    hipMemsetAsync((char*)d_ws + WS_CTL, 0, CTL_BYTES, stream);
    Params p{};
    for (int i = 0; i < 19; ++i) p.in[i] = (const float*)d_in[i];
    p.out = (float*)d_out; p.ws = (unsigned char*)d_ws;
    void* args[] = {&p};
    hipError_t e = hipLaunchCooperativeKernel((const void*)mega_fwd, dim3(grid), dim3(512), args, LDS_BYTES, stream);
    if (e != hipSuccess) fprintf(stderr, "cooperative launch failed: %s (grid %d)\n", hipGetErrorString(e), grid);
}
```

```cpp
#include <hip/hip_runtime.h>
#include <hip/hip_cooperative_groups.h>
#include <cstdio>
#include <cstdint>
namespace cg = cooperative_groups;
namespace pg8 {
#define PG8_LAS __attribute__((address_space(3)))
typedef unsigned short bf16_t;
typedef short bf16x8 __attribute__((ext_vector_type(8)));
typedef float f32x4 __attribute__((ext_vector_type(4)));
typedef unsigned u32x4 __attribute__((ext_vector_type(4)));
constexpr int BM = 256, BK = 64, HALF = 128, HTB = HALF * BK * 2  , STAGE_BYTES = 8 * HTB, NXCD = 8, WGM = 8;

__host__ __device__ __forceinline__ int lds_byte(int r, int c) { const int st = (r >> 4) * 2 + (c >> 5), rr = r & 15, cc = c & 31, ob = rr * 64 + cc * 2; return st * 1024 + (ob ^ (((ob >> 9) & 1) << 5)); }
__host__ __device__ __forceinline__ void stage_rc(int b, int& R, int& C) { const int st = b / 1024, sb = b % 1024, swz = sb ^ (((sb >> 9) & 1) << 5); R = (st >> 1) * 16 + swz / 64; C = (st & 1) * 32 + (swz % 64) / 2; }
__host__ __device__ __forceinline__ int perm32(int rho) { const int n = rho >> 4, i = rho & 15; return 8 * (i >> 2) + 4 * n + (i & 3); }

struct Unit { int pm, pn; };
struct Gemm { const bf16_t* A; const bf16_t* Bt; int M, N, K; };

struct StaticOrder {
    int nM, nN, nwg, G, c;
    __host__ __device__ void init(int M, int N, int G_, int c_) { nM = M / BM; nN = N / BM; nwg = nM * nN; G = G_; c = c_; }
    __host__ __device__ bool next(int i, Unit& u) const {
        const long L = (long)i * G + c; if (L >= nwg) return false;
        int wgid = (int)L; { const int q = nwg / NXCD, r = nwg % NXCD, xcd = wgid % NXCD, off = wgid / NXCD; wgid = (xcd < r ? xcd * (q + 1) : r * (q + 1) + (xcd - r) * q) + off; }
        const int nig = WGM * nN, gid = wgid / nig, fm = gid * WGM, gsz = (nM - fm) < WGM ? (nM - fm) : WGM;
        u.pm = fm + ((wgid % nig) % gsz); u.pn = (wgid % nig) / gsz; return true;
    }
    __device__ __forceinline__ void a_ready(const Unit&) const {}
    __device__ __forceinline__ void done(const Unit&) const {}
};

typedef float f32x2 __attribute__((ext_vector_type(2)));
typedef __bf16 bf16x2_t __attribute__((ext_vector_type(2)));
__device__ __forceinline__ unsigned cvt_pk_bf16(float lo, float hi) { f32x2 v = {lo, hi}; bf16x2_t b = __builtin_convertvector(v, bf16x2_t); return __builtin_bit_cast(unsigned, b); }
typedef unsigned u32x2 __attribute__((ext_vector_type(2)));
struct EpiDyn {
    static constexpr bool AFTER_DRAIN = false;
    int mode; bool perm;
    bf16_t* O; int ldc;
    const float* ssin; float* ssn; float* outf;
    const PG8_LAS float* rs; int pm0;
    __device__ __forceinline__ void operator()(const f32x4 (&acc)[2][2][4][2], const Unit& u, int wr, int wc, int fr, int fq) const {
        const int row0 = u.pm * BM + wr * 64 + fr; const int col0 = u.pn * BM + wc * 32 + 8 * fq;
        if (mode == 1) {
            const bool nx = ssn != nullptr, fin = outf != nullptr;
#pragma unroll
            for (int ai = 0; ai < 2; ++ai)
#pragma unroll
                for (int m = 0; m < 4; ++m) { const int row = row0 + ai * HALF + m * 16; bf16_t* rowp = O + (size_t)row * ldc + col0; float ssq = 0.f;
#pragma unroll
                    for (int bj = 0; bj < 2; ++bj) { const u32x4 bw = *(const u32x4*)(rowp + bj * HALF);
                        f32x4 v0 = acc[ai][bj][m][0], v1 = acc[ai][bj][m][1];
                        v0[0] += __builtin_bit_cast(float, bw.x << 16); v0[1] += __builtin_bit_cast(float, bw.x & 0xffff0000u); v0[2] += __builtin_bit_cast(float, bw.y << 16); v0[3] += __builtin_bit_cast(float, bw.y & 0xffff0000u);
                        v1[0] += __builtin_bit_cast(float, bw.z << 16); v1[1] += __builtin_bit_cast(float, bw.z & 0xffff0000u); v1[2] += __builtin_bit_cast(float, bw.w << 16); v1[3] += __builtin_bit_cast(float, bw.w & 0xffff0000u);
                        ssq += (v0[0] * v0[0] + v0[1] * v0[1]) + (v0[2] * v0[2] + v0[3] * v0[3]) + (v1[0] * v1[0] + v1[1] * v1[1]) + (v1[2] * v1[2] + v1[3] * v1[3]);
                        if (fin) { float* op = outf + (size_t)row * ldc + col0 + bj * HALF; *(f32x4*)op = v0; *(f32x4*)(op + 4) = v1; }
                        else { u32x4 w; w.x = cvt_pk_bf16(v0[0], v0[1]); w.y = cvt_pk_bf16(v0[2], v0[3]); w.z = cvt_pk_bf16(v1[0], v1[1]); w.w = cvt_pk_bf16(v1[2], v1[3]); *(u32x4*)(rowp + bj * HALF) = w; } }
                    if (nx) { ssq += __shfl_xor(ssq, 16); ssq += __shfl_xor(ssq, 32); if (fq == 0) (void)__hip_atomic_fetch_add(ssn + row, ssq, __ATOMIC_RELAXED, __HIP_MEMORY_SCOPE_AGENT); } }
        } else {
            const bool sq = (mode == 2), scl = ssin != nullptr;
#pragma unroll
            for (int ai = 0; ai < 2; ++ai)
#pragma unroll
                for (int m = 0; m < 4; ++m) { const int row = row0 + ai * HALF + m * 16; bf16_t* rowp = O + (size_t)row * ldc + col0;
                    const float sc = rs ? rs[((u.pm - pm0) >> 3) * 256 + (row & 255)] : (scl ? 1.0f / sqrtf(ssin[row] * (1.f / 1024.f) + 1e-6f) : 1.0f);
#pragma unroll
                    for (int bj = 0; bj < 2; ++bj) { f32x4 v0 = acc[ai][bj][m][0] * sc, v1 = acc[ai][bj][m][1] * sc;
                        if (sq) {
#pragma unroll
                            for (int e = 0; e < 4; ++e) { float a = v0[e] > 0.f ? v0[e] : 0.f; v0[e] = a * a; float b = v1[e] > 0.f ? v1[e] : 0.f; v1[e] = b * b; } }
                        u32x4 w; w.x = cvt_pk_bf16(v0[0], v0[1]); w.y = cvt_pk_bf16(v0[2], v0[3]); w.z = cvt_pk_bf16(v1[0], v1[1]); w.w = cvt_pk_bf16(v1[2], v1[3]);
                        *(u32x4*)(rowp + bj * HALF) = w; } }
        }
    }
};
template <class Epi, class Sched, bool ALIGN_EPI = false, bool SP2 = false>
__device__ __forceinline__ void gemm_phase(PG8_LAS unsigned char* lds, const Gemm g, const Sched& S, const Epi& E) {
    int tid_ = threadIdx.x; asm volatile("" : "+v"(tid_)); const int tid = tid_, wid = __builtin_amdgcn_readfirstlane(tid >> 6), lane = tid & 63, wr = wid >> 2, wc = wid & 3, fr = lane & 15, fq = lane >> 4;
    const int K = g.K, nt = K / BK;
    unsigned voffA[2], voffB[2];
#pragma unroll
    for (int i = 0; i < 2; ++i) { int R, C; stage_rc(tid * 16 + i * 8192, R, C); const int Rb = E.perm ? ((R & ~31) + perm32(R & 31)) : R;
        voffA[i] = (unsigned)(R * K + C) * 2u; voffB[i] = (unsigned)(Rb * K + C) * 2u; }
    const size_t kstep = (size_t)(BK * 2);
    const size_t hstep = (size_t)HALF * K * 2;
    const size_t tstep = 2 * hstep;
    const unsigned ldsw = (unsigned)wid * 1024u;
    const int aoff = lds_byte(wr * 64 + fr, fq * 8), boff = lds_byte(wc * 32 + fr, fq * 8);
#define PG8_SA(b, h) (((b) * 2 + (h)) * HTB)
#define PG8_SB(b, h) ((4 + (b) * 2 + (h)) * HTB)
#define PG8_STAGE(bufoff, gbase, voff) do { _Pragma("unroll") for (int _i = 0; _i < 2; ++_i) \
        __builtin_amdgcn_global_load_lds((const unsigned*)((const char*)(gbase) + (voff)[_i]), (PG8_LAS unsigned*)(lds + (bufoff) + ldsw + _i * 8192), 16, 0, 0); } while (0)
#define PG8_LDA(dst, b, h) do { _Pragma("unroll") for (int m = 0; m < 4; ++m) _Pragma("unroll") for (int k = 0; k < 2; ++k) dst[m][k] = *(const PG8_LAS bf16x8*)(lds + PG8_SA(b, h) + aoff + m * 2048 + k * 1024); } while (0)
#define PG8_LDB(dst, b, h) do { _Pragma("unroll") for (int n = 0; n < 2; ++n) _Pragma("unroll") for (int k = 0; k < 2; ++k) dst[n][k] = *(const PG8_LAS bf16x8*)(lds + PG8_SB(b, h) + boff + n * 2048 + k * 1024); } while (0)
#define PG8_MMA(ai, bj, At, Bt) do { __builtin_amdgcn_s_setprio(1); _Pragma("unroll") for (int m = 0; m < 4; ++m) _Pragma("unroll") for (int n = 0; n < 2; ++n) _Pragma("unroll") for (int k = 0; k < 2; ++k) \
        acc[ai][bj][m][n] = __builtin_amdgcn_mfma_f32_16x16x32_bf16(Bt[n][k], At[m][k], acc[ai][bj][m][n], 0, 0, 0); __builtin_amdgcn_s_setprio(0); } while (0)
#define PG8_WAIT_V(n) asm volatile("s_waitcnt vmcnt(" #n ")" ::: "memory")
#define PG8_WAIT_L(n) asm volatile("s_waitcnt lgkmcnt(" #n ")" ::: "memory")
#define PG8_BAR __builtin_amdgcn_s_barrier()
#define PG8_SCHED __builtin_amdgcn_sched_barrier(0)
    Unit cur, nxt; int ui = 0;
    if (!S.next(0, cur)) return;
    f32x4 acc[2][2][4][2];
#pragma unroll
    for (int a = 0; a < 2; ++a)
#pragma unroll
        for (int b = 0; b < 2; ++b)
#pragma unroll
            for (int m = 0; m < 4; ++m)
#pragma unroll
                for (int n = 0; n < 2; ++n) acc[a][b][m][n] = (f32x4){0.f, 0.f, 0.f, 0.f};
    bf16x8 At[4][2], B0[2][2], B1[2][2];
    const char* cA = (const char*)g.A + (size_t)cur.pm * tstep; const char* cB = (const char*)g.Bt + (size_t)cur.pn * tstep;
    S.a_ready(cur);
    if constexpr (SP2) {
        PG8_STAGE(PG8_SB(0, 0), cB, voffB); PG8_STAGE(PG8_SB(0, 1), cB + hstep, voffB); PG8_STAGE(PG8_SA(0, 0), cA, voffA); PG8_STAGE(PG8_SA(0, 1), cA + hstep, voffA);
        if (wr == 1) PG8_BAR;
        PG8_WAIT_V(2); PG8_BAR;
        PG8_STAGE(PG8_SB(1, 0), cB + kstep, voffB); PG8_STAGE(PG8_SA(1, 0), cA + kstep, voffA); PG8_STAGE(PG8_SB(1, 1), cB + hstep + kstep, voffB);
        PG8_WAIT_V(6); PG8_BAR;
    } else {
        PG8_STAGE(PG8_SB(0, 0), cB, voffB); PG8_STAGE(PG8_SA(0, 0), cA, voffA); PG8_STAGE(PG8_SB(0, 1), cB + hstep, voffB); PG8_STAGE(PG8_SA(0, 1), cA + hstep, voffA);
        if (wr == 1) PG8_BAR;
        PG8_WAIT_V(4); PG8_BAR;
        PG8_STAGE(PG8_SB(1, 0), cB + kstep, voffB); PG8_STAGE(PG8_SA(1, 0), cA + kstep, voffA); PG8_STAGE(PG8_SB(1, 1), cB + hstep + kstep, voffB);
        PG8_WAIT_V(6); PG8_BAR;
    }
    for (;;) {
        const bool has_next = S.next(ui + 1, nxt);
        const char* nA = has_next ? (const char*)g.A + (size_t)nxt.pm * tstep : cA; const char* nB = has_next ? (const char*)g.Bt + (size_t)nxt.pn * tstep : cB;
        for (int t = 0; t < nt; t += 2) {
            const bool last = (t == nt - 2);
            const char* a1 = cA + (size_t)(t + 1) * kstep;
            const char* a2 = last ? nA : cA + (size_t)(t + 2) * kstep; const char* b2 = last ? nB : cB + (size_t)(t + 2) * kstep;
            const char* a3 = a2 + kstep; const char* b3 = b2 + kstep;
            if (last && has_next) S.a_ready(nxt);
            if constexpr (SP2) {
            PG8_LDB(B0, 0, 0); PG8_LDB(B1, 0, 1); PG8_SCHED; PG8_LDA(At, 0, 0); PG8_STAGE(PG8_SA(1, 1), a1 + hstep, voffA);
            PG8_WAIT_V(8); PG8_WAIT_L(0); PG8_BAR; PG8_MMA(0, 0, At, B0); PG8_MMA(0, 1, At, B1); PG8_BAR; PG8_SCHED;
            PG8_LDA(At, 0, 1); PG8_STAGE(PG8_SB(0, 0), b2, voffB); PG8_STAGE(PG8_SB(0, 1), b2 + hstep, voffB); PG8_STAGE(PG8_SA(0, 0), a2, voffA);
            PG8_WAIT_V(8); PG8_WAIT_L(0); PG8_BAR; PG8_MMA(1, 0, At, B0); PG8_MMA(1, 1, At, B1); PG8_BAR; PG8_SCHED;
            PG8_LDB(B0, 1, 0); PG8_LDB(B1, 1, 1); PG8_SCHED; PG8_LDA(At, 1, 0); PG8_STAGE(PG8_SA(0, 1), a2 + hstep, voffA);
            PG8_WAIT_V(8); PG8_WAIT_L(0); PG8_BAR; PG8_MMA(0, 0, At, B0); PG8_MMA(0, 1, At, B1); PG8_BAR; PG8_SCHED;
            PG8_LDA(At, 1, 1); PG8_STAGE(PG8_SB(1, 0), b3, voffB); PG8_STAGE(PG8_SB(1, 1), b3 + hstep, voffB); PG8_STAGE(PG8_SA(1, 0), a3, voffA);
            PG8_WAIT_V(8); PG8_WAIT_L(0); PG8_BAR; PG8_MMA(1, 0, At, B0); PG8_MMA(1, 1, At, B1); PG8_BAR; PG8_SCHED;
            } else {
            PG8_LDB(B0, 0, 0); PG8_SCHED; PG8_LDA(At, 0, 0); PG8_STAGE(PG8_SA(1, 1), a1 + hstep, voffA);
            PG8_WAIT_L(8); PG8_BAR; PG8_WAIT_L(0); PG8_MMA(0, 0, At, B0); PG8_BAR; PG8_SCHED;
            PG8_LDB(B1, 0, 1); PG8_STAGE(PG8_SB(0, 0), b2, voffB);
            PG8_BAR; PG8_WAIT_L(0); PG8_MMA(0, 1, At, B1); PG8_BAR;
            PG8_LDA(At, 0, 1); PG8_STAGE(PG8_SA(0, 0), a2, voffA);
            PG8_BAR; PG8_WAIT_L(0); PG8_MMA(1, 0, At, B0); PG8_BAR; PG8_SCHED;
            PG8_STAGE(PG8_SB(0, 1), b2 + hstep, voffB);
            PG8_WAIT_V(6); PG8_BAR; PG8_MMA(1, 1, At, B1); PG8_BAR;
            PG8_LDB(B0, 1, 0); PG8_SCHED; PG8_LDA(At, 1, 0); PG8_STAGE(PG8_SA(0, 1), a2 + hstep, voffA);
            PG8_WAIT_L(8); PG8_BAR; PG8_WAIT_L(0); PG8_MMA(0, 0, At, B0); PG8_BAR; PG8_SCHED;
            PG8_LDB(B1, 1, 1); PG8_STAGE(PG8_SB(1, 0), b3, voffB);
            PG8_BAR; PG8_WAIT_L(0); PG8_MMA(0, 1, At, B1); PG8_BAR;
            PG8_LDA(At, 1, 1); PG8_STAGE(PG8_SA(1, 0), a3, voffA);
            PG8_BAR; PG8_WAIT_L(0); PG8_MMA(1, 0, At, B0); PG8_BAR; PG8_SCHED;
            PG8_STAGE(PG8_SB(1, 1), b3 + hstep, voffB);
            PG8_WAIT_V(6); PG8_BAR; PG8_MMA(1, 1, At, B1); PG8_BAR;
            }
        }
        if constexpr (ALIGN_EPI) { if (wr == 0) PG8_BAR; }
        if constexpr (!Epi::AFTER_DRAIN) { E(acc, cur, wr, wc, fr, fq); S.done(cur); }
        if (!has_next) break;
#pragma unroll
        for (int a = 0; a < 2; ++a)
#pragma unroll
            for (int b = 0; b < 2; ++b)
#pragma unroll
                for (int m = 0; m < 4; ++m)
#pragma unroll
                    for (int n = 0; n < 2; ++n) acc[a][b][m][n] = (f32x4){0.f, 0.f, 0.f, 0.f};
        cur = nxt; cA = nA; cB = nB; ++ui;
        if constexpr (ALIGN_EPI) { if (wr == 1) PG8_BAR; }
    }
    PG8_WAIT_V(0);
    if constexpr (!ALIGN_EPI) { if (wr == 0) PG8_BAR; }
    PG8_BAR;
    if constexpr (Epi::AFTER_DRAIN) { E.fused(acc, cur, wr, wc, fr, fq, lds, wid, lane); S.done(cur); }
#undef PG8_SA
#undef PG8_SB
#undef PG8_STAGE
#undef PG8_LDA
#undef PG8_LDB
#undef PG8_MMA
#undef PG8_WAIT_V
#undef PG8_WAIT_L
#undef PG8_BAR
#undef PG8_SCHED
}
}

#define LAS __attribute__((address_space(3)))
typedef unsigned short bf16_t;
typedef short bf16x8 __attribute__((ext_vector_type(8)));
typedef float f32x4 __attribute__((ext_vector_type(4)));
typedef unsigned u32x4 __attribute__((ext_vector_type(4)));
typedef unsigned u32x2 __attribute__((ext_vector_type(2)));

constexpr int T = 65536, DM = 1024, SEQ = 2048, NBATCH = 32, ZW = 3584, DFF = 4096, NMEMROWS = 8192;
constexpr float EPS = 1e-6f, LOG2E = 1.4426950408889634f, LN2 = 0.6931471805599453f;
constexpr size_t MiB = 1u << 20;
constexpr size_t WS_CTL = 0, CTL_BYTES = 2 * MiB;
constexpr size_t WS_SS = 256 * 1024;
constexpr int CW_BAR = 2048;
constexpr size_t WS_WB = 2 * MiB, WB_LAYER = 36 * MiB;
constexpr size_t WB_IN = 0, WB_OUT = 7 * MiB, WB_MQ = 9 * MiB, WB_MKV = 11 * MiB, WB_MO = 15 * MiB, WB_FF1 = 17 * MiB, WB_FF2 = 25 * MiB;
constexpr size_t WS_KM = 74 * MiB, KM_LAYER = 32 * MiB, VT_OFF = 16 * MiB;
constexpr size_t WS_YM = 138 * MiB, WS_ZU = 266 * MiB, WS_H = 778 * MiB;
constexpr size_t WS_MN = WS_ZU, WS_KVT = WS_ZU + 32 * MiB;
constexpr size_t WS_QM = WS_ZU;
constexpr size_t WS_END = WS_H + 128 * MiB;
constexpr size_t OUT_OP = 0, OUT_LSE = 192 * MiB;
constexpr int LDS_BYTES = 147456;
constexpr int N_ATT_UNITS = NBATCH * 8 * 48;

#ifndef SKIP_HGRN
#define SKIP_HGRN 0
#endif
#ifndef SKIP_ATTN
#define SKIP_ATTN 0
#endif
#ifndef SKIP_XATTN
#define SKIP_XATTN 0
#endif
struct Params { const float* in[19]; float* out; unsigned char* ws; };

__device__ __forceinline__ unsigned f2bf(float f) { unsigned u = __builtin_bit_cast(unsigned, f); return (u + 0x7fffu + ((u >> 16) & 1u)) >> 16; }
__device__ __forceinline__ unsigned pk2(float lo, float hi) { return pg8::cvt_pk_bf16(lo, hi); }
__device__ __forceinline__ float bflo(unsigned w) { return __builtin_bit_cast(float, w << 16); }
__device__ __forceinline__ float bfhi(unsigned w) { return __builtin_bit_cast(float, w & 0xffff0000u); }
__device__ __forceinline__ void unpack8(const u32x4 w, float (&f)[8]) {
    f[0] = bflo(w.x); f[1] = bfhi(w.x); f[2] = bflo(w.y); f[3] = bfhi(w.y); f[4] = bflo(w.z); f[5] = bfhi(w.z); f[6] = bflo(w.w); f[7] = bfhi(w.w);
}
__device__ __forceinline__ u32x4 pack8(const float (&f)[8]) { u32x4 w; w.x = pk2(f[0], f[1]); w.y = pk2(f[2], f[3]); w.z = pk2(f[4], f[5]); w.w = pk2(f[6], f[7]); return w; }
__device__ __forceinline__ float wave_sum(float v) {
#pragma unroll
    for (int o = 1; o < 64; o <<= 1) v += __shfl_xor(v, o);
    return v;
}
#define DPPF(v, ctrl) __builtin_bit_cast(float, __builtin_amdgcn_mov_dpp(__builtin_bit_cast(int, (v)), (ctrl), 0xF, 0xF, true))
__device__ __forceinline__ float sum8_dpp(float v) { v += DPPF(v, 0xB1); v += DPPF(v, 0x4E); v += DPPF(v, 0x141); return v; }
__device__ __forceinline__ float sum16_dpp(float v) { v = sum8_dpp(v); v += DPPF(v, 0x128); return v; }
#define MFMA16(a, b, c) __builtin_amdgcn_mfma_f32_16x16x32_bf16((a), (b), (c), 0, 0, 0)
#define LDS_WAIT() asm volatile("s_waitcnt lgkmcnt(0)" ::: "memory")
#define LDS_BARRIER() do { asm volatile("s_waitcnt lgkmcnt(0)" ::: "memory"); __builtin_amdgcn_s_barrier(); asm volatile("" ::: "memory"); } while (0)

__device__ __forceinline__ void transpose_item(const float* W, int K, int N, bf16_t* WT, LAS float* scr, int item, int lane, const float* g = nullptr) {
    const int nblk = N / 32, kb = item / nblk, nb = item % nblk, k0 = 64 * kb, n0 = 32 * nb;
#pragma unroll 8
    for (int i = 0; i < 32; ++i) { const int kk = 2 * i + (lane >> 5); scr[kk * 33 + (lane & 31)] = W[(size_t)(k0 + kk) * N + n0 + (lane & 31)] * (g ? g[k0 + kk] : 1.0f); }
    LDS_WAIT();
    const int c = lane & 7;
#pragma unroll
    for (int j = 0; j < 4; ++j) { const int n = (lane >> 3) + 8 * j; const LAS float* s = scr + (8 * c) * 33 + n;
        u32x4 o; o.x = pk2(s[0 * 33], s[1 * 33]); o.y = pk2(s[2 * 33], s[3 * 33]); o.z = pk2(s[4 * 33], s[5 * 33]); o.w = pk2(s[6 * 33], s[7 * 33]);
        *(u32x4*)(WT + (size_t)(n0 + n) * K + k0 + 8 * c) = o; }
    LDS_WAIT();
}
__device__ __forceinline__ void rms_row_1024(const float* xrow, const float* g, bf16_t* orow, int lane) {
    const f32x4* xr = (const f32x4*)xrow + lane; const f32x4* gr = (const f32x4*)g + lane;
    f32x4 v[4]; float s = 0.f;
#pragma unroll
    for (int j = 0; j < 4; ++j) { v[j] = xr[64 * j]; s += (v[j].x * v[j].x + v[j].y * v[j].y) + (v[j].z * v[j].z + v[j].w * v[j].w); }
    const float rstd = 1.0f / sqrtf(wave_sum(s) * (1.f / 1024.f) + EPS);
    u32x2* o8 = (u32x2*)orow + lane;
#pragma unroll
    for (int j = 0; j < 4; ++j) { const f32x4 gv = gr[64 * j]; u32x2 w; w.x = pk2(v[j].x * rstd * gv.x, v[j].y * rstd * gv.y); w.y = pk2(v[j].z * rstd * gv.z, v[j].w * rstd * gv.w); o8[64 * j] = w; }
}

__device__ __forceinline__ void prep_row_1024(const float* xrow, bf16_t* orow, float* ssp, int lane) {
    const f32x4* xr = (const f32x4*)xrow + lane;
    float s = 0.f; u32x2* o8 = (u32x2*)orow + lane;
#pragma unroll
    for (int j = 0; j < 4; ++j) { const f32x4 v = xr[64 * j]; s += (v.x * v.x + v.y * v.y) + (v.z * v.z + v.w * v.w);
        u32x2 w; w.x = pk2(v.x, v.y); w.y = pk2(v.z, v.w); o8[64 * j] = w; }
    s = wave_sum(s);
    if (lane == 0) *ssp = s;
}

struct AttnU { int b, h, p, d, r, n; };
__device__ __forceinline__ AttnU attn_decode(int u) {
    AttnU U; const int bh = u / 48, s48 = u % 48, idx = s48 & 15; U.b = bh >> 3; U.h = bh & 7; U.p = s48 >> 4;
    if (U.p == 0) { U.d = 1; U.r = 0; U.n = idx; } else if (U.p == 1) { U.d = 4; U.r = idx & 3; U.n = idx >> 2; } else { U.d = 16; U.r = idx; U.n = 0; }
    return U;
}
struct AttnRegs { u32x4 kw[4], vw[4], q0, q1; };
__device__ __forceinline__ void attn_load(AttnRegs& R, const bf16_t* Z, const AttnU& U, int tid) {
    const int wave = tid >> 6, lane = tid & 63, fr = lane & 15, fq = lane >> 4;
    const size_t rowbase = (size_t)U.b * SEQ;
#pragma unroll
    for (int it = 0; it < 4; ++it) {
        const int c = tid + 512 * it, row = c >> 3, ch = c & 7, lk = 128 * (U.n - 1) + row;
        R.kw[it] = (u32x4){0u, 0u, 0u, 0u}; R.vw[it] = (u32x4){0u, 0u, 0u, 0u};
        if (lk >= 0) { const bf16_t* zr = Z + (rowbase + (size_t)(lk * U.d + U.r)) * ZW + U.h * 64 + ch * 8; R.kw[it] = *(const u32x4*)(zr + 512); R.vw[it] = *(const u32x4*)(zr + 1024); }
    }
    const int qi = 16 * wave + fr, posq = (128 * U.n + qi) * U.d + U.r;
    const bf16_t* zq = Z + (rowbase + (size_t)posq) * ZW + U.h * 64;
    R.q0 = *(const u32x4*)(zq + fq * 8); R.q1 = *(const u32x4*)(zq + 32 + fq * 8);
}
__device__ __forceinline__ void attn_stage(LAS unsigned char* lds, const AttnRegs& R, const float* gq, const float* gk, int tid, bf16x8& Q0, bf16x8& Q1) {
    const int lane = tid & 63, fq = lane >> 4;
    LAS bf16_t* Ks = (LAS bf16_t*)lds; LAS bf16_t* Vt = (LAS bf16_t*)(lds + 36864);
#pragma unroll
    for (int it = 0; it < 4; ++it) {
        const int c = tid + 512 * it, row = c >> 3, ch = c & 7;
        const u32x4 vw = R.vw[it];
        float kf[8]; unpack8(R.kw[it], kf);
        float ss = 0.f;
#pragma unroll
        for (int e = 0; e < 8; ++e) ss += kf[e] * kf[e];
        ss = sum8_dpp(ss);
        const float rstd = __builtin_amdgcn_rsqf(ss * (1.f / 64.f) + EPS);
        const f32x4 g0 = *(const f32x4*)(gk + ch * 8), g1 = *(const f32x4*)(gk + ch * 8 + 4);
        kf[0] *= rstd * g0.x; kf[1] *= rstd * g0.y; kf[2] *= rstd * g0.z; kf[3] *= rstd * g0.w; kf[4] *= rstd * g1.x; kf[5] *= rstd * g1.y; kf[6] *= rstd * g1.z; kf[7] *= rstd * g1.w;
        *(LAS u32x4*)(Ks + row * 72 + ch * 8) = pack8(kf);
        LAS bf16_t* vt = Vt + (ch * 8) * 264 + 8 * ch + row;
        vt[0 * 264] = (bf16_t)(vw.x & 0xffffu); vt[1 * 264] = (bf16_t)(vw.x >> 16); vt[2 * 264] = (bf16_t)(vw.y & 0xffffu); vt[3 * 264] = (bf16_t)(vw.y >> 16);
        vt[4 * 264] = (bf16_t)(vw.z & 0xffffu); vt[5 * 264] = (bf16_t)(vw.z >> 16); vt[6 * 264] = (bf16_t)(vw.w & 0xffffu); vt[7 * 264] = (bf16_t)(vw.w >> 16);
    }
    float a[8], c[8]; unpack8(R.q0, a); unpack8(R.q1, c);
    float ss = 0.f;
#pragma unroll
    for (int e = 0; e < 8; ++e) ss += a[e] * a[e] + c[e] * c[e];
    ss += __shfl_xor(ss, 16); ss += __shfl_xor(ss, 32);
    const float sc = __builtin_amdgcn_rsqf(ss * (1.f / 64.f) + EPS) * (0.125f * LOG2E);
#pragma unroll
    for (int e = 0; e < 8; ++e) { a[e] *= sc * gq[fq * 8 + e]; c[e] *= sc * gq[32 + fq * 8 + e]; }
    Q0 = __builtin_bit_cast(bf16x8, pack8(a)); Q1 = __builtin_bit_cast(bf16x8, pack8(c));
}
__device__ __forceinline__ void attn_compute(LAS unsigned char* lds, const AttnU& U, const bf16x8 Q0, const bf16x8 Q1, bf16_t* OP, float* LSE, int tid) {
    const int wave = __builtin_amdgcn_readfirstlane(tid >> 6), lane = tid & 63, fr = lane & 15, fq = lane >> 4;
    const int b = U.b, h = U.h, p = U.p, d = U.d, r = U.r, n = U.n;
    LAS bf16_t* Ks = (LAS bf16_t*)lds;
    LAS bf16_t* Vt = (LAS bf16_t*)(lds + 36864);
    LAS bf16_t* Ps = (LAS bf16_t*)(lds + 70784) + wave * (16 * 168);
    const size_t rowbase = (size_t)b * SEQ;
    const int qi = 16 * wave + fr, posq = (128 * n + qi) * d + r;
    const int start = wave < 6 ? 16 * wave : 96, i0 = 16 * wave;
    const float slope2 = exp2f(-(float)(h + 1)) * (float)d * LOG2E;
    const float fbase = (float)(qi + 128 - start - 4 * fq);
    f32x4 S[10]; bool dead[10];
    float m = -1e30f;
#pragma unroll
    for (int t = 0; t < 10; ++t) {
        const int k0 = start + 16 * t;
        dead[t] = (k0 > i0 + 143) || (k0 + 15 < i0) || (n == 0 && k0 + 15 < 128);
        const bool full = (k0 >= i0 + 15) && (k0 + 15 <= i0 + 128) && (n > 0 || k0 >= 128);
        if (dead[t]) { S[t] = (f32x4){-1e30f, -1e30f, -1e30f, -1e30f}; }
        else {
            const LAS bf16_t* kp = Ks + (k0 + fr) * 72 + fq * 8;
            const bf16x8 a0 = *(const LAS bf16x8*)kp, a1 = *(const LAS bf16x8*)(kp + 32);
            f32x4 acc = (f32x4){0.f, 0.f, 0.f, 0.f};
            acc = MFMA16(a0, Q0, acc); acc = MFMA16(a1, Q1, acc);
            if (full) {
#pragma unroll
                for (int j = 0; j < 4; ++j) { const float v = acc[j] - slope2 * (fbase - (float)(16 * t + j)); acc[j] = v; m = fmaxf(m, v); }
            } else {
#pragma unroll
                for (int j = 0; j < 4; ++j) {
                    const int kj = k0 + 4 * fq + j, step = qi + 128 - kj, lk = 128 * (n - 1) + kj;
                    const bool valid = (step >= 0) && (step <= 128) && (lk >= 0);
                    const float v = valid ? acc[j] - slope2 * (float)step : -1e30f;
                    acc[j] = v; m = fmaxf(m, v);
                }
            }
            S[t] = acc;
        }
    }
    m = fmaxf(m, __shfl_xor(m, 16)); m = fmaxf(m, __shfl_xor(m, 32));
    float sum = 0.f;
#pragma unroll
    for (int t = 0; t < 10; ++t) {
        u32x2 w = (u32x2){0u, 0u};
        if (!dead[t]) {
            float pe[4];
#pragma unroll
            for (int j = 0; j < 4; ++j) { pe[j] = __builtin_amdgcn_exp2f(S[t][j] - m); sum += pe[j]; }
            w.x = pk2(pe[0], pe[1]); w.y = pk2(pe[2], pe[3]);
        }
        *(LAS u32x2*)(Ps + fr * 168 + 16 * t + 4 * fq) = w;
    }
    sum += __shfl_xor(sum, 16); sum += __shfl_xor(sum, 32);
    LDS_WAIT();
    f32x4 O[4];
#pragma unroll
    for (int dt = 0; dt < 4; ++dt) O[dt] = (f32x4){0.f, 0.f, 0.f, 0.f};
#pragma unroll
    for (int kc = 0; kc < 5; ++kc) {
        if (dead[2 * kc] && dead[2 * kc + 1]) continue;
        const bf16x8 pb = *(const LAS bf16x8*)(Ps + fr * 168 + 32 * kc + fq * 8);
#pragma unroll
        for (int dt = 0; dt < 4; ++dt) { const bf16x8 va = *(const LAS bf16x8*)(Vt + fr * 264 + 8 * (fr >> 3) + start + fq * 8 + dt * (16 * 264 + 16) + 32 * kc); O[dt] = MFMA16(va, pb, O[dt]); }
    }
    const float inv = __builtin_amdgcn_rcpf(sum);
    const size_t trow = rowbase + (size_t)posq;
    bf16_t* op = OP + ((size_t)p * T + trow) * 512 + h * 64 + 4 * fq;
#pragma unroll
    for (int dt = 0; dt < 4; ++dt) { u32x2 w; w.x = pk2(O[dt][0] * inv, O[dt][1] * inv); w.y = pk2(O[dt][2] * inv, O[dt][3] * inv); *(u32x2*)(op + 16 * dt) = w; }
    if (fq == 0) LSE[((size_t)p * T + trow) * 8 + h] = (m + __builtin_amdgcn_logf(sum)) * LN2;
}
constexpr int ATT_TK = 4;
__device__ __forceinline__ void attn_loop(LAS unsigned char* lds, const bf16_t* Z, bf16_t* OP, float* LSE, const float* gq, const float* gk, unsigned* ctr, int tid) {
    LAS int* sh = (LAS int*)(lds + LDS_BYTES - 64);
    __syncthreads();
    if (tid == 0) { const int a0 = (int)__hip_atomic_fetch_add(ctr, 1u, __ATOMIC_RELAXED, __HIP_MEMORY_SCOPE_AGENT), a1 = (int)__hip_atomic_fetch_add(ctr, 1u, __ATOMIC_RELAXED, __HIP_MEMORY_SCOPE_AGENT); sh[0] = a0; sh[1] = a1; }
    __syncthreads();
    int u_cur = ATT_TK * __builtin_amdgcn_readfirstlane(sh[0]), tk_nxt = __builtin_amdgcn_readfirstlane(sh[1]), tk_nn = 0;
    __syncthreads();
    AttnRegs R;
    if (u_cur < N_ATT_UNITS) { const AttnU U = attn_decode(u_cur); attn_load(R, Z, U, tid); }
    while (u_cur < N_ATT_UNITS) {
        const bool first = (u_cur % ATT_TK) == 0, last = (u_cur % ATT_TK) == ATT_TK - 1;
        const int u_nxt = last ? ATT_TK * tk_nxt : u_cur + 1;
        const AttnU U = attn_decode(u_cur);
        bf16x8 Q0, Q1;
        attn_stage(lds, R, gq, gk, tid, Q0, Q1);
        int nn = 0;
        if (first && tid == 0) nn = (int)__hip_atomic_fetch_add(ctr, 1u, __ATOMIC_RELAXED, __HIP_MEMORY_SCOPE_AGENT);
        if (u_nxt < N_ATT_UNITS) { const AttnU Un = attn_decode(u_nxt); attn_load(R, Z, Un, tid); }
        LDS_BARRIER();
        attn_compute(lds, U, Q0, Q1, OP, LSE, tid);
        if (first && tid == 0) sh[0] = nn;
        LDS_BARRIER();
        if (first) tk_nn = __builtin_amdgcn_readfirstlane(sh[0]);
        if (last) tk_nxt = tk_nn;
        u_cur = u_nxt;
    }
}

__device__ __forceinline__ void hgrn_unit(LAS unsigned char* lds, const bf16_t* Z, bf16_t* YM, const float* hg_lb, const float* gon, int layer, int u, int tid) {
    const int wave = __builtin_amdgcn_readfirstlane(tid >> 6), lane = tid & 63, fr = lane & 15, fq = lane >> 4;
    const int b = u >> 2, hh = u & 3, tt = tid >> 4, kg = (tid & 15) * 8;
    LAS float*  LG  = (LAS float*)lds;
    LAS bf16_t* QdS = (LAS bf16_t*)(lds + 16384);
    LAS bf16_t* KdS = (LAS bf16_t*)(lds + 25088);
    LAS bf16_t* QeS = (LAS bf16_t*)(lds + 33792);
    LAS bf16_t* KlT = (LAS bf16_t*)(lds + 42496);
    LAS bf16_t* iT  = (LAS bf16_t*)(lds + 52736);
    LAS bf16_t* ScS = (LAS bf16_t*)(lds + 62976);
    LAS bf16_t* StS = (LAS bf16_t*)(lds + 65536);
    LAS float*  DEC = (LAS float*)(lds + 100352);
    LAS float*  OS  = (LAS float*)(lds + 100864);
    LAS float*  LBS = (LAS float*)(lds + 117760);
    LAS float*  GOS = (LAS float*)(lds + 118272);
    if (tid < 128) { const int c = hh * 128 + tid; LBS[tid] = layer == 0 ? 0.f : 1.0f / (1.0f + __expf(hg_lb[c] - hg_lb[512 + c])); GOS[tid] = gon[c]; }
    for (int i = tid; i < 34816 / 4; i += 512) ((LAS unsigned*)(lds + 65536))[i] = 0u;
    f32x4 St[8];
#pragma unroll
    for (int kt = 0; kt < 8; ++kt) St[kt] = (f32x4){0.f, 0.f, 0.f, 0.f};
    __syncthreads();
    const bf16_t* zb = Z + ((size_t)b * SEQ) * ZW + hh * 128 + kg;
    u32x4 nq, nf, ni, ng;
    { const bf16_t* zr = zb + (size_t)tt * ZW; nq = *(const u32x4*)(zr + 1536); nf = *(const u32x4*)(zr + 2048); ni = *(const u32x4*)(zr + 2560); ng = *(const u32x4*)(zr + 3072); }
    for (int c = 0; c < 64; ++c) {
        const u32x4 cq = nq, cf = nf, ci = ni, cgt = ng;
        if (c + 1 < 64) { const bf16_t* zr = zb + (size_t)((c + 1) * 32 + tt) * ZW; nq = *(const u32x4*)(zr + 1536); nf = *(const u32x4*)(zr + 2048); ni = *(const u32x4*)(zr + 2560); ng = *(const u32x4*)(zr + 3072); }
        float qs[8], kk[8], bc[8];
        { float qv[8], fv[8]; unpack8(cq, qv); unpack8(cf, fv);
          const f32x4 lb0 = *(const LAS f32x4*)(LBS + kg), lb1 = *(const LAS f32x4*)(LBS + kg + 4);
          const float lbv[8] = {lb0.x, lb0.y, lb0.z, lb0.w, lb1.x, lb1.y, lb1.z, lb1.w};
#pragma unroll
          for (int e = 0; e < 8; ++e) {
              qs[e] = qv[e] * __builtin_amdgcn_rcpf(1.0f + __expf(-qv[e]));
              const float ef = __expf(-fv[e]), sg = __builtin_amdgcn_rcpf(1.0f + ef);
              const float f = lbv[e] + (1.0f - lbv[e]) * sg;
              float v = __logf(fmaxf(f, 1e-12f));
              kk[e] = (1.0f - lbv[e]) * ef * sg;
              const float x1 = __shfl_up(v, 16); if (fq >= 1) v += x1;
              const float x2 = __shfl_up(v, 32); if (fq >= 2) v += x2;
              bc[e] = v;
          } }
        if (fq == 3) { *(LAS f32x4*)(LG + wave * 128 + kg) = (f32x4){bc[0], bc[1], bc[2], bc[3]}; *(LAS f32x4*)(LG + wave * 128 + kg + 4) = (f32x4){bc[4], bc[5], bc[6], bc[7]}; }
        LDS_BARRIER();
        float bl[8], br[8];
#pragma unroll
        for (int e = 0; e < 8; ++e) { bl[e] = 0.f; br[e] = 0.f; }
#pragma unroll 1
        for (int w2 = 0; w2 < 8; ++w2) {
            const f32x4 v0 = *(const LAS f32x4*)(LG + w2 * 128 + kg), v1 = *(const LAS f32x4*)(LG + w2 * 128 + kg + 4);
            const float vv[8] = {v0.x, v0.y, v0.z, v0.w, v1.x, v1.y, v1.z, v1.w};
            const float inc = w2 < wave ? 1.f : 0.f;
#pragma unroll
            for (int e = 0; e < 8; ++e) { bl[e] += vv[e]; bc[e] += inc * vv[e]; }
            if (w2 == 3) {
#pragma unroll
                for (int e = 0; e < 8; ++e) br[e] = bl[e];
            }
        }
        {
            float qd[8], kd[8], qe[8], kl[8];
#pragma unroll
            for (int e = 0; e < 8; ++e) { qd[e] = qs[e] * __expf(bc[e] - br[e]); kd[e] = kk[e] * __expf(br[e] - bc[e]); qe[e] = qs[e] * __expf(bc[e]); kl[e] = kk[e] * __expf(bl[e] - bc[e]); }
            *(LAS u32x4*)(QdS + tt * 136 + kg) = pack8(qd);
            *(LAS u32x4*)(KdS + tt * 136 + kg) = pack8(kd);
            *(LAS u32x4*)(QeS + tt * 136 + kg) = pack8(qe);
            const u32x4 klw = pack8(kl);
            const int tsw = (((tt >> 3) ^ ((kg >> 3) & 3)) << 3) | (tt & 7);
            LAS bf16_t* kp = KlT + kg * 40 + tsw; LAS bf16_t* ip = iT + kg * 40 + tsw;
            kp[0 * 40] = (bf16_t)(klw.x & 0xffffu); kp[1 * 40] = (bf16_t)(klw.x >> 16); kp[2 * 40] = (bf16_t)(klw.y & 0xffffu); kp[3 * 40] = (bf16_t)(klw.y >> 16);
            kp[4 * 40] = (bf16_t)(klw.z & 0xffffu); kp[5 * 40] = (bf16_t)(klw.z >> 16); kp[6 * 40] = (bf16_t)(klw.w & 0xffffu); kp[7 * 40] = (bf16_t)(klw.w >> 16);
            ip[0 * 40] = (bf16_t)(ci.x & 0xffffu); ip[1 * 40] = (bf16_t)(ci.x >> 16); ip[2 * 40] = (bf16_t)(ci.y & 0xffffu); ip[3 * 40] = (bf16_t)(ci.y >> 16);
            ip[4 * 40] = (bf16_t)(ci.z & 0xffffu); ip[5 * 40] = (bf16_t)(ci.z >> 16); ip[6 * 40] = (bf16_t)(ci.w & 0xffffu); ip[7 * 40] = (bf16_t)(ci.w >> 16);
            if (tt == 0) { *(LAS f32x4*)(DEC + kg) = (f32x4){__expf(bl[0]), __expf(bl[1]), __expf(bl[2]), __expf(bl[3])}; *(LAS f32x4*)(DEC + kg + 4) = (f32x4){__expf(bl[4]), __expf(bl[5]), __expf(bl[6]), __expf(bl[7])}; }
        }
        LDS_BARRIER();
        if (wave < 4) {
            const int tr = wave >> 1, sc = wave & 1;
            f32x4 acc = (f32x4){0.f, 0.f, 0.f, 0.f};
#pragma unroll
            for (int ks = 0; ks < 4; ++ks) { const bf16x8 a = *(const LAS bf16x8*)(QdS + (16 * tr + fr) * 136 + 32 * ks + fq * 8), bb = *(const LAS bf16x8*)(KdS + (16 * sc + fr) * 136 + 32 * ks + fq * 8); acc = MFMA16(a, bb, acc); }
#pragma unroll
            for (int j = 0; j < 4; ++j) { const int t = 16 * tr + 4 * fq + j, s = 16 * sc + fr; ScS[t * 40 + s] = (bf16_t)f2bf(s <= t ? acc[j] : 0.f); }
        }
        f32x4 o0 = (f32x4){0.f, 0.f, 0.f, 0.f}, o1 = (f32x4){0.f, 0.f, 0.f, 0.f};
#pragma unroll
        for (int ks = 0; ks < 4; ++ks) {
            const bf16x8 bb = *(const LAS bf16x8*)(StS + (16 * wave + fr) * 136 + 32 * ks + fq * 8);
            const bf16x8 a0 = *(const LAS bf16x8*)(QeS + fr * 136 + 32 * ks + fq * 8), a1 = *(const LAS bf16x8*)(QeS + (16 + fr) * 136 + 32 * ks + fq * 8);
            o0 = MFMA16(a0, bb, o0); o1 = MFMA16(a1, bb, o1);
        }
        LDS_BARRIER();
        {
            const bf16x8 bb = *(const LAS bf16x8*)(iT + (16 * wave + fr) * 40 + ((fq ^ (((16 * wave + fr) >> 3) & 3)) << 3));
            const bf16x8 a0 = *(const LAS bf16x8*)(ScS + fr * 40 + fq * 8), a1 = *(const LAS bf16x8*)(ScS + (16 + fr) * 40 + fq * 8);
            o0 = MFMA16(a0, bb, o0); o1 = MFMA16(a1, bb, o1);
#pragma unroll
            for (int j = 0; j < 4; ++j) { OS[(4 * fq + j) * 132 + 16 * wave + fr] = o0[j]; OS[(16 + 4 * fq + j) * 132 + 16 * wave + fr] = o1[j]; }
#pragma unroll
            for (int kt = 0; kt < 8; ++kt) {
                const bf16x8 a = *(const LAS bf16x8*)(KlT + (16 * kt + fr) * 40 + ((fq ^ (((16 * kt + fr) >> 3) & 3)) << 3));
                const f32x4 dec = *(const LAS f32x4*)(DEC + 16 * kt + 4 * fq);
                f32x4 sv = St[kt] * dec; sv = MFMA16(a, bb, sv); St[kt] = sv;
                u32x2 w; w.x = pk2(sv[0], sv[1]); w.y = pk2(sv[2], sv[3]);
                *(LAS u32x2*)(StS + (16 * wave + fr) * 136 + 16 * kt + 4 * fq) = w;
            }
        }
        LDS_BARRIER();
        {
            const f32x4 x0 = *(const LAS f32x4*)(OS + tt * 132 + kg), x1 = *(const LAS f32x4*)(OS + tt * 132 + kg + 4);
            float ov[8] = {x0.x, x0.y, x0.z, x0.w, x1.x, x1.y, x1.z, x1.w};
            float ss = 0.f;
#pragma unroll
            for (int e = 0; e < 8; ++e) ss += ov[e] * ov[e];
            ss = sum16_dpp(ss);
            const float rstd = __builtin_amdgcn_rsqf(ss * (1.f / 128.f) + EPS);
            float gv[8]; unpack8(cgt, gv);
            const f32x4 go0 = *(const LAS f32x4*)(GOS + kg), go1 = *(const LAS f32x4*)(GOS + kg + 4);
            const float gov[8] = {go0.x, go0.y, go0.z, go0.w, go1.x, go1.y, go1.z, go1.w};
#pragma unroll
            for (int e = 0; e < 8; ++e) ov[e] = ov[e] * rstd * gov[e] * (gv[e] * __builtin_amdgcn_rcpf(1.0f + __expf(-gv[e])));
            *(u32x4*)(YM + ((size_t)b * SEQ + c * 32 + tt) * 1024 + 512 + hh * 128 + kg) = pack8(ov);
        }
    }
    __syncthreads();
}

__device__ __forceinline__ void xattn_ld(u32x4 (&pre)[8], const bf16_t* src, int tid) {
#pragma unroll
    for (int it = 0; it < 8; ++it) { const int c = tid + 512 * it, row = c >> 5, ch = c & 31; pre[it] = *(const u32x4*)(src + row * 256 + ch * 8); }
}
__device__ __forceinline__ void xattn_st(LAS bf16_t* dst, const u32x4 (&pre)[8], int tid) {
    int t_ = tid; asm volatile("" : "+v"(t_));
    LAS bf16_t* p = dst + (t_ >> 5) * 264 + (t_ & 31) * 8;
#pragma unroll
    for (int it = 0; it < 8; ++it) *(LAS u32x4*)(p + it * (16 * 264)) = pre[it];
}
__device__ __forceinline__ void xattn_q_frags(bf16x8 (&Q)[8], const bf16_t* qp, const float* gmq, int fq) {
    u32x4 qw[8]; float ss = 0.f;
#pragma unroll
    for (int ks = 0; ks < 8; ++ks) { qw[ks] = *(const u32x4*)(qp + 32 * ks); float f[8]; unpack8(qw[ks], f);
#pragma unroll
        for (int e = 0; e < 8; ++e) ss += f[e] * f[e]; }
    ss += __shfl_xor(ss, 16); ss += __shfl_xor(ss, 32);
    const float sc = __builtin_amdgcn_rsqf(ss * (1.f / 256.f) + EPS) * (0.0625f * LOG2E);
#pragma unroll
    for (int ks = 0; ks < 8; ++ks) { float f[8]; unpack8(qw[ks], f); const f32x4 g0 = *(const f32x4*)(gmq + 32 * ks + fq * 8), g1 = *(const f32x4*)(gmq + 32 * ks + fq * 8 + 4);
        f[0] *= sc * g0.x; f[1] *= sc * g0.y; f[2] *= sc * g0.z; f[3] *= sc * g0.w; f[4] *= sc * g1.x; f[5] *= sc * g1.y; f[6] *= sc * g1.z; f[7] *= sc * g1.w;
        Q[ks] = __builtin_bit_cast(bf16x8, pack8(f)); }
}
template <bool FIRST>
__device__ __forceinline__ void xattn_sp_stage(bf16x8 (&P0)[4], bf16x8 (&P1)[4], float& sum0, float& sum1, float& m0, float& m1, const LAS bf16_t* SB, const bf16x8 (&Q0)[8], const bf16x8 (&Q1)[8], int fr, int fq) {
#pragma unroll
    for (int kc = 0; kc < 4; ++kc) {
        f32x4 a00 = (f32x4){0.f, 0.f, 0.f, 0.f}, a01 = a00, a10 = a00, a11 = a00;
#pragma unroll
        for (int ks = 0; ks < 8; ++ks) {
            const bf16x8 ka = *(const LAS bf16x8*)(SB + (32 * kc + fr) * 264 + 32 * ks + fq * 8), kb = *(const LAS bf16x8*)(SB + (32 * kc + 16 + fr) * 264 + 32 * ks + fq * 8);
            a00 = MFMA16(ka, Q0[ks], a00); a10 = MFMA16(ka, Q1[ks], a10); a01 = MFMA16(kb, Q0[ks], a01); a11 = MFMA16(kb, Q1[ks], a11);
        }
        if (FIRST && kc == 0) {
            float x0 = fmaxf(fmaxf(a00[0], a00[1]), fmaxf(a00[2], a00[3])), x1 = fmaxf(fmaxf(a10[0], a10[1]), fmaxf(a10[2], a10[3]));
            x0 = fmaxf(x0, __shfl_xor(x0, 16)); x0 = fmaxf(x0, __shfl_xor(x0, 32)); x1 = fmaxf(x1, __shfl_xor(x1, 16)); x1 = fmaxf(x1, __shfl_xor(x1, 32));
            m0 = x0; m1 = x1;
        }
        float pe[8], pf[8];
#pragma unroll
        for (int j = 0; j < 4; ++j) { pe[j] = __builtin_amdgcn_exp2f(a00[j] - m0); pe[4 + j] = __builtin_amdgcn_exp2f(a01[j] - m0); pf[j] = __builtin_amdgcn_exp2f(a10[j] - m1); pf[4 + j] = __builtin_amdgcn_exp2f(a11[j] - m1); }
#pragma unroll
        for (int e = 0; e < 8; ++e) { sum0 += pe[e]; sum1 += pf[e]; }
        P0[kc] = __builtin_bit_cast(bf16x8, pack8(pe)); P1[kc] = __builtin_bit_cast(bf16x8, pack8(pf));
        asm volatile("" ::: "memory");
    }
}
__device__ __forceinline__ void xattn_pv_stage(const LAS bf16_t* SB, const bf16x8 (&P0a)[4], const bf16x8 (&P0b)[4], const bf16x8 (&P1a)[4], const bf16x8 (&P1b)[4], float inv0, float inv1, bf16_t* o0, bf16_t* o1, int fr, int fq) {
    f32x4 O0[8], O1[8];
#pragma unroll
    for (int dt = 0; dt < 8; ++dt) { O0[dt] = (f32x4){0.f, 0.f, 0.f, 0.f}; O1[dt] = (f32x4){0.f, 0.f, 0.f, 0.f}; }
#pragma unroll
    for (int kc = 0; kc < 8; ++kc) {
        const bf16x8 p0 = kc < 4 ? P0a[kc & 3] : P0b[kc & 3], p1 = kc < 4 ? P1a[kc & 3] : P1b[kc & 3];
#pragma unroll
        for (int dt = 0; dt < 8; ++dt) {
            const LAS bf16_t* vp = SB + (16 * dt + fr) * 264 + 32 * kc + 4 * fq;
            const u32x2 lo = *(const LAS u32x2*)vp, hi = *(const LAS u32x2*)(vp + 16);
            const u32x4 w = (u32x4){lo.x, lo.y, hi.x, hi.y};
            const bf16x8 va = __builtin_bit_cast(bf16x8, w);
            O0[dt] = MFMA16(va, p0, O0[dt]); O1[dt] = MFMA16(va, p1, O1[dt]);
            if (dt == 7) asm volatile("" ::: "memory");
        }
    }
#pragma unroll
    for (int dt = 0; dt < 8; ++dt) {
        u32x2 w; w.x = pk2(O0[dt][0] * inv0, O0[dt][1] * inv0); w.y = pk2(O0[dt][2] * inv0, O0[dt][3] * inv0); *(u32x2*)(o0 + 16 * dt) = w;
        u32x2 v; v.x = pk2(O1[dt][0] * inv1, O1[dt][1] * inv1); v.y = pk2(O1[dt][2] * inv1, O1[dt][3] * inv1); *(u32x2*)(o1 + 16 * dt) = v;
    }
}
__device__ __forceinline__ void xattn_phase(LAS unsigned char* lds, const bf16_t* QM, const bf16_t* KM, const bf16_t* VT, bf16_t* OM, const float* gmq, int bid, int G, int tid0) {
    const int wave = __builtin_amdgcn_readfirstlane(tid0 >> 6);
    LAS bf16_t* SB0 = (LAS bf16_t*)lds; LAS bf16_t* SB1 = (LAS bf16_t*)(lds + 67584);
    if (bid >= 1024) return;
    u32x4 pre[8];
    { const int u0 = bid; xattn_ld(pre, KM + (size_t)((u0 >> 5) * 4 + ((u0 >> 3) & 3)) * 65536, tid0); }
    for (int u = bid; u < 1024; u += G) {
        int tid_ = tid0; asm volatile("" : "+v"(tid_));
        const int tid = tid_, lane = tid & 63, fr = lane & 15, fq = lane >> 4;
        const int b = u >> 5, h = (u >> 3) & 3, qb = u & 7;
        const bf16_t* KMp = KM + (size_t)(b * 4 + h) * 65536; const bf16_t* VTp = VT + (size_t)(b * 4 + h) * 65536;
        const size_t trow = (size_t)b * SEQ + qb * 256 + 32 * wave + fr;
        xattn_st(SB0, pre, tid);
        bf16x8 Q0[8], Q1[8];
        xattn_q_frags(Q0, QM + trow * 1024 + h * 256 + fq * 8, gmq, fq);
        asm volatile("" ::: "memory");
        xattn_q_frags(Q1, QM + (trow + 16) * 1024 + h * 256 + fq * 8, gmq, fq);
        bf16x8 P0a[4], P0b[4], P1a[4], P1b[4];
        float m0, m1, sum0, sum1;
        LDS_BARRIER();
        m0 = 0.f; m1 = 0.f; sum0 = 0.f; sum1 = 0.f;
        xattn_sp_stage<true>(P0a, P1a, sum0, sum1, m0, m1, SB0, Q0, Q1, fr, fq);
        { u32x4 t1[8]; xattn_ld(t1, KMp + 128 * 256, tid); xattn_st(SB1, t1, tid); } LDS_BARRIER();
        xattn_sp_stage<false>(P0b, P1b, sum0, sum1, m0, m1, SB1, Q0, Q1, fr, fq);
        sum0 += __shfl_xor(sum0, 16); sum0 += __shfl_xor(sum0, 32); sum1 += __shfl_xor(sum1, 16); sum1 += __shfl_xor(sum1, 32);
        const float inv0 = __builtin_amdgcn_rcpf(sum0), inv1 = __builtin_amdgcn_rcpf(sum1);
        bf16_t* o0 = OM + trow * 1024 + h * 256 + 4 * fq; bf16_t* o1 = o0 + 16 * 1024;
        { u32x4 t2[8]; xattn_ld(t2, VTp, tid); xattn_st(SB0, t2, tid); } xattn_ld(pre, VTp + 128 * 256, tid); LDS_BARRIER();
        xattn_pv_stage(SB0, P0a, P0b, P1a, P1b, inv0, inv1, o0, o1, fr, fq);
        xattn_st(SB1, pre, tid);
        { const int un = u + G; if (un < 1024) xattn_ld(pre, KM + (size_t)((un >> 5) * 4 + ((un >> 3) & 3)) * 65536, tid); }
        LDS_BARRIER();
        xattn_pv_stage(SB1, P0a, P0b, P1a, P1b, inv0, inv1, o0 + 128, o1 + 128, fr, fq);
    }
}

#define XB_TMO      128
#define XB_XCNT(j)  (256  + 64 * (j))
#define XB_XSUB(j)  (1280 + 64 * (j))
#define XB_XGEN(j)  (2304 + 64 * (j))
#define XB_TOP      3328
#define XB_TOPGEN   3392
#define XCD_BAR_WORDS 3456
#define XB_SPIN_CAP (1u << 18)

__device__ __forceinline__ unsigned xb_ld(unsigned* p)              { return __hip_atomic_load(p, __ATOMIC_RELAXED, __HIP_MEMORY_SCOPE_AGENT); }
__device__ __forceinline__ unsigned xb_add(unsigned* p, unsigned v) { return __hip_atomic_fetch_add(p, v, __ATOMIC_RELAXED, __HIP_MEMORY_SCOPE_AGENT); }
__device__ __forceinline__ unsigned xb_xcc_id() { return (unsigned)__builtin_amdgcn_s_getreg((3 << 11) | 20) & 0xFu; }
#define XB_SPIN(cond, bar) do { unsigned _sp = 0; while (cond) { __builtin_amdgcn_s_sleep(1); \
    if ((++_sp & 255u) == 0u) { if (xb_ld(&(bar)[XB_TMO])) break; if (_sp > XB_SPIN_CAP) { atomicAdd(&(bar)[XB_TMO], 1u); break; } } } } while (0)

struct XcdBarrier {
    unsigned* bar; unsigned x;
    volatile LAS unsigned* st;
};

__device__ __forceinline__ XcdBarrier xcd_barrier_post(unsigned* bar, volatile LAS unsigned* st) {
    XcdBarrier b; b.bar = bar; b.x = xb_xcc_id(); b.st = st;
    if (threadIdx.x == 0) (void)xb_add(&bar[XB_XCNT(b.x)], 1u);
    return b;
}
__device__ __forceinline__ void xcd_barrier_complete(unsigned* bar, unsigned x, unsigned& nloc, unsigned& nx) {
    const unsigned G = gridDim.x * gridDim.y * gridDim.z;
    unsigned sum, cnt, mine, sp = 0u;
    for (;;) {
        sum = 0u; cnt = 0u; mine = 0u;
#pragma unroll
        for (unsigned j = 0; j < 16; ++j) { const unsigned c = xb_ld(&bar[XB_XCNT(j)]); sum += c; cnt += (c > 0u) ? 1u : 0u; mine = (j == x) ? c : mine; }
        if (sum == G) break;
        __builtin_amdgcn_s_sleep(1);
        if ((++sp & 255u) == 0u) { if (xb_ld(&bar[XB_TMO])) break; if (sp > XB_SPIN_CAP) { atomicAdd(&bar[XB_TMO], 1u); break; } }
    }
    nloc = mine > 0u ? mine : 1u; nx = cnt > 0u ? cnt : 1u;
}

__device__ __forceinline__ void xcd_barrier(const XcdBarrier& b) {
    asm volatile("s_waitcnt vmcnt(0)" ::: "memory");
    __syncthreads();
    if (threadIdx.x == 0) {
        unsigned* bar = b.bar;
        __builtin_amdgcn_s_waitcnt(0);
        unsigned nloc = b.st[0], nx = b.st[1];
        if (nloc == 0u) { xcd_barrier_complete(bar, b.x, nloc, nx); b.st[0] = nloc; b.st[1] = nx; }
        const unsigned old = xb_add(&bar[XB_XSUB(b.x)], 1u);
        const unsigned gen = old / nloc;
        if (old + 1u == (gen + 1u) * nloc) {
            __builtin_amdgcn_fence(__ATOMIC_RELEASE, "agent");
            asm volatile("s_waitcnt vmcnt(0)" ::: "memory");
            const unsigned og = xb_add(&bar[XB_TOP], 1u);
            const unsigned tg = og / nx;
            if (og + 1u == (tg + 1u) * nx) xb_add(&bar[XB_TOPGEN], 1u);
            else XB_SPIN(xb_ld(&bar[XB_TOPGEN]) == tg, bar);
            __builtin_amdgcn_fence(__ATOMIC_ACQUIRE, "agent");
            xb_add(&bar[XB_XGEN(b.x)], 1u);
            asm volatile("s_waitcnt vmcnt(0)" ::: "memory");
        } else {
            XB_SPIN(xb_ld(&bar[XB_XGEN(b.x)]) == gen, bar);
            __builtin_amdgcn_fence(__ATOMIC_ACQUIRE, "agent");
            asm volatile("s_waitcnt vmcnt(0)" ::: "memory");
        }
    }
    __syncthreads();
}

constexpr int N_PHASES = 4 + 18;
__global__ void __launch_bounds__(512, 2) mega_fwd(Params P) {
    extern __shared__ __attribute__((aligned(16))) unsigned char smem[];
    LAS unsigned char* lds = (LAS unsigned char*)smem;
    cg::grid_group grid = cg::this_grid();
    if (threadIdx.x < 8) ((LAS unsigned*)(lds + LDS_BYTES - 32))[threadIdx.x] = 0u;
    __syncthreads();
    const XcdBarrier xbar = xcd_barrier_post((unsigned*)(P.ws + WS_CTL) + CW_BAR, (volatile LAS unsigned*)(lds + LDS_BYTES - 32));
    grid.sync();
    for (int ph = 0; ph < N_PHASES; ++ph) {
        int tid_ = threadIdx.x, bid_ = blockIdx.x; asm volatile("" : "+v"(tid_)); asm volatile("" : "+s"(bid_));
        const int tid = tid_, bid = bid_, lane = tid & 63, wave = __builtin_amdgcn_readfirstlane(tid >> 6);
        const int G = gridDim.x, gw = bid * 8 + wave, NGW = G * 8;
        const int gtid = bid * 512 + tid, NGT = G * 512;
        unsigned char* ws = P.ws;
        bf16_t* Xb = (bf16_t*)(ws + WS_H); bf16_t* ZU = (bf16_t*)(ws + WS_ZU); bf16_t* YM = (bf16_t*)(ws + WS_YM); bf16_t* QM = (bf16_t*)(ws + WS_QM);
        bf16_t* OP = (bf16_t*)((unsigned char*)P.out + OUT_OP); float* LSE = (float*)((unsigned char*)P.out + OUT_LSE);
        bf16_t* MN = (bf16_t*)(ws + WS_MN); bf16_t* KVT = (bf16_t*)(ws + WS_KVT);
        const float* x_in = P.in[0]; float* X = P.out;
        bool is_gemm = false;
        pg8::Gemm gj{nullptr, nullptr, 0, 0, 0};
        pg8::EpiDyn E{0, true, nullptr, 0, nullptr, nullptr, nullptr};
        float* SS = (float*)(ws + WS_SS);
        if (ph == 0) {
            LAS float* scr = (LAS float*)(lds + wave * 16384);
            constexpr int NI_IN = 16 * 112, NI_SQ = 16 * 32, NI_MKV = 16 * 64, NI_FF1 = 16 * 128, NI_FF2 = 64 * 32;
            constexpr int NI_LAYER = NI_IN + 3 * NI_SQ + NI_MKV + NI_FF1 + NI_FF2;
            for (int it = gw; it < 2 * NI_LAYER; it += NGW) {
                const int l = it / NI_LAYER; int r = it % NI_LAYER;
                unsigned char* wb = ws + WS_WB + (size_t)l * WB_LAYER;
                if (r < NI_IN) { transpose_item(P.in[3] + (size_t)l * 1024 * 3584, 1024, 3584, (bf16_t*)(wb + WB_IN), scr, r, lane, P.in[2] + l * 1024); continue; } r -= NI_IN;
                if (r < NI_SQ) { transpose_item(P.in[8] + (size_t)l * 1024 * 1024, 1024, 1024, (bf16_t*)(wb + WB_OUT), scr, r, lane); continue; } r -= NI_SQ;
                if (r < NI_SQ) { transpose_item(P.in[11] + (size_t)l * 1024 * 1024, 1024, 1024, (bf16_t*)(wb + WB_MQ), scr, r, lane, P.in[9] + l * 1024); continue; } r -= NI_SQ;
                if (r < NI_MKV) { transpose_item(P.in[12] + (size_t)l * 1024 * 2048, 1024, 2048, (bf16_t*)(wb + WB_MKV), scr, r, lane); continue; } r -= NI_MKV;
                if (r < NI_SQ) { transpose_item(P.in[15] + (size_t)l * 1024 * 1024, 1024, 1024, (bf16_t*)(wb + WB_MO), scr, r, lane); continue; } r -= NI_SQ;
                if (r < NI_FF1) { transpose_item(P.in[17] + (size_t)l * 1024 * 4096, 1024, 4096, (bf16_t*)(wb + WB_FF1), scr, r, lane, P.in[16] + l * 1024); continue; } r -= NI_FF1;
                transpose_item(P.in[18] + (size_t)l * 4096 * 1024, 4096, 1024, (bf16_t*)(wb + WB_FF2), scr, r, lane);
            }
            for (int it = gw; it < 2 * NMEMROWS; it += NGW) { const int l = it / NMEMROWS, row = it % NMEMROWS; rms_row_1024(P.in[1] + (size_t)row * 1024, P.in[10] + l * 1024, MN + ((size_t)l * NMEMROWS + row) * 1024, lane); }
            for (int row = gw; row < T; row += NGW) prep_row_1024(x_in + (size_t)row * 1024, Xb + (size_t)row * 1024, SS + row, lane);
        } else if (ph <= 2) {
            const int l = ph - 1;
            gj = pg8::Gemm{MN + (size_t)l * NMEMROWS * 1024, (const bf16_t*)(ws + WS_WB + (size_t)l * WB_LAYER + WB_MKV), NMEMROWS, 2048, 1024};
            E = pg8::EpiDyn{0, true, KVT + (size_t)l * NMEMROWS * 2048, 2048, nullptr, nullptr, nullptr, nullptr, 0};
            is_gemm = true;
        } else if (ph == 3) {
            for (int it = gw; it < 2 * NMEMROWS * 4; it += NGW) {
                const int l = it / (NMEMROWS * 4), rem = it % (NMEMROWS * 4), row = rem >> 2, h = rem & 3;
                const bf16_t* src = KVT + ((size_t)l * NMEMROWS + row) * 2048 + h * 256 + lane * 4;
                const u32x2 w = *(const u32x2*)src;
                float f0 = bflo(w.x), f1 = bfhi(w.x), f2 = bflo(w.y), f3 = bfhi(w.y);
                const float rstd = 1.0f / sqrtf(wave_sum(f0 * f0 + f1 * f1 + f2 * f2 + f3 * f3) * (1.f / 256.f) + EPS);
                const f32x4 gv = *(const f32x4*)(P.in[14] + l * 256 + lane * 4);
                u32x2 o; o.x = pk2(f0 * rstd * gv.x, f1 * rstd * gv.y); o.y = pk2(f2 * rstd * gv.z, f3 * rstd * gv.w);
                bf16_t* dst = (bf16_t*)(ws + WS_KM + (size_t)l * KM_LAYER) + ((size_t)((row >> 8) * 4 + h) * 256 + (row & 255)) * 256 + lane * 4;
                *(u32x2*)dst = o;
            }
            for (int it = gtid; it < 2 * 32 * 4 * 32 * 256; it += NGT) {
                const int dd = it & 255, mg = (it >> 8) & 31, h = (it >> 13) & 3, b = (it >> 15) & 31, l = it >> 20;
                const bf16_t* src = KVT + ((size_t)l * NMEMROWS + b * 256 + mg * 8) * 2048 + 1024 + h * 256 + dd;
                u32x4 o;
                o.x = (unsigned)src[0 * 2048] | ((unsigned)src[1 * 2048] << 16); o.y = (unsigned)src[2 * 2048] | ((unsigned)src[3 * 2048] << 16);
                o.z = (unsigned)src[4 * 2048] | ((unsigned)src[5 * 2048] << 16); o.w = (unsigned)src[6 * 2048] | ((unsigned)src[7 * 2048] << 16);
                bf16_t* dst = (bf16_t*)(ws + WS_KM + (size_t)l * KM_LAYER + VT_OFF) + ((size_t)(b * 4 + h) * 256 + dd) * 256 + mg * 8;
                *(u32x4*)dst = o;
            }
        } else {
            const int l = (ph - 4) / 9, k = (ph - 4) % 9;
            const unsigned char* wb = ws + WS_WB + (size_t)l * WB_LAYER;
            const float* xcur = (l == 0) ? x_in : X;
            float* ssl = SS + (size_t)(3 * l) * T;
            if (k == 0) {
                gj = pg8::Gemm{Xb, (const bf16_t*)(wb + WB_IN), T, ZW, 1024}; E = pg8::EpiDyn{0, true, ZU, ZW, ssl, nullptr, nullptr, nullptr, 0}; is_gemm = true;
            } else if (k == 1) {
#if SKIP_HGRN
                for (int it = gtid; it < T * 64; it += NGT) { const int t = it >> 6, c8 = it & 63; *(u32x4*)(YM + (size_t)t * 1024 + 512 + c8 * 8) = (u32x4){0u, 0u, 0u, 0u}; }
#else
                for (int u = bid; u < 128; u += G) hgrn_unit(lds, ZU, YM, P.in[6], P.in[7] + l * 512, l, u, tid);
#endif
                int tid2 = tid; asm volatile("" : "+v"(tid2));
                if (!SKIP_ATTN) attn_loop(lds, ZU, OP, LSE, P.in[4] + l * 64, P.in[5] + l * 64, (unsigned*)(ws + WS_CTL) + 64 * (1 + l), tid2);
            } else if (k == 2) {
                for (int it = gtid; it < T * 64; it += NGT) {
                    const int t = it >> 6, c8 = it & 63, h = c8 >> 3;
                    if (SKIP_ATTN) { *(u32x4*)(YM + (size_t)t * 1024 + c8 * 8) = (u32x4){0u, 0u, 0u, 0u}; continue; }
                    const float l0 = LSE[((size_t)0 * T + t) * 8 + h], l1 = LSE[((size_t)1 * T + t) * 8 + h], l2 = LSE[((size_t)2 * T + t) * 8 + h];
                    const float mx = fmaxf(l0, fmaxf(l1, l2));
                    float w0 = __expf(l0 - mx), w1 = __expf(l1 - mx), w2 = __expf(l2 - mx);
                    const float inv = 1.0f / (w0 + w1 + w2); w0 *= inv; w1 *= inv; w2 *= inv;
                    float a[8], bq[8], cq[8];
                    unpack8(*(const u32x4*)(OP + ((size_t)0 * T + t) * 512 + c8 * 8), a);
                    unpack8(*(const u32x4*)(OP + ((size_t)1 * T + t) * 512 + c8 * 8), bq);
                    unpack8(*(const u32x4*)(OP + ((size_t)2 * T + t) * 512 + c8 * 8), cq);
#pragma unroll
                    for (int e = 0; e < 8; ++e) a[e] = w0 * a[e] + w1 * bq[e] + w2 * cq[e];
                    *(u32x4*)(YM + (size_t)t * 1024 + c8 * 8) = pack8(a);
                }
            } else if (k == 3) {
                gj = pg8::Gemm{YM, (const bf16_t*)(wb + WB_OUT), T, 1024, 1024}; E = pg8::EpiDyn{1, true, Xb, 1024, nullptr, ssl + T, nullptr, nullptr, 0}; is_gemm = true;
            } else if (k == 4) {
                gj = pg8::Gemm{Xb, (const bf16_t*)(wb + WB_MQ), T, 1024, 1024}; E = pg8::EpiDyn{0, true, QM, 1024, ssl + T, nullptr, nullptr, nullptr, 0}; is_gemm = true;
            } else if (k == 5) {
                const bf16_t* KM = (const bf16_t*)(ws + WS_KM + (size_t)l * KM_LAYER); const bf16_t* VT = (const bf16_t*)(ws + WS_KM + (size_t)l * KM_LAYER + VT_OFF);
#if SKIP_XATTN
                for (int it = gtid; it < T * 128; it += NGT) *(u32x4*)(YM + (size_t)it * 8) = (u32x4){0u, 0u, 0u, 0u};
#else
                xattn_phase(lds, QM, KM, VT, YM, P.in[13] + l * 256, bid, G, tid);
                __syncthreads();
#endif
            } else if (k == 6) {
                gj = pg8::Gemm{YM, (const bf16_t*)(wb + WB_MO), T, 1024, 1024}; E = pg8::EpiDyn{1, true, Xb, 1024, nullptr, ssl + 2 * T, nullptr, nullptr, 0}; is_gemm = true;
            } else if (k == 7) {
                gj = pg8::Gemm{Xb, (const bf16_t*)(wb + WB_FF1), T, DFF, 1024}; E = pg8::EpiDyn{2, true, ZU, DFF, ssl + 2 * T, nullptr, nullptr, nullptr, 0}; is_gemm = true;
            } else {
                gj = pg8::Gemm{ZU, (const bf16_t*)(wb + WB_FF2), T, 1024, DFF};
                E = pg8::EpiDyn{1, true, Xb, 1024, nullptr, l == 0 ? SS + (size_t)3 * T : nullptr, l == 1 ? X : nullptr, nullptr, 0}; is_gemm = true;
            }
        }
        if (is_gemm) {
            pg8::StaticOrder S; S.init(gj.M, gj.N, G, bid);
            if (E.ssin != nullptr) {
                pg8::Unit u0;
                if (S.next(0, u0)) {
                    LAS float* RS = (LAS float*)(lds + 131072);
                    for (int i = tid; i < 2048; i += 512) { const int pmx = u0.pm + 8 * (i >> 8); if (pmx < S.nM) RS[i] = 1.0f / sqrtf(E.ssin[pmx * 256 + (i & 255)] * (1.f / 1024.f) + EPS); }
                    E.rs = RS; E.pm0 = u0.pm;
                }
                __syncthreads();
            }
            pg8::gemm_phase<pg8::EpiDyn, pg8::StaticOrder, true, true>(lds, gj, S, E);
        }
        if (ph + 1 < N_PHASES) {
            asm volatile("s_waitcnt vmcnt(0) lgkmcnt(0)" ::: "memory");
            __syncthreads();
            xcd_barrier(xbar);
        }
    }
}

extern "C" void kernel_launch(void* const* d_in, const int* in_sizes, int n_in, void* d_out, int out_size, void* d_ws, size_t ws_size, hipStream_t stream) {
    static int grid = 0;
    if (grid == 0) {
        if (n_in != 19 || in_sizes[0] != T * DM || out_size != T * DM || ws_size < WS_END) {
            fprintf(stderr, "kernel_launch: unexpected shapes: n_in %d in0 %d out %d ws %zu (need %zu)\n", n_in, n_in > 0 ? in_sizes[0] : -1, out_size, ws_size, (size_t)WS_END);
            grid = -1; return;
        }
        int dev = 0, cus = 0, per_cu = 0;
        hipGetDevice(&dev);
        hipDeviceGetAttribute(&cus, hipDeviceAttributeMultiprocessorCount, dev);
        hipFuncSetAttribute((const void*)mega_fwd, hipFuncAttributeMaxDynamicSharedMemorySize, LDS_BYTES);
        hipOccupancyMaxActiveBlocksPerMultiprocessor(&per_cu, (const void*)mega_fwd, 512, LDS_BYTES);
        if (per_cu < 1) { fprintf(stderr, "kernel_launch: occupancy query returned %d\n", per_cu); per_cu = 1; }
        grid = cus * per_cu;
        (void)hipGetLastError();
    }
    if (grid < 0) return;
    hipMemsetAsync((char*)d_ws + WS_CTL, 0, CTL_BYTES, stream);
    Params p{};
    for (int i = 0; i < 19; ++i) p.in[i] = (const float*)d_in[i];
    p.out = (float*)d_out; p.ws = (unsigned char*)d_ws;
    void* args[] = {&p};
    hipError_t e = hipLaunchCooperativeKernel((const void*)mega_fwd, dim3(grid), dim3(512), args, LDS_BYTES, stream);
    if (e != hipSuccess) fprintf(stderr, "cooperative launch failed: %s (grid %d)\n", hipGetErrorString(e), grid);
}
```

```cpp
#include <hip/hip_runtime.h>
#include <hip/hip_cooperative_groups.h>
#include <cstdio>
#include <cstdint>
namespace cg = cooperative_groups;
namespace pg8 {
#define PG8_LAS __attribute__((address_space(3)))
typedef unsigned short bf16_t;
typedef short bf16x8 __attribute__((ext_vector_type(8)));
typedef float f32x4 __attribute__((ext_vector_type(4)));
typedef unsigned u32x4 __attribute__((ext_vector_type(4)));
constexpr int BM = 256, BK = 64, HALF = 128, HTB = HALF * BK * 2  , STAGE_BYTES = 8 * HTB, NXCD = 8, WGM = 8;

__host__ __device__ __forceinline__ int lds_byte(int r, int c) { const int st = (r >> 4) * 2 + (c >> 5), rr = r & 15, cc = c & 31, ob = rr * 64 + cc * 2; return st * 1024 + (ob ^ (((ob >> 9) & 1) << 5)); }
__host__ __device__ __forceinline__ void stage_rc(int b, int& R, int& C) { const int st = b / 1024, sb = b % 1024, swz = sb ^ (((sb >> 9) & 1) << 5); R = (st >> 1) * 16 + swz / 64; C = (st & 1) * 32 + (swz % 64) / 2; }
__host__ __device__ __forceinline__ int perm32(int rho) { const int n = rho >> 4, i = rho & 15; return 8 * (i >> 2) + 4 * n + (i & 3); }

struct Unit { int pm, pn; };
struct Gemm { const bf16_t* A; const bf16_t* Bt; int M, N, K; };

struct StaticOrder {
    int nM, nN, nwg, G, c;
    __host__ __device__ void init(int M, int N, int G_, int c_) { nM = M / BM; nN = N / BM; nwg = nM * nN; G = G_; c = c_; }
    __host__ __device__ bool next(int i, Unit& u) const {
        const long L = (long)i * G + c; if (L >= nwg) return false;
        int wgid = (int)L; { const int q = nwg / NXCD, r = nwg % NXCD, xcd = wgid % NXCD, off = wgid / NXCD; wgid = (xcd < r ? xcd * (q + 1) : r * (q + 1) + (xcd - r) * q) + off; }
        const int nig = WGM * nN, gid = wgid / nig, fm = gid * WGM, gsz = (nM - fm) < WGM ? (nM - fm) : WGM;
        u.pm = fm + ((wgid % nig) % gsz); u.pn = (wgid % nig) / gsz; return true;
    }
    __device__ __forceinline__ void a_ready(const Unit&) const {}
    __device__ __forceinline__ void done(const Unit&) const {}
};

typedef float f32x2 __attribute__((ext_vector_type(2)));
typedef __bf16 bf16x2_t __attribute__((ext_vector_type(2)));
__device__ __forceinline__ unsigned cvt_pk_bf16(float lo, float hi) { f32x2 v = {lo, hi}; bf16x2_t b = __builtin_convertvector(v, bf16x2_t); return __builtin_bit_cast(unsigned, b); }
typedef unsigned u32x2 __attribute__((ext_vector_type(2)));
struct EpiDyn {
    static constexpr bool AFTER_DRAIN = false;
    int mode; bool perm;
    bf16_t* O; int ldc;
    const float* ssin; float* ssn; float* outf;
    const PG8_LAS float* rs; int pm0;
    __device__ __forceinline__ void operator()(const f32x4 (&acc)[2][2][4][2], const Unit& u, int wr, int wc, int fr, int fq) const {
        const int row0 = u.pm * BM + wr * 64 + fr; const int col0 = u.pn * BM + wc * 32 + 8 * fq;
        if (mode == 1) {
            const bool nx = ssn != nullptr, fin = outf != nullptr;
#pragma unroll
            for (int ai = 0; ai < 2; ++ai)
#pragma unroll
                for (int m = 0; m < 4; ++m) { const int row = row0 + ai * HALF + m * 16; bf16_t* rowp = O + (size_t)row * ldc + col0; float ssq = 0.f;
#pragma unroll
                    for (int bj = 0; bj < 2; ++bj) { const u32x4 bw = *(const u32x4*)(rowp + bj * HALF);
                        f32x4 v0 = acc[ai][bj][m][0], v1 = acc[ai][bj][m][1];
                        v0[0] += __builtin_bit_cast(float, bw.x << 16); v0[1] += __builtin_bit_cast(float, bw.x & 0xffff0000u); v0[2] += __builtin_bit_cast(float, bw.y << 16); v0[3] += __builtin_bit_cast(float, bw.y & 0xffff0000u);
                        v1[0] += __builtin_bit_cast(float, bw.z << 16); v1[1] += __builtin_bit_cast(float, bw.z & 0xffff0000u); v1[2] += __builtin_bit_cast(float, bw.w << 16); v1[3] += __builtin_bit_cast(float, bw.w & 0xffff0000u);
                        ssq += (v0[0] * v0[0] + v0[1] * v0[1]) + (v0[2] * v0[2] + v0[3] * v0[3]) + (v1[0] * v1[0] + v1[1] * v1[1]) + (v1[2] * v1[2] + v1[3] * v1[3]);
                        if (fin) { float* op = outf + (size_t)row * ldc + col0 + bj * HALF; *(f32x4*)op = v0; *(f32x4*)(op + 4) = v1; }
                        else { u32x4 w; w.x = cvt_pk_bf16(v0[0], v0[1]); w.y = cvt_pk_bf16(v0[2], v0[3]); w.z = cvt_pk_bf16(v1[0], v1[1]); w.w = cvt_pk_bf16(v1[2], v1[3]); *(u32x4*)(rowp + bj * HALF) = w; } }
                    if (nx) { ssq += __shfl_xor(ssq, 16); ssq += __shfl_xor(ssq, 32); if (fq == 0) (void)__hip_atomic_fetch_add(ssn + row, ssq, __ATOMIC_RELAXED, __HIP_MEMORY_SCOPE_AGENT); } }
        } else {
            const bool sq = (mode == 2), scl = ssin != nullptr;
#pragma unroll
            for (int ai = 0; ai < 2; ++ai)
#pragma unroll
                for (int m = 0; m < 4; ++m) { const int row = row0 + ai * HALF + m * 16; bf16_t* rowp = O + (size_t)row * ldc + col0;
                    const float sc = rs ? rs[((u.pm - pm0) >> 3) * 256 + (row & 255)] : (scl ? 1.0f / sqrtf(ssin[row] * (1.f / 1024.f) + 1e-6f) : 1.0f);
#pragma unroll
                    for (int bj = 0; bj < 2; ++bj) { f32x4 v0 = acc[ai][bj][m][0] * sc, v1 = acc[ai][bj][m][1] * sc;
                        if (sq) {
#pragma unroll
                            for (int e = 0; e < 4; ++e) { float a = v0[e] > 0.f ? v0[e] : 0.f; v0[e] = a * a; float b = v1[e] > 0.f ? v1[e] : 0.f; v1[e] = b * b; } }
                        u32x4 w; w.x = cvt_pk_bf16(v0[0], v0[1]); w.y = cvt_pk_bf16(v0[2], v0[3]); w.z = cvt_pk_bf16(v1[0], v1[1]); w.w = cvt_pk_bf16(v1[2], v1[3]);
                        *(u32x4*)(rowp + bj * HALF) = w; } }
        }
    }
};
template <class Epi, class Sched, bool ALIGN_EPI = false, bool SP2 = false>
__device__ __forceinline__ void gemm_phase(PG8_LAS unsigned char* lds, const Gemm g, const Sched& S, const Epi& E) {
    int tid_ = threadIdx.x; asm volatile("" : "+v"(tid_)); const int tid = tid_, wid = __builtin_amdgcn_readfirstlane(tid >> 6), lane = tid & 63, wr = wid >> 2, wc = wid & 3, fr = lane & 15, fq = lane >> 4;
    const int K = g.K, nt = K / BK;
    unsigned voffA[2], voffB[2];
#pragma unroll
    for (int i = 0; i < 2; ++i) { int R, C; stage_rc(tid * 16 + i * 8192, R, C); const int Rb = E.perm ? ((R & ~31) + perm32(R & 31)) : R;
        voffA[i] = (unsigned)(R * K + C) * 2u; voffB[i] = (unsigned)(Rb * K + C) * 2u; }
    const size_t kstep = (size_t)(BK * 2);
    const size_t hstep = (size_t)HALF * K * 2;
    const size_t tstep = 2 * hstep;
    const unsigned ldsw = (unsigned)wid * 1024u;
    const int aoff = lds_byte(wr * 64 + fr, fq * 8), boff = lds_byte(wc * 32 + fr, fq * 8);
#define PG8_SA(b, h) (((b) * 2 + (h)) * HTB)
#define PG8_SB(b, h) ((4 + (b) * 2 + (h)) * HTB)
#define PG8_STAGE(bufoff, gbase, voff) do { _Pragma("unroll") for (int _i = 0; _i < 2; ++_i) \
        __builtin_amdgcn_global_load_lds((const unsigned*)((const char*)(gbase) + (voff)[_i]), (PG8_LAS unsigned*)(lds + (bufoff) + ldsw + _i * 8192), 16, 0, 0); } while (0)
#define PG8_LDA(dst, b, h) do { _Pragma("unroll") for (int m = 0; m < 4; ++m) _Pragma("unroll") for (int k = 0; k < 2; ++k) dst[m][k] = *(const PG8_LAS bf16x8*)(lds + PG8_SA(b, h) + aoff + m * 2048 + k * 1024); } while (0)
#define PG8_LDB(dst, b, h) do { _Pragma("unroll") for (int n = 0; n < 2; ++n) _Pragma("unroll") for (int k = 0; k < 2; ++k) dst[n][k] = *(const PG8_LAS bf16x8*)(lds + PG8_SB(b, h) + boff + n * 2048 + k * 1024); } while (0)
#define PG8_MMA(ai, bj, At, Bt) do { __builtin_amdgcn_s_setprio(1); _Pragma("unroll") for (int m = 0; m < 4; ++m) _Pragma("unroll") for (int n = 0; n < 2; ++n) _Pragma("unroll") for (int k = 0; k < 2; ++k) \
        acc[ai][bj][m][n] = __builtin_amdgcn_mfma_f32_16x16x32_bf16(Bt[n][k], At[m][k], acc[ai][bj][m][n], 0, 0, 0); __builtin_amdgcn_s_setprio(0); } while (0)
#define PG8_WAIT_V(n) asm volatile("s_waitcnt vmcnt(" #n ")" ::: "memory")
#define PG8_WAIT_L(n) asm volatile("s_waitcnt lgkmcnt(" #n ")" ::: "memory")
#define PG8_BAR __builtin_amdgcn_s_barrier()
#define PG8_SCHED __builtin_amdgcn_sched_barrier(0)
    Unit cur, nxt; int ui = 0;
    if (!S.next(0, cur)) return;
    f32x4 acc[2][2][4][2];
#pragma unroll
    for (int a = 0; a < 2; ++a)
#pragma unroll
        for (int b = 0; b < 2; ++b)
#pragma unroll
            for (int m = 0; m < 4; ++m)
#pragma unroll
                for (int n = 0; n < 2; ++n) acc[a][b][m][n] = (f32x4){0.f, 0.f, 0.f, 0.f};
    bf16x8 At[4][2], B0[2][2], B1[2][2];
    const char* cA = (const char*)g.A + (size_t)cur.pm * tstep; const char* cB = (const char*)g.Bt + (size_t)cur.pn * tstep;
    S.a_ready(cur);
    if constexpr (SP2) {
        PG8_STAGE(PG8_SB(0, 0), cB, voffB); PG8_STAGE(PG8_SB(0, 1), cB + hstep, voffB); PG8_STAGE(PG8_SA(0, 0), cA, voffA); PG8_STAGE(PG8_SA(0, 1), cA + hstep, voffA);
        if (wr == 1) PG8_BAR;
        PG8_WAIT_V(2); PG8_BAR;
        PG8_STAGE(PG8_SB(1, 0), cB + kstep, voffB); PG8_STAGE(PG8_SA(1, 0), cA + kstep, voffA); PG8_STAGE(PG8_SB(1, 1), cB + hstep + kstep, voffB);
        PG8_WAIT_V(6); PG8_BAR;
    } else {
        PG8_STAGE(PG8_SB(0, 0), cB, voffB); PG8_STAGE(PG8_SA(0, 0), cA, voffA); PG8_STAGE(PG8_SB(0, 1), cB + hstep, voffB); PG8_STAGE(PG8_SA(0, 1), cA + hstep, voffA);
        if (wr == 1) PG8_BAR;
        PG8_WAIT_V(4); PG8_BAR;
        PG8_STAGE(PG8_SB(1, 0), cB + kstep, voffB); PG8_STAGE(PG8_SA(1, 0), cA + kstep, voffA); PG8_STAGE(PG8_SB(1, 1), cB + hstep + kstep, voffB);
        PG8_WAIT_V(6); PG8_BAR;
    }
    for (;;) {
        const bool has_next = S.next(ui + 1, nxt);
        const char* nA = has_next ? (const char*)g.A + (size_t)nxt.pm * tstep : cA; const char* nB = has_next ? (const char*)g.Bt + (size_t)nxt.pn * tstep : cB;
        for (int t = 0; t < nt; t += 2) {
            const bool last = (t == nt - 2);
            const char* a1 = cA + (size_t)(t + 1) * kstep;
            const char* a2 = last ? nA : cA + (size_t)(t + 2) * kstep; const char* b2 = last ? nB : cB + (size_t)(t + 2) * kstep;
            const char* a3 = a2 + kstep; const char* b3 = b2 + kstep;
            if (last && has_next) S.a_ready(nxt);
            if constexpr (SP2) {
            PG8_LDB(B0, 0, 0); PG8_LDB(B1, 0, 1); PG8_SCHED; PG8_LDA(At, 0, 0); PG8_STAGE(PG8_SA(1, 1), a1 + hstep, voffA);
            PG8_WAIT_V(8); PG8_WAIT_L(0); PG8_BAR; PG8_MMA(0, 0, At, B0); PG8_MMA(0, 1, At, B1); PG8_BAR; PG8_SCHED;
            PG8_LDA(At, 0, 1); PG8_STAGE(PG8_SB(0, 0), b2, voffB); PG8_STAGE(PG8_SB(0, 1), b2 + hstep, voffB); PG8_STAGE(PG8_SA(0, 0), a2, voffA);
            PG8_WAIT_V(8); PG8_WAIT_L(0); PG8_BAR; PG8_MMA(1, 0, At, B0); PG8_MMA(1, 1, At, B1); PG8_BAR; PG8_SCHED;
            PG8_LDB(B0, 1, 0); PG8_LDB(B1, 1, 1); PG8_SCHED; PG8_LDA(At, 1, 0); PG8_STAGE(PG8_SA(0, 1), a2 + hstep, voffA);
            PG8_WAIT_V(8); PG8_WAIT_L(0); PG8_BAR; PG8_MMA(0, 0, At, B0); PG8_MMA(0, 1, At, B1); PG8_BAR; PG8_SCHED;
            PG8_LDA(At, 1, 1); PG8_STAGE(PG8_SB(1, 0), b3, voffB); PG8_STAGE(PG8_SB(1, 1), b3 + hstep, voffB); PG8_STAGE(PG8_SA(1, 0), a3, voffA);
            PG8_WAIT_V(8); PG8_WAIT_L(0); PG8_BAR; PG8_MMA(1, 0, At, B0); PG8_MMA(1, 1, At, B1); PG8_BAR; PG8_SCHED;
            } else {
            PG8_LDB(B0, 0, 0); PG8_SCHED; PG8_LDA(At, 0, 0); PG8_STAGE(PG8_SA(1, 1), a1 + hstep, voffA);
            PG8_WAIT_L(8); PG8_BAR; PG8_WAIT_L(0); PG8_MMA(0, 0, At, B0); PG8_BAR; PG8_SCHED;
            PG8_LDB(B1, 0, 1); PG8_STAGE(PG8_SB(0, 0), b2, voffB);
            PG8_BAR; PG8_WAIT_L(0); PG8_MMA(0, 1, At, B1); PG8_BAR;
            PG8_LDA(At, 0, 1); PG8_STAGE(PG8_SA(0, 0), a2, voffA);
            PG8_BAR; PG8_WAIT_L(0); PG8_MMA(1, 0, At, B0); PG8_BAR; PG8_SCHED;
            PG8_STAGE(PG8_SB(0, 1), b2 + hstep, voffB);
            PG8_WAIT_V(6); PG8_BAR; PG8_MMA(1, 1, At, B1); PG8_BAR;
            PG8_LDB(B0, 1, 0); PG8_SCHED; PG8_LDA(At, 1, 0); PG8_STAGE(PG8_SA(0, 1), a2 + hstep, voffA);
            PG8_WAIT_L(8); PG8_BAR; PG8_WAIT_L(0); PG8_MMA(0, 0, At, B0); PG8_BAR; PG8_SCHED;
            PG8_LDB(B1, 1, 1); PG8_STAGE(PG8_SB(1, 0), b3, voffB);
            PG8_BAR; PG8_WAIT_L(0); PG8_MMA(0, 1, At, B1); PG8_BAR;
            PG8_LDA(At, 1, 1); PG8_STAGE(PG8_SA(1, 0), a3, voffA);
            PG8_BAR; PG8_WAIT_L(0); PG8_MMA(1, 0, At, B0); PG8_BAR; PG8_SCHED;
            PG8_STAGE(PG8_SB(1, 1), b3 + hstep, voffB);
            PG8_WAIT_V(6); PG8_BAR; PG8_MMA(1, 1, At, B1); PG8_BAR;
            }
        }
        if constexpr (ALIGN_EPI) { if (wr == 0) PG8_BAR; }
        if constexpr (!Epi::AFTER_DRAIN) { E(acc, cur, wr, wc, fr, fq); S.done(cur); }
        if (!has_next) break;
#pragma unroll
        for (int a = 0; a < 2; ++a)
#pragma unroll
            for (int b = 0; b < 2; ++b)
#pragma unroll
                for (int m = 0; m < 4; ++m)
#pragma unroll
                    for (int n = 0; n < 2; ++n) acc[a][b][m][n] = (f32x4){0.f, 0.f, 0.f, 0.f};
        cur = nxt; cA = nA; cB = nB; ++ui;
        if constexpr (ALIGN_EPI) { if (wr == 1) PG8_BAR; }
    }
    PG8_WAIT_V(0);
    if constexpr (!ALIGN_EPI) { if (wr == 0) PG8_BAR; }
    PG8_BAR;
    if constexpr (Epi::AFTER_DRAIN) { E.fused(acc, cur, wr, wc, fr, fq, lds, wid, lane); S.done(cur); }
#undef PG8_SA
#undef PG8_SB
#undef PG8_STAGE
#undef PG8_LDA
#undef PG8_LDB
#undef PG8_MMA
#undef PG8_WAIT_V
#undef PG8_WAIT_L
#undef PG8_BAR
#undef PG8_SCHED
}
}

#define LAS __attribute__((address_space(3)))
typedef unsigned short bf16_t;
typedef short bf16x8 __attribute__((ext_vector_type(8)));
typedef float f32x4 __attribute__((ext_vector_type(4)));
typedef unsigned u32x4 __attribute__((ext_vector_type(4)));
typedef unsigned u32x2 __attribute__((ext_vector_type(2)));

constexpr int T = 65536, DM = 1024, SEQ = 2048, NBATCH = 32, ZW = 3584, DFF = 4096, NMEMROWS = 8192;
constexpr float EPS = 1e-6f, LOG2E = 1.4426950408889634f, LN2 = 0.6931471805599453f;
constexpr size_t MiB = 1u << 20;
constexpr size_t WS_CTL = 0, CTL_BYTES = 2 * MiB;
constexpr size_t WS_SS = 256 * 1024;
constexpr int CW_BAR = 2048;
constexpr size_t WS_WB = 2 * MiB, WB_LAYER = 36 * MiB;
constexpr size_t WB_IN = 0, WB_OUT = 7 * MiB, WB_MQ = 9 * MiB, WB_MKV = 11 * MiB, WB_MO = 15 * MiB, WB_FF1 = 17 * MiB, WB_FF2 = 25 * MiB;
constexpr size_t WS_KM = 74 * MiB, KM_LAYER = 32 * MiB, VT_OFF = 16 * MiB;
constexpr size_t WS_YM = 138 * MiB, WS_ZU = 266 * MiB, WS_H = 778 * MiB;
constexpr size_t WS_MN = WS_ZU, WS_KVT = WS_ZU + 32 * MiB;
constexpr size_t WS_QM = WS_ZU;
constexpr size_t WS_END = WS_H + 128 * MiB;
constexpr size_t OUT_OP = 0, OUT_LSE = 192 * MiB;
constexpr int LDS_BYTES = 147456;
constexpr int N_ATT_UNITS = NBATCH * 8 * 48;

#ifndef SKIP_HGRN
#define SKIP_HGRN 0
#endif
#ifndef SKIP_ATTN
#define SKIP_ATTN 0
#endif
#ifndef SKIP_XATTN
#define SKIP_XATTN 0
#endif
struct Params { const float* in[19]; float* out; unsigned char* ws; };

__device__ __forceinline__ unsigned f2bf(float f) { unsigned u = __builtin_bit_cast(unsigned, f); return (u + 0x7fffu + ((u >> 16) & 1u)) >> 16; }
__device__ __forceinline__ unsigned pk2(float lo, float hi) { return pg8::cvt_pk_bf16(lo, hi); }
__device__ __forceinline__ float bflo(unsigned w) { return __builtin_bit_cast(float, w << 16); }
__device__ __forceinline__ float bfhi(unsigned w) { return __builtin_bit_cast(float, w & 0xffff0000u); }
__device__ __forceinline__ void unpack8(const u32x4 w, float (&f)[8]) {
    f[0] = bflo(w.x); f[1] = bfhi(w.x); f[2] = bflo(w.y); f[3] = bfhi(w.y); f[4] = bflo(w.z); f[5] = bfhi(w.z); f[6] = bflo(w.w); f[7] = bfhi(w.w);
}
__device__ __forceinline__ u32x4 pack8(const float (&f)[8]) { u32x4 w; w.x = pk2(f[0], f[1]); w.y = pk2(f[2], f[3]); w.z = pk2(f[4], f[5]); w.w = pk2(f[6], f[7]); return w; }
__device__ __forceinline__ float wave_sum(float v) {
#pragma unroll
    for (int o = 1; o < 64; o <<= 1) v += __shfl_xor(v, o);
    return v;
}
#define DPPF(v, ctrl) __builtin_bit_cast(float, __builtin_amdgcn_mov_dpp(__builtin_bit_cast(int, (v)), (ctrl), 0xF, 0xF, true))
__device__ __forceinline__ float sum8_dpp(float v) { v += DPPF(v, 0xB1); v += DPPF(v, 0x4E); v += DPPF(v, 0x141); return v; }
__device__ __forceinline__ float sum16_dpp(float v) { v = sum8_dpp(v); v += DPPF(v, 0x128); return v; }
#define MFMA16(a, b, c) __builtin_amdgcn_mfma_f32_16x16x32_bf16((a), (b), (c), 0, 0, 0)
#define LDS_WAIT() asm volatile("s_waitcnt lgkmcnt(0)" ::: "memory")
#define LDS_BARRIER() do { asm volatile("s_waitcnt lgkmcnt(0)" ::: "memory"); __builtin_amdgcn_s_barrier(); asm volatile("" ::: "memory"); } while (0)

__device__ __forceinline__ void transpose_item(const float* W, int K, int N, bf16_t* WT, LAS float* scr, int item, int lane, const float* g = nullptr) {
    const int nblk = N / 32, kb = item / nblk, nb = item % nblk, k0 = 64 * kb, n0 = 32 * nb;
#pragma unroll 8
    for (int i = 0; i < 32; ++i) { const int kk = 2 * i + (lane >> 5); scr[kk * 33 + (lane & 31)] = W[(size_t)(k0 + kk) * N + n0 + (lane & 31)] * (g ? g[k0 + kk] : 1.0f); }
    LDS_WAIT();
    const int c = lane & 7;
#pragma unroll
    for (int j = 0; j < 4; ++j) { const int n = (lane >> 3) + 8 * j; const LAS float* s = scr + (8 * c) * 33 + n;
        u32x4 o; o.x = pk2(s[0 * 33], s[1 * 33]); o.y = pk2(s[2 * 33], s[3 * 33]); o.z = pk2(s[4 * 33], s[5 * 33]); o.w = pk2(s[6 * 33], s[7 * 33]);
        *(u32x4*)(WT + (size_t)(n0 + n) * K + k0 + 8 * c) = o; }
    LDS_WAIT();
}
__device__ __forceinline__ void rms_row_1024(const float* xrow, const float* g, bf16_t* orow, int lane) {
    const f32x4* xr = (const f32x4*)xrow + lane; const f32x4* gr = (const f32x4*)g + lane;
    f32x4 v[4]; float s = 0.f;
#pragma unroll
    for (int j = 0; j < 4; ++j) { v[j] = xr[64 * j]; s += (v[j].x * v[j].x + v[j].y * v[j].y) + (v[j].z * v[j].z + v[j].w * v[j].w); }
    const float rstd = 1.0f / sqrtf(wave_sum(s) * (1.f / 1024.f) + EPS);
    u32x2* o8 = (u32x2*)orow + lane;
#pragma unroll
    for (int j = 0; j < 4; ++j) { const f32x4 gv = gr[64 * j]; u32x2 w; w.x = pk2(v[j].x * rstd * gv.x, v[j].y * rstd * gv.y); w.y = pk2(v[j].z * rstd * gv.z, v[j].w * rstd * gv.w); o8[64 * j] = w; }
}

__device__ __forceinline__ void prep_row_1024(const float* xrow, bf16_t* orow, float* ssp, int lane) {
    const f32x4* xr = (const f32x4*)xrow + lane;
    float s = 0.f; u32x2* o8 = (u32x2*)orow + lane;
#pragma unroll
    for (int j = 0; j < 4; ++j) { const f32x4 v = xr[64 * j]; s += (v.x * v.x + v.y * v.y) + (v.z * v.z + v.w * v.w);
        u32x2 w; w.x = pk2(v.x, v.y); w.y = pk2(v.z, v.w); o8[64 * j] = w; }
    s = wave_sum(s);
    if (lane == 0) *ssp = s;
}

struct AttnU { int b, h, p, d, r, n; };
__device__ __forceinline__ AttnU attn_decode(int u) {
    AttnU U; const int bh = u / 48, s48 = u % 48, idx = s48 & 15; U.b = bh >> 3; U.h = bh & 7; U.p = s48 >> 4;
    if (U.p == 0) { U.d = 1; U.r = 0; U.n = idx; } else if (U.p == 1) { U.d = 4; U.r = idx & 3; U.n = idx >> 2; } else { U.d = 16; U.r = idx; U.n = 0; }
    return U;
}
struct AttnRegs { u32x4 kw[4], vw[4], q0, q1; };
__device__ __forceinline__ void attn_load(AttnRegs& R, const bf16_t* Z, const AttnU& U, int tid) {
    const int wave = tid >> 6, lane = tid & 63, fr = lane & 15, fq = lane >> 4;
    const size_t rowbase = (size_t)U.b * SEQ;
#pragma unroll
    for (int it = 0; it < 4; ++it) {
        const int c = tid + 512 * it, row = c >> 3, ch = c & 7, lk = 128 * (U.n - 1) + row;
        R.kw[it] = (u32x4){0u, 0u, 0u, 0u}; R.vw[it] = (u32x4){0u, 0u, 0u, 0u};
        if (lk >= 0) { const bf16_t* zr = Z + (rowbase + (size_t)(lk * U.d + U.r)) * ZW + U.h * 64 + ch * 8; R.kw[it] = *(const u32x4*)(zr + 512); R.vw[it] = *(const u32x4*)(zr + 1024); }
    }
    const int qi = 16 * wave + fr, posq = (128 * U.n + qi) * U.d + U.r;
    const bf16_t* zq = Z + (rowbase + (size_t)posq) * ZW + U.h * 64;
    R.q0 = *(const u32x4*)(zq + fq * 8); R.q1 = *(const u32x4*)(zq + 32 + fq * 8);
}
__device__ __forceinline__ void attn_stage(LAS unsigned char* lds, const AttnRegs& R, const float* gq, const float* gk, int tid, bf16x8& Q0, bf16x8& Q1) {
    const int lane = tid & 63, fq = lane >> 4;
    LAS bf16_t* Ks = (LAS bf16_t*)lds; LAS bf16_t* Vt = (LAS bf16_t*)(lds + 36864);
#pragma unroll
    for (int it = 0; it < 4; ++it) {
        const int c = tid + 512 * it, row = c >> 3, ch = c & 7;
        const u32x4 vw = R.vw[it];
        float kf[8]; unpack8(R.kw[it], kf);
        float ss = 0.f;
#pragma unroll
        for (int e = 0; e < 8; ++e) ss += kf[e] * kf[e];
        ss = sum8_dpp(ss);
        const float rstd = __builtin_amdgcn_rsqf(ss * (1.f / 64.f) + EPS);
        const f32x4 g0 = *(const f32x4*)(gk + ch * 8), g1 = *(const f32x4*)(gk + ch * 8 + 4);
        kf[0] *= rstd * g0.x; kf[1] *= rstd * g0.y; kf[2] *= rstd * g0.z; kf[3] *= rstd * g0.w; kf[4] *= rstd * g1.x; kf[5] *= rstd * g1.y; kf[6] *= rstd * g1.z; kf[7] *= rstd * g1.w;
        *(LAS u32x4*)(Ks + row * 72 + ch * 8) = pack8(kf);
        LAS bf16_t* vt = Vt + (ch * 8) * 264 + 8 * ch + row;
        vt[0 * 264] = (bf16_t)(vw.x & 0xffffu); vt[1 * 264] = (bf16_t)(vw.x >> 16); vt[2 * 264] = (bf16_t)(vw.y & 0xffffu); vt[3 * 264] = (bf16_t)(vw.y >> 16);
        vt[4 * 264] = (bf16_t)(vw.z & 0xffffu); vt[5 * 264] = (bf16_t)(vw.z >> 16); vt[6 * 264] = (bf16_t)(vw.w & 0xffffu); vt[7 * 264] = (bf16_t)(vw.w >> 16);
    }
    float a[8], c[8]; unpack8(R.q0, a); unpack8(R.q1, c);
    float ss = 0.f;
#pragma unroll
    for (int e = 0; e < 8; ++e) ss += a[e] * a[e] + c[e] * c[e];
    ss += __shfl_xor(ss, 16); ss += __shfl_xor(ss, 32);
    const float sc = __builtin_amdgcn_rsqf(ss * (1.f / 64.f) + EPS) * (0.125f * LOG2E);
#pragma unroll
    for (int e = 0; e < 8; ++e) { a[e] *= sc * gq[fq * 8 + e]; c[e] *= sc * gq[32 + fq * 8 + e]; }
    Q0 = __builtin_bit_cast(bf16x8, pack8(a)); Q1 = __builtin_bit_cast(bf16x8, pack8(c));
}
__device__ __forceinline__ void attn_compute(LAS unsigned char* lds, const AttnU& U, const bf16x8 Q0, const bf16x8 Q1, bf16_t* OP, float* LSE, int tid) {
    const int wave = __builtin_amdgcn_readfirstlane(tid >> 6), lane = tid & 63, fr = lane & 15, fq = lane >> 4;
    const int b = U.b, h = U.h, p = U.p, d = U.d, r = U.r, n = U.n;
    LAS bf16_t* Ks = (LAS bf16_t*)lds;
    LAS bf16_t* Vt = (LAS bf16_t*)(lds + 36864);
    LAS bf16_t* Ps = (LAS bf16_t*)(lds + 70784) + wave * (16 * 168);
    const size_t rowbase = (size_t)b * SEQ;
    const int qi = 16 * wave + fr, posq = (128 * n + qi) * d + r;
    const int start = wave < 6 ? 16 * wave : 96, i0 = 16 * wave;
    const float slope2 = exp2f(-(float)(h + 1)) * (float)d * LOG2E;
    const float fbase = (float)(qi + 128 - start - 4 * fq);
    f32x4 S[10]; bool dead[10];
    float m = -1e30f;
#pragma unroll
    for (int t = 0; t < 10; ++t) {
        const int k0 = start + 16 * t;
        dead[t] = (k0 > i0 + 143) || (k0 + 15 < i0) || (n == 0 && k0 + 15 < 128);
        const bool full = (k0 >= i0 + 15) && (k0 + 15 <= i0 + 128) && (n > 0 || k0 >= 128);
        if (dead[t]) { S[t] = (f32x4){-1e30f, -1e30f, -1e30f, -1e30f}; }
        else {
            const LAS bf16_t* kp = Ks + (k0 + fr) * 72 + fq * 8;
            const bf16x8 a0 = *(const LAS bf16x8*)kp, a1 = *(const LAS bf16x8*)(kp + 32);
            f32x4 acc = (f32x4){0.f, 0.f, 0.f, 0.f};
            acc = MFMA16(a0, Q0, acc); acc = MFMA16(a1, Q1, acc);
            if (full) {
#pragma unroll
                for (int j = 0; j < 4; ++j) { const float v = acc[j] - slope2 * (fbase - (float)(16 * t + j)); acc[j] = v; m = fmaxf(m, v); }
            } else {
#pragma unroll
                for (int j = 0; j < 4; ++j) {
                    const int kj = k0 + 4 * fq + j, step = qi + 128 - kj, lk = 128 * (n - 1) + kj;
                    const bool valid = (step >= 0) && (step <= 128) && (lk >= 0);
                    const float v = valid ? acc[j] - slope2 * (float)step : -1e30f;
                    acc[j] = v; m = fmaxf(m, v);
                }
            }
            S[t] = acc;
        }
    }
    m = fmaxf(m, __shfl_xor(m, 16)); m = fmaxf(m, __shfl_xor(m, 32));
    float sum = 0.f;
#pragma unroll
    for (int t = 0; t < 10; ++t) {
        u32x2 w = (u32x2){0u, 0u};
        if (!dead[t]) {
            float pe[4];
#pragma unroll
            for (int j = 0; j < 4; ++j) { pe[j] = __builtin_amdgcn_exp2f(S[t][j] - m); sum += pe[j]; }
            w.x = pk2(pe[0], pe[1]); w.y = pk2(pe[2], pe[3]);
        }
        *(LAS u32x2*)(Ps + fr * 168 + 16 * t + 4 * fq) = w;
    }
    sum += __shfl_xor(sum, 16); sum += __shfl_xor(sum, 32);
    LDS_WAIT();
    f32x4 O[4];
#pragma unroll
    for (int dt = 0; dt < 4; ++dt) O[dt] = (f32x4){0.f, 0.f, 0.f, 0.f};
#pragma unroll
    for (int kc = 0; kc < 5; ++kc) {
        if (dead[2 * kc] && dead[2 * kc + 1]) continue;
        const bf16x8 pb = *(const LAS bf16x8*)(Ps + fr * 168 + 32 * kc + fq * 8);
#pragma unroll
        for (int dt = 0; dt < 4; ++dt) { const bf16x8 va = *(const LAS bf16x8*)(Vt + fr * 264 + 8 * (fr >> 3) + start + fq * 8 + dt * (16 * 264 + 16) + 32 * kc); O[dt] = MFMA16(va, pb, O[dt]); }
    }
    const float inv = __builtin_amdgcn_rcpf(sum);
    const size_t trow = rowbase + (size_t)posq;
    bf16_t* op = OP + ((size_t)p * T + trow) * 512 + h * 64 + 4 * fq;
#pragma unroll
    for (int dt = 0; dt < 4; ++dt) { u32x2 w; w.x = pk2(O[dt][0] * inv, O[dt][1] * inv); w.y = pk2(O[dt][2] * inv, O[dt][3] * inv); *(u32x2*)(op + 16 * dt) = w; }
    if (fq == 0) LSE[((size_t)p * T + trow) * 8 + h] = (m + __builtin_amdgcn_logf(sum)) * LN2;
}
constexpr int ATT_TK = 4, ATT_Q_TICKETS = (N_ATT_UNITS / 8) / ATT_TK;
__device__ __forceinline__ int att_unit_base(int q, int t) { const int j = ATT_TK * t; return (8 * (j / 48) + q) * 48 + (j % 48); }
__device__ __forceinline__ unsigned* att_ctr(unsigned* ctrs, int q) { return ctrs + 64 * q; }
__device__ __forceinline__ int att_resolve(unsigned* ctrs, int xcc, int& qoff, int t) {
    for (;;) {
        if (qoff < 8 && t < ATT_Q_TICKETS) return att_unit_base((xcc + qoff) & 7, t);
        if (++qoff >= 8) return N_ATT_UNITS;
        t = (int)__hip_atomic_fetch_add(att_ctr(ctrs, (xcc + qoff) & 7), 1u, __ATOMIC_RELAXED, __HIP_MEMORY_SCOPE_AGENT);
    }
}
__device__ __forceinline__ void attn_loop(LAS unsigned char* lds, const bf16_t* Z, bf16_t* OP, float* LSE, const float* gq, const float* gk, unsigned* ctrs, int xcc, int tid) {
    LAS int* sh = (LAS int*)(lds + LDS_BYTES - 64);
    int qoff = 0;
    __syncthreads();
    if (tid == 0) {
        const int t0 = (int)__hip_atomic_fetch_add(att_ctr(ctrs, xcc & 7), 1u, __ATOMIC_RELAXED, __HIP_MEMORY_SCOPE_AGENT);
        const int u0 = att_resolve(ctrs, xcc, qoff, t0);
        const int t1 = qoff < 8 ? (int)__hip_atomic_fetch_add(att_ctr(ctrs, (xcc + qoff) & 7), 1u, __ATOMIC_RELAXED, __HIP_MEMORY_SCOPE_AGENT) : ATT_Q_TICKETS;
        const int u1 = att_resolve(ctrs, xcc, qoff, t1);
        sh[0] = u0; sh[1] = u1;
    }
    __syncthreads();
    int u_cur = __builtin_amdgcn_readfirstlane(sh[0]), ub_nxt = __builtin_amdgcn_readfirstlane(sh[1]), ub_nn = N_ATT_UNITS;
    __syncthreads();
    AttnRegs R;
    if (u_cur < N_ATT_UNITS) { const AttnU U = attn_decode(u_cur); attn_load(R, Z, U, tid); }
    while (u_cur < N_ATT_UNITS) {
        const bool first = (u_cur % ATT_TK) == 0, last = (u_cur % ATT_TK) == ATT_TK - 1;
        const int u_nxt = last ? ub_nxt : u_cur + 1;
        const AttnU U = attn_decode(u_cur);
        bf16x8 Q0, Q1;
        attn_stage(lds, R, gq, gk, tid, Q0, Q1);
        int nn = ATT_Q_TICKETS;
        if (first && tid == 0 && qoff < 8) nn = (int)__hip_atomic_fetch_add(att_ctr(ctrs, (xcc + qoff) & 7), 1u, __ATOMIC_RELAXED, __HIP_MEMORY_SCOPE_AGENT);
        if (u_nxt < N_ATT_UNITS) { const AttnU Un = attn_decode(u_nxt); attn_load(R, Z, Un, tid); }
        LDS_BARRIER();
        attn_compute(lds, U, Q0, Q1, OP, LSE, tid);
        if (first && tid == 0) sh[0] = att_resolve(ctrs, xcc, qoff, nn);
        LDS_BARRIER();
        if (first) ub_nn = __builtin_amdgcn_readfirstlane(sh[0]);
        if (last) ub_nxt = ub_nn;
        u_cur = u_nxt;
    }
}

__device__ __forceinline__ void hgrn_unit(LAS unsigned char* lds, const bf16_t* Z, bf16_t* YM, const float* hg_lb, const float* gon, int layer, int u, int tid) {
    const int wave = __builtin_amdgcn_readfirstlane(tid >> 6), lane = tid & 63, fr = lane & 15, fq = lane >> 4;
    const int b = u >> 2, hh = u & 3, tt = tid >> 4, kg = (tid & 15) * 8;
    LAS float*  LG  = (LAS float*)lds;
    LAS bf16_t* QdS = (LAS bf16_t*)(lds + 16384);
    LAS bf16_t* KdS = (LAS bf16_t*)(lds + 25088);
    LAS bf16_t* QeS = (LAS bf16_t*)(lds + 33792);
    LAS bf16_t* KlT = (LAS bf16_t*)(lds + 42496);
    LAS bf16_t* iT  = (LAS bf16_t*)(lds + 52736);
    LAS bf16_t* ScS = (LAS bf16_t*)(lds + 62976);
    LAS bf16_t* StS = (LAS bf16_t*)(lds + 65536);
    LAS float*  DEC = (LAS float*)(lds + 100352);
    LAS float*  OS  = (LAS float*)(lds + 100864);
    LAS float*  LBS = (LAS float*)(lds + 117760);
    LAS float*  GOS = (LAS float*)(lds + 118272);
    if (tid < 128) { const int c = hh * 128 + tid; LBS[tid] = layer == 0 ? 0.f : 1.0f / (1.0f + __expf(hg_lb[c] - hg_lb[512 + c])); GOS[tid] = gon[c]; }
    for (int i = tid; i < 34816 / 4; i += 512) ((LAS unsigned*)(lds + 65536))[i] = 0u;
    f32x4 St[8];
#pragma unroll
    for (int kt = 0; kt < 8; ++kt) St[kt] = (f32x4){0.f, 0.f, 0.f, 0.f};
    __syncthreads();
    const bf16_t* zb = Z + ((size_t)b * SEQ) * ZW + hh * 128 + kg;
    u32x4 nq, nf, ni, ng;
    { const bf16_t* zr = zb + (size_t)tt * ZW; nq = *(const u32x4*)(zr + 1536); nf = *(const u32x4*)(zr + 2048); ni = *(const u32x4*)(zr + 2560); ng = *(const u32x4*)(zr + 3072); }
    for (int c = 0; c < 64; ++c) {
        const u32x4 cq = nq, cf = nf, ci = ni, cgt = ng;
        if (c + 1 < 64) { const bf16_t* zr = zb + (size_t)((c + 1) * 32 + tt) * ZW; nq = *(const u32x4*)(zr + 1536); nf = *(const u32x4*)(zr + 2048); ni = *(const u32x4*)(zr + 2560); ng = *(const u32x4*)(zr + 3072); }
        float qs[8], kk[8], bc[8];
        { float qv[8], fv[8]; unpack8(cq, qv); unpack8(cf, fv);
          const f32x4 lb0 = *(const LAS f32x4*)(LBS + kg), lb1 = *(const LAS f32x4*)(LBS + kg + 4);
          const float lbv[8] = {lb0.x, lb0.y, lb0.z, lb0.w, lb1.x, lb1.y, lb1.z, lb1.w};
#pragma unroll
          for (int e = 0; e < 8; ++e) {
              qs[e] = qv[e] * __builtin_amdgcn_rcpf(1.0f + __expf(-qv[e]));
              const float ef = __expf(-fv[e]), sg = __builtin_amdgcn_rcpf(1.0f + ef);
              const float f = lbv[e] + (1.0f - lbv[e]) * sg;
              float v = __logf(fmaxf(f, 1e-12f));
              kk[e] = (1.0f - lbv[e]) * ef * sg;
              const float x1 = __shfl_up(v, 16); if (fq >= 1) v += x1;
              const float x2 = __shfl_up(v, 32); if (fq >= 2) v += x2;
              bc[e] = v;
          } }
        if (fq == 3) { *(LAS f32x4*)(LG + wave * 128 + kg) = (f32x4){bc[0], bc[1], bc[2], bc[3]}; *(LAS f32x4*)(LG + wave * 128 + kg + 4) = (f32x4){bc[4], bc[5], bc[6], bc[7]}; }
        LDS_BARRIER();
        float bl[8], br[8];
#pragma unroll
        for (int e = 0; e < 8; ++e) { bl[e] = 0.f; br[e] = 0.f; }
#pragma unroll 1
        for (int w2 = 0; w2 < 8; ++w2) {
            const f32x4 v0 = *(const LAS f32x4*)(LG + w2 * 128 + kg), v1 = *(const LAS f32x4*)(LG + w2 * 128 + kg + 4);
            const float vv[8] = {v0.x, v0.y, v0.z, v0.w, v1.x, v1.y, v1.z, v1.w};
            const float inc = w2 < wave ? 1.f : 0.f;
#pragma unroll
            for (int e = 0; e < 8; ++e) { bl[e] += vv[e]; bc[e] += inc * vv[e]; }
            if (w2 == 3) {
#pragma unroll
                for (int e = 0; e < 8; ++e) br[e] = bl[e];
            }
        }
        {
            float qd[8], kd[8], qe[8], kl[8];
#pragma unroll
            for (int e = 0; e < 8; ++e) { qd[e] = qs[e] * __expf(bc[e] - br[e]); kd[e] = kk[e] * __expf(br[e] - bc[e]); qe[e] = qs[e] * __expf(bc[e]); kl[e] = kk[e] * __expf(bl[e] - bc[e]); }
            *(LAS u32x4*)(QdS + tt * 136 + kg) = pack8(qd);
            *(LAS u32x4*)(KdS + tt * 136 + kg) = pack8(kd);
            *(LAS u32x4*)(QeS + tt * 136 + kg) = pack8(qe);
            const u32x4 klw = pack8(kl);
            const int tsw = (((tt >> 3) ^ ((kg >> 3) & 3)) << 3) | (tt & 7);
            LAS bf16_t* kp = KlT + kg * 40 + tsw; LAS bf16_t* ip = iT + kg * 40 + tsw;
            kp[0 * 40] = (bf16_t)(klw.x & 0xffffu); kp[1 * 40] = (bf16_t)(klw.x >> 16); kp[2 * 40] = (bf16_t)(klw.y & 0xffffu); kp[3 * 40] = (bf16_t)(klw.y >> 16);
            kp[4 * 40] = (bf16_t)(klw.z & 0xffffu); kp[5 * 40] = (bf16_t)(klw.z >> 16); kp[6 * 40] = (bf16_t)(klw.w & 0xffffu); kp[7 * 40] = (bf16_t)(klw.w >> 16);
            ip[0 * 40] = (bf16_t)(ci.x & 0xffffu); ip[1 * 40] = (bf16_t)(ci.x >> 16); ip[2 * 40] = (bf16_t)(ci.y & 0xffffu); ip[3 * 40] = (bf16_t)(ci.y >> 16);
            ip[4 * 40] = (bf16_t)(ci.z & 0xffffu); ip[5 * 40] = (bf16_t)(ci.z >> 16); ip[6 * 40] = (bf16_t)(ci.w & 0xffffu); ip[7 * 40] = (bf16_t)(ci.w >> 16);
            if (tt == 0) { *(LAS f32x4*)(DEC + kg) = (f32x4){__expf(bl[0]), __expf(bl[1]), __expf(bl[2]), __expf(bl[3])}; *(LAS f32x4*)(DEC + kg + 4) = (f32x4){__expf(bl[4]), __expf(bl[5]), __expf(bl[6]), __expf(bl[7])}; }
        }
        LDS_BARRIER();
        if (wave < 4) {
            const int tr = wave >> 1, sc = wave & 1;
            f32x4 acc = (f32x4){0.f, 0.f, 0.f, 0.f};
#pragma unroll
            for (int ks = 0; ks < 4; ++ks) { const bf16x8 a = *(const LAS bf16x8*)(QdS + (16 * tr + fr) * 136 + 32 * ks + fq * 8), bb = *(const LAS bf16x8*)(KdS + (16 * sc + fr) * 136 + 32 * ks + fq * 8); acc = MFMA16(a, bb, acc); }
#pragma unroll
            for (int j = 0; j < 4; ++j) { const int t = 16 * tr + 4 * fq + j, s = 16 * sc + fr; ScS[t * 40 + s] = (bf16_t)f2bf(s <= t ? acc[j] : 0.f); }
        }
        f32x4 o0 = (f32x4){0.f, 0.f, 0.f, 0.f}, o1 = (f32x4){0.f, 0.f, 0.f, 0.f};
#pragma unroll
        for (int ks = 0; ks < 4; ++ks) {
            const bf16x8 bb = *(const LAS bf16x8*)(StS + (16 * wave + fr) * 136 + 32 * ks + fq * 8);
            const bf16x8 a0 = *(const LAS bf16x8*)(QeS + fr * 136 + 32 * ks + fq * 8), a1 = *(const LAS bf16x8*)(QeS + (16 + fr) * 136 + 32 * ks + fq * 8);
            o0 = MFMA16(a0, bb, o0); o1 = MFMA16(a1, bb, o1);
        }
        LDS_BARRIER();
        {
            const bf16x8 bb = *(const LAS bf16x8*)(iT + (16 * wave + fr) * 40 + ((fq ^ (((16 * wave + fr) >> 3) & 3)) << 3));
            const bf16x8 a0 = *(const LAS bf16x8*)(ScS + fr * 40 + fq * 8), a1 = *(const LAS bf16x8*)(ScS + (16 + fr) * 40 + fq * 8);
            o0 = MFMA16(a0, bb, o0); o1 = MFMA16(a1, bb, o1);
#pragma unroll
            for (int j = 0; j < 4; ++j) { OS[(4 * fq + j) * 132 + 16 * wave + fr] = o0[j]; OS[(16 + 4 * fq + j) * 132 + 16 * wave + fr] = o1[j]; }
#pragma unroll
            for (int kt = 0; kt < 8; ++kt) {
                const bf16x8 a = *(const LAS bf16x8*)(KlT + (16 * kt + fr) * 40 + ((fq ^ (((16 * kt + fr) >> 3) & 3)) << 3));
                const f32x4 dec = *(const LAS f32x4*)(DEC + 16 * kt + 4 * fq);
                f32x4 sv = St[kt] * dec; sv = MFMA16(a, bb, sv); St[kt] = sv;
                u32x2 w; w.x = pk2(sv[0], sv[1]); w.y = pk2(sv[2], sv[3]);
                *(LAS u32x2*)(StS + (16 * wave + fr) * 136 + 16 * kt + 4 * fq) = w;
            }
        }
        LDS_BARRIER();
        {
            const f32x4 x0 = *(const LAS f32x4*)(OS + tt * 132 + kg), x1 = *(const LAS f32x4*)(OS + tt * 132 + kg + 4);
            float ov[8] = {x0.x, x0.y, x0.z, x0.w, x1.x, x1.y, x1.z, x1.w};
            float ss = 0.f;
#pragma unroll
            for (int e = 0; e < 8; ++e) ss += ov[e] * ov[e];
            ss = sum16_dpp(ss);
            const float rstd = __builtin_amdgcn_rsqf(ss * (1.f / 128.f) + EPS);
            float gv[8]; unpack8(cgt, gv);
            const f32x4 go0 = *(const LAS f32x4*)(GOS + kg), go1 = *(const LAS f32x4*)(GOS + kg + 4);
            const float gov[8] = {go0.x, go0.y, go0.z, go0.w, go1.x, go1.y, go1.z, go1.w};
#pragma unroll
            for (int e = 0; e < 8; ++e) ov[e] = ov[e] * rstd * gov[e] * (gv[e] * __builtin_amdgcn_rcpf(1.0f + __expf(-gv[e])));
            *(u32x4*)(YM + ((size_t)b * SEQ + c * 32 + tt) * 1024 + 512 + hh * 128 + kg) = pack8(ov);
        }
    }
    __syncthreads();
}

__device__ __forceinline__ void xattn_ld(u32x4 (&pre)[8], const bf16_t* src, int tid) {
#pragma unroll
    for (int it = 0; it < 8; ++it) { const int c = tid + 512 * it, row = c >> 5, ch = c & 31; pre[it] = *(const u32x4*)(src + row * 256 + ch * 8); }
}
__device__ __forceinline__ void xattn_st(LAS bf16_t* dst, const u32x4 (&pre)[8], int tid) {
    int t_ = tid; asm volatile("" : "+v"(t_));
    LAS bf16_t* p = dst + (t_ >> 5) * 264 + (t_ & 31) * 8;
#pragma unroll
    for (int it = 0; it < 8; ++it) *(LAS u32x4*)(p + it * (16 * 264)) = pre[it];
}
__device__ __forceinline__ void xattn_q_frags(bf16x8 (&Q)[8], const bf16_t* qp, const float* gmq, int fq) {
    u32x4 qw[8]; float ss = 0.f;
#pragma unroll
    for (int ks = 0; ks < 8; ++ks) { qw[ks] = *(const u32x4*)(qp + 32 * ks); float f[8]; unpack8(qw[ks], f);
#pragma unroll
        for (int e = 0; e < 8; ++e) ss += f[e] * f[e]; }
    ss += __shfl_xor(ss, 16); ss += __shfl_xor(ss, 32);
    const float sc = __builtin_amdgcn_rsqf(ss * (1.f / 256.f) + EPS) * (0.0625f * LOG2E);
#pragma unroll
    for (int ks = 0; ks < 8; ++ks) { float f[8]; unpack8(qw[ks], f); const f32x4 g0 = *(const f32x4*)(gmq + 32 * ks + fq * 8), g1 = *(const f32x4*)(gmq + 32 * ks + fq * 8 + 4);
        f[0] *= sc * g0.x; f[1] *= sc * g0.y; f[2] *= sc * g0.z; f[3] *= sc * g0.w; f[4] *= sc * g1.x; f[5] *= sc * g1.y; f[6] *= sc * g1.z; f[7] *= sc * g1.w;
        Q[ks] = __builtin_bit_cast(bf16x8, pack8(f)); }
}
template <bool FIRST>
__device__ __forceinline__ void xattn_sp_stage(bf16x8 (&P0)[4], bf16x8 (&P1)[4], float& sum0, float& sum1, float& m0, float& m1, const LAS bf16_t* SB, const bf16x8 (&Q0)[8], const bf16x8 (&Q1)[8], int fr, int fq) {
#pragma unroll
    for (int kc = 0; kc < 4; ++kc) {
        f32x4 a00 = (f32x4){0.f, 0.f, 0.f, 0.f}, a01 = a00, a10 = a00, a11 = a00;
#pragma unroll
        for (int ks = 0; ks < 8; ++ks) {
            const bf16x8 ka = *(const LAS bf16x8*)(SB + (32 * kc + fr) * 264 + 32 * ks + fq * 8), kb = *(const LAS bf16x8*)(SB + (32 * kc + 16 + fr) * 264 + 32 * ks + fq * 8);
            a00 = MFMA16(ka, Q0[ks], a00); a10 = MFMA16(ka, Q1[ks], a10); a01 = MFMA16(kb, Q0[ks], a01); a11 = MFMA16(kb, Q1[ks], a11);
        }
        if (FIRST && kc == 0) {
            float x0 = fmaxf(fmaxf(a00[0], a00[1]), fmaxf(a00[2], a00[3])), x1 = fmaxf(fmaxf(a10[0], a10[1]), fmaxf(a10[2], a10[3]));
            x0 = fmaxf(x0, __shfl_xor(x0, 16)); x0 = fmaxf(x0, __shfl_xor(x0, 32)); x1 = fmaxf(x1, __shfl_xor(x1, 16)); x1 = fmaxf(x1, __shfl_xor(x1, 32));
            m0 = x0; m1 = x1;
        }
        float pe[8], pf[8];
#pragma unroll
        for (int j = 0; j < 4; ++j) { pe[j] = __builtin_amdgcn_exp2f(a00[j] - m0); pe[4 + j] = __builtin_amdgcn_exp2f(a01[j] - m0); pf[j] = __builtin_amdgcn_exp2f(a10[j] - m1); pf[4 + j] = __builtin_amdgcn_exp2f(a11[j] - m1); }
#pragma unroll
        for (int e = 0; e < 8; ++e) { sum0 += pe[e]; sum1 += pf[e]; }
        P0[kc] = __builtin_bit_cast(bf16x8, pack8(pe)); P1[kc] = __builtin_bit_cast(bf16x8, pack8(pf));
        asm volatile("" ::: "memory");
    }
}
__device__ __forceinline__ void xattn_pv_stage(const LAS bf16_t* SB, const bf16x8 (&P0a)[4], const bf16x8 (&P0b)[4], const bf16x8 (&P1a)[4], const bf16x8 (&P1b)[4], float inv0, float inv1, bf16_t* o0, bf16_t* o1, int fr, int fq) {
    f32x4 O0[8], O1[8];
#pragma unroll
    for (int dt = 0; dt < 8; ++dt) { O0[dt] = (f32x4){0.f, 0.f, 0.f, 0.f}; O1[dt] = (f32x4){0.f, 0.f, 0.f, 0.f}; }
#pragma unroll
    for (int kc = 0; kc < 8; ++kc) {
        const bf16x8 p0 = kc < 4 ? P0a[kc & 3] : P0b[kc & 3], p1 = kc < 4 ? P1a[kc & 3] : P1b[kc & 3];
#pragma unroll
        for (int dt = 0; dt < 8; ++dt) {
            const LAS bf16_t* vp = SB + (16 * dt + fr) * 264 + 32 * kc + 4 * fq;
            const u32x2 lo = *(const LAS u32x2*)vp, hi = *(const LAS u32x2*)(vp + 16);
            const u32x4 w = (u32x4){lo.x, lo.y, hi.x, hi.y};
            const bf16x8 va = __builtin_bit_cast(bf16x8, w);
            O0[dt] = MFMA16(va, p0, O0[dt]); O1[dt] = MFMA16(va, p1, O1[dt]);
            if (dt == 7) asm volatile("" ::: "memory");
        }
    }
#pragma unroll
    for (int dt = 0; dt < 8; ++dt) {
        u32x2 w; w.x = pk2(O0[dt][0] * inv0, O0[dt][1] * inv0); w.y = pk2(O0[dt][2] * inv0, O0[dt][3] * inv0); *(u32x2*)(o0 + 16 * dt) = w;
        u32x2 v; v.x = pk2(O1[dt][0] * inv1, O1[dt][1] * inv1); v.y = pk2(O1[dt][2] * inv1, O1[dt][3] * inv1); *(u32x2*)(o1 + 16 * dt) = v;
    }
}
__device__ __forceinline__ void xattn_phase(LAS unsigned char* lds, const bf16_t* QM, const bf16_t* KM, const bf16_t* VT, bf16_t* OM, const float* gmq, int bid, int G, int tid0) {
    const int wave = __builtin_amdgcn_readfirstlane(tid0 >> 6);
    LAS bf16_t* SB0 = (LAS bf16_t*)lds; LAS bf16_t* SB1 = (LAS bf16_t*)(lds + 67584);
    if (bid >= 1024) return;
    u32x4 pre[8];
    { const int u0 = bid; xattn_ld(pre, KM + (size_t)((u0 >> 5) * 4 + ((u0 >> 3) & 3)) * 65536, tid0); }
    for (int u = bid; u < 1024; u += G) {
        int tid_ = tid0; asm volatile("" : "+v"(tid_));
        const int tid = tid_, lane = tid & 63, fr = lane & 15, fq = lane >> 4;
        const int b = u >> 5, h = (u >> 3) & 3, qb = u & 7;
        const bf16_t* KMp = KM + (size_t)(b * 4 + h) * 65536; const bf16_t* VTp = VT + (size_t)(b * 4 + h) * 65536;
        const size_t trow = (size_t)b * SEQ + qb * 256 + 32 * wave + fr;
        xattn_st(SB0, pre, tid);
        bf16x8 Q0[8], Q1[8];
        xattn_q_frags(Q0, QM + trow * 1024 + h * 256 + fq * 8, gmq, fq);
        asm volatile("" ::: "memory");
        xattn_q_frags(Q1, QM + (trow + 16) * 1024 + h * 256 + fq * 8, gmq, fq);
        bf16x8 P0a[4], P0b[4], P1a[4], P1b[4];
        float m0, m1, sum0, sum1;
        LDS_BARRIER();
        m0 = 0.f; m1 = 0.f; sum0 = 0.f; sum1 = 0.f;
        xattn_sp_stage<true>(P0a, P1a, sum0, sum1, m0, m1, SB0, Q0, Q1, fr, fq);
        { u32x4 t1[8]; xattn_ld(t1, KMp + 128 * 256, tid); xattn_st(SB1, t1, tid); } LDS_BARRIER();
        xattn_sp_stage<false>(P0b, P1b, sum0, sum1, m0, m1, SB1, Q0, Q1, fr, fq);
        sum0 += __shfl_xor(sum0, 16); sum0 += __shfl_xor(sum0, 32); sum1 += __shfl_xor(sum1, 16); sum1 += __shfl_xor(sum1, 32);
        const float inv0 = __builtin_amdgcn_rcpf(sum0), inv1 = __builtin_amdgcn_rcpf(sum1);
        bf16_t* o0 = OM + trow * 1024 + h * 256 + 4 * fq; bf16_t* o1 = o0 + 16 * 1024;
        { u32x4 t2[8]; xattn_ld(t2, VTp, tid); xattn_st(SB0, t2, tid); } xattn_ld(pre, VTp + 128 * 256, tid); LDS_BARRIER();
        xattn_pv_stage(SB0, P0a, P0b, P1a, P1b, inv0, inv1, o0, o1, fr, fq);
        xattn_st(SB1, pre, tid);
        { const int un = u + G; if (un < 1024) xattn_ld(pre, KM + (size_t)((un >> 5) * 4 + ((un >> 3) & 3)) * 65536, tid); }
        LDS_BARRIER();
        xattn_pv_stage(SB1, P0a, P0b, P1a, P1b, inv0, inv1, o0 + 128, o1 + 128, fr, fq);
    }
}

#define XB_TMO      128
#define XB_XCNT(j)  (256  + 64 * (j))
#define XB_XSUB(j)  (1280 + 64 * (j))
#define XB_XGEN(j)  (2304 + 64 * (j))
#define XB_TOP      3328
#define XB_TOPGEN   3392
#define XCD_BAR_WORDS 3456
#define XB_SPIN_CAP (1u << 18)

__device__ __forceinline__ unsigned xb_ld(unsigned* p)              { return __hip_atomic_load(p, __ATOMIC_RELAXED, __HIP_MEMORY_SCOPE_AGENT); }
__device__ __forceinline__ unsigned xb_add(unsigned* p, unsigned v) { return __hip_atomic_fetch_add(p, v, __ATOMIC_RELAXED, __HIP_MEMORY_SCOPE_AGENT); }
__device__ __forceinline__ unsigned xb_xcc_id() { return (unsigned)__builtin_amdgcn_s_getreg((3 << 11) | 20) & 0xFu; }
#define XB_SPIN(cond, bar) do { unsigned _sp = 0; while (cond) { __builtin_amdgcn_s_sleep(1); \
    if ((++_sp & 255u) == 0u) { if (xb_ld(&(bar)[XB_TMO])) break; if (_sp > XB_SPIN_CAP) { atomicAdd(&(bar)[XB_TMO], 1u); break; } } } } while (0)

struct XcdBarrier {
    unsigned* bar; unsigned x;
    volatile LAS unsigned* st;
};

__device__ __forceinline__ XcdBarrier xcd_barrier_post(unsigned* bar, volatile LAS unsigned* st) {
    XcdBarrier b; b.bar = bar; b.x = xb_xcc_id(); b.st = st;
    if (threadIdx.x == 0) (void)xb_add(&bar[XB_XCNT(b.x)], 1u);
    return b;
}
__device__ __forceinline__ void xcd_barrier_complete(unsigned* bar, unsigned x, unsigned& nloc, unsigned& nx) {
    const unsigned G = gridDim.x * gridDim.y * gridDim.z;
    unsigned sum, cnt, mine, sp = 0u;
    for (;;) {
        sum = 0u; cnt = 0u; mine = 0u;
#pragma unroll
        for (unsigned j = 0; j < 16; ++j) { const unsigned c = xb_ld(&bar[XB_XCNT(j)]); sum += c; cnt += (c > 0u) ? 1u : 0u; mine = (j == x) ? c : mine; }
        if (sum == G) break;
        __builtin_amdgcn_s_sleep(1);
        if ((++sp & 255u) == 0u) { if (xb_ld(&bar[XB_TMO])) break; if (sp > XB_SPIN_CAP) { atomicAdd(&bar[XB_TMO], 1u); break; } }
    }
    nloc = mine > 0u ? mine : 1u; nx = cnt > 0u ? cnt : 1u;
}

__device__ __forceinline__ void xcd_barrier(const XcdBarrier& b) {
    asm volatile("s_waitcnt vmcnt(0)" ::: "memory");
    __syncthreads();
    if (threadIdx.x == 0) {
        unsigned* bar = b.bar;
        __builtin_amdgcn_s_waitcnt(0);
        unsigned nloc = b.st[0], nx = b.st[1];
        if (nloc == 0u) { xcd_barrier_complete(bar, b.x, nloc, nx); b.st[0] = nloc; b.st[1] = nx; }
        const unsigned old = xb_add(&bar[XB_XSUB(b.x)], 1u);
        const unsigned gen = old / nloc;
        if (old + 1u == (gen + 1u) * nloc) {
            __builtin_amdgcn_fence(__ATOMIC_RELEASE, "agent");
            asm volatile("s_waitcnt vmcnt(0)" ::: "memory");
            const unsigned og = xb_add(&bar[XB_TOP], 1u);
            const unsigned tg = og / nx;
            if (og + 1u == (tg + 1u) * nx) xb_add(&bar[XB_TOPGEN], 1u);
            else XB_SPIN(xb_ld(&bar[XB_TOPGEN]) == tg, bar);
            __builtin_amdgcn_fence(__ATOMIC_ACQUIRE, "agent");
            xb_add(&bar[XB_XGEN(b.x)], 1u);
            asm volatile("s_waitcnt vmcnt(0)" ::: "memory");
        } else {
            XB_SPIN(xb_ld(&bar[XB_XGEN(b.x)]) == gen, bar);
            __builtin_amdgcn_fence(__ATOMIC_ACQUIRE, "agent");
            asm volatile("s_waitcnt vmcnt(0)" ::: "memory");
        }
    }
    __syncthreads();
}

constexpr int N_PHASES = 4 + 18;
__global__ void __launch_bounds__(512, 2) mega_fwd(Params P) {
    extern __shared__ __attribute__((aligned(16))) unsigned char smem[];
    LAS unsigned char* lds = (LAS unsigned char*)smem;
    cg::grid_group grid = cg::this_grid();
    if (threadIdx.x < 8) ((LAS unsigned*)(lds + LDS_BYTES - 32))[threadIdx.x] = 0u;
    __syncthreads();
    const XcdBarrier xbar = xcd_barrier_post((unsigned*)(P.ws + WS_CTL) + CW_BAR, (volatile LAS unsigned*)(lds + LDS_BYTES - 32));
    grid.sync();
    for (int ph = 0; ph < N_PHASES; ++ph) {
        int tid_ = threadIdx.x, bid_ = blockIdx.x; asm volatile("" : "+v"(tid_)); asm volatile("" : "+s"(bid_));
        const int tid = tid_, bid = bid_, lane = tid & 63, wave = __builtin_amdgcn_readfirstlane(tid >> 6);
        const int G = gridDim.x, gw = bid * 8 + wave, NGW = G * 8;
        const int gtid = bid * 512 + tid, NGT = G * 512;
        unsigned char* ws = P.ws;
        bf16_t* Xb = (bf16_t*)(ws + WS_H); bf16_t* ZU = (bf16_t*)(ws + WS_ZU); bf16_t* YM = (bf16_t*)(ws + WS_YM); bf16_t* QM = (bf16_t*)(ws + WS_QM);
        bf16_t* OP = (bf16_t*)((unsigned char*)P.out + OUT_OP); float* LSE = (float*)((unsigned char*)P.out + OUT_LSE);
        bf16_t* MN = (bf16_t*)(ws + WS_MN); bf16_t* KVT = (bf16_t*)(ws + WS_KVT);
        const float* x_in = P.in[0]; float* X = P.out;
        bool is_gemm = false;
        pg8::Gemm gj{nullptr, nullptr, 0, 0, 0};
        pg8::EpiDyn E{0, true, nullptr, 0, nullptr, nullptr, nullptr};
        float* SS = (float*)(ws + WS_SS);
        if (ph == 0) {
            LAS float* scr = (LAS float*)(lds + wave * 16384);
            constexpr int NI_IN = 16 * 112, NI_SQ = 16 * 32, NI_MKV = 16 * 64, NI_FF1 = 16 * 128, NI_FF2 = 64 * 32;
            constexpr int NI_LAYER = NI_IN + 3 * NI_SQ + NI_MKV + NI_FF1 + NI_FF2;
            for (int it = gw; it < 2 * NI_LAYER; it += NGW) {
                const int l = it / NI_LAYER; int r = it % NI_LAYER;
                unsigned char* wb = ws + WS_WB + (size_t)l * WB_LAYER;
                if (r < NI_IN) { transpose_item(P.in[3] + (size_t)l * 1024 * 3584, 1024, 3584, (bf16_t*)(wb + WB_IN), scr, r, lane, P.in[2] + l * 1024); continue; } r -= NI_IN;
                if (r < NI_SQ) { transpose_item(P.in[8] + (size_t)l * 1024 * 1024, 1024, 1024, (bf16_t*)(wb + WB_OUT), scr, r, lane); continue; } r -= NI_SQ;
                if (r < NI_SQ) { transpose_item(P.in[11] + (size_t)l * 1024 * 1024, 1024, 1024, (bf16_t*)(wb + WB_MQ), scr, r, lane, P.in[9] + l * 1024); continue; } r -= NI_SQ;
                if (r < NI_MKV) { transpose_item(P.in[12] + (size_t)l * 1024 * 2048, 1024, 2048, (bf16_t*)(wb + WB_MKV), scr, r, lane); continue; } r -= NI_MKV;
                if (r < NI_SQ) { transpose_item(P.in[15] + (size_t)l * 1024 * 1024, 1024, 1024, (bf16_t*)(wb + WB_MO), scr, r, lane); continue; } r -= NI_SQ;
                if (r < NI_FF1) { transpose_item(P.in[17] + (size_t)l * 1024 * 4096, 1024, 4096, (bf16_t*)(wb + WB_FF1), scr, r, lane, P.in[16] + l * 1024); continue; } r -= NI_FF1;
                transpose_item(P.in[18] + (size_t)l * 4096 * 1024, 4096, 1024, (bf16_t*)(wb + WB_FF2), scr, r, lane);
            }
            for (int it = gw; it < 2 * NMEMROWS; it += NGW) { const int l = it / NMEMROWS, row = it % NMEMROWS; rms_row_1024(P.in[1] + (size_t)row * 1024, P.in[10] + l * 1024, MN + ((size_t)l * NMEMROWS + row) * 1024, lane); }
            for (int row = gw; row < T; row += NGW) prep_row_1024(x_in + (size_t)row * 1024, Xb + (size_t)row * 1024, SS + row, lane);
        } else if (ph <= 2) {
            const int l = ph - 1;
            gj = pg8::Gemm{MN + (size_t)l * NMEMROWS * 1024, (const bf16_t*)(ws + WS_WB + (size_t)l * WB_LAYER + WB_MKV), NMEMROWS, 2048, 1024};
            E = pg8::EpiDyn{0, true, KVT + (size_t)l * NMEMROWS * 2048, 2048, nullptr, nullptr, nullptr, nullptr, 0};
            is_gemm = true;
        } else if (ph == 3) {
            for (int it = gw; it < 2 * NMEMROWS * 4; it += NGW) {
                const int l = it / (NMEMROWS * 4), rem = it % (NMEMROWS * 4), row = rem >> 2, h = rem & 3;
                const bf16_t* src = KVT + ((size_t)l * NMEMROWS + row) * 2048 + h * 256 + lane * 4;
                const u32x2 w = *(const u32x2*)src;
                float f0 = bflo(w.x), f1 = bfhi(w.x), f2 = bflo(w.y), f3 = bfhi(w.y);
                const float rstd = 1.0f / sqrtf(wave_sum(f0 * f0 + f1 * f1 + f2 * f2 + f3 * f3) * (1.f / 256.f) + EPS);
                const f32x4 gv = *(const f32x4*)(P.in[14] + l * 256 + lane * 4);
                u32x2 o; o.x = pk2(f0 * rstd * gv.x, f1 * rstd * gv.y); o.y = pk2(f2 * rstd * gv.z, f3 * rstd * gv.w);
                bf16_t* dst = (bf16_t*)(ws + WS_KM + (size_t)l * KM_LAYER) + ((size_t)((row >> 8) * 4 + h) * 256 + (row & 255)) * 256 + lane * 4;
                *(u32x2*)dst = o;
            }
            for (int it = gtid; it < 2 * 32 * 4 * 32 * 256; it += NGT) {
                const int dd = it & 255, mg = (it >> 8) & 31, h = (it >> 13) & 3, b = (it >> 15) & 31, l = it >> 20;
                const bf16_t* src = KVT + ((size_t)l * NMEMROWS + b * 256 + mg * 8) * 2048 + 1024 + h * 256 + dd;
                u32x4 o;
                o.x = (unsigned)src[0 * 2048] | ((unsigned)src[1 * 2048] << 16); o.y = (unsigned)src[2 * 2048] | ((unsigned)src[3 * 2048] << 16);
                o.z = (unsigned)src[4 * 2048] | ((unsigned)src[5 * 2048] << 16); o.w = (unsigned)src[6 * 2048] | ((unsigned)src[7 * 2048] << 16);
                bf16_t* dst = (bf16_t*)(ws + WS_KM + (size_t)l * KM_LAYER + VT_OFF) + ((size_t)(b * 4 + h) * 256 + dd) * 256 + mg * 8;
                *(u32x4*)dst = o;
            }
        } else {
            const int l = (ph - 4) / 9, k = (ph - 4) % 9;
            const unsigned char* wb = ws + WS_WB + (size_t)l * WB_LAYER;
            const float* xcur = (l == 0) ? x_in : X;
            float* ssl = SS + (size_t)(3 * l) * T;
            if (k == 0) {
                gj = pg8::Gemm{Xb, (const bf16_t*)(wb + WB_IN), T, ZW, 1024}; E = pg8::EpiDyn{0, true, ZU, ZW, ssl, nullptr, nullptr, nullptr, 0}; is_gemm = true;
            } else if (k == 1) {
#if SKIP_HGRN
                for (int it = gtid; it < T * 64; it += NGT) { const int t = it >> 6, c8 = it & 63; *(u32x4*)(YM + (size_t)t * 1024 + 512 + c8 * 8) = (u32x4){0u, 0u, 0u, 0u}; }
#else
                for (int u = bid; u < 128; u += G) hgrn_unit(lds, ZU, YM, P.in[6], P.in[7] + l * 512, l, u, tid);
#endif
                int tid2 = tid; asm volatile("" : "+v"(tid2));
                if (!SKIP_ATTN) attn_loop(lds, ZU, OP, LSE, P.in[4] + l * 64, P.in[5] + l * 64, (unsigned*)(ws + WS_CTL) + 64 * (8 + 8 * l), (int)(xbar.x & 7u), tid2);
            } else if (k == 2) {
                for (int it = gtid; it < T * 64; it += NGT) {
                    const int t = it >> 6, c8 = it & 63, h = c8 >> 3;
                    if (SKIP_ATTN) { *(u32x4*)(YM + (size_t)t * 1024 + c8 * 8) = (u32x4){0u, 0u, 0u, 0u}; continue; }
                    const float l0 = LSE[((size_t)0 * T + t) * 8 + h], l1 = LSE[((size_t)1 * T + t) * 8 + h], l2 = LSE[((size_t)2 * T + t) * 8 + h];
                    const float mx = fmaxf(l0, fmaxf(l1, l2));
                    float w0 = __expf(l0 - mx), w1 = __expf(l1 - mx), w2 = __expf(l2 - mx);
                    const float inv = 1.0f / (w0 + w1 + w2); w0 *= inv; w1 *= inv; w2 *= inv;
                    float a[8], bq[8], cq[8];
                    unpack8(*(const u32x4*)(OP + ((size_t)0 * T + t) * 512 + c8 * 8), a);
                    unpack8(*(const u32x4*)(OP + ((size_t)1 * T + t) * 512 + c8 * 8), bq);
                    unpack8(*(const u32x4*)(OP + ((size_t)2 * T + t) * 512 + c8 * 8), cq);
#pragma unroll
                    for (int e = 0; e < 8; ++e) a[e] = w0 * a[e] + w1 * bq[e] + w2 * cq[e];
                    *(u32x4*)(YM + (size_t)t * 1024 + c8 * 8) = pack8(a);
                }
            } else if (k == 3) {
                gj = pg8::Gemm{YM, (const bf16_t*)(wb + WB_OUT), T, 1024, 1024}; E = pg8::EpiDyn{1, true, Xb, 1024, nullptr, ssl + T, nullptr, nullptr, 0}; is_gemm = true;
            } else if (k == 4) {
                gj = pg8::Gemm{Xb, (const bf16_t*)(wb + WB_MQ), T, 1024, 1024}; E = pg8::EpiDyn{0, true, QM, 1024, ssl + T, nullptr, nullptr, nullptr, 0}; is_gemm = true;
            } else if (k == 5) {
                const bf16_t* KM = (const bf16_t*)(ws + WS_KM + (size_t)l * KM_LAYER); const bf16_t* VT = (const bf16_t*)(ws + WS_KM + (size_t)l * KM_LAYER + VT_OFF);
#if SKIP_XATTN
                for (int it = gtid; it < T * 128; it += NGT) *(u32x4*)(YM + (size_t)it * 8) = (u32x4){0u, 0u, 0u, 0u};
#else
                xattn_phase(lds, QM, KM, VT, YM, P.in[13] + l * 256, bid, G, tid);
                __syncthreads();
#endif
            } else if (k == 6) {
                gj = pg8::Gemm{YM, (const bf16_t*)(wb + WB_MO), T, 1024, 1024}; E = pg8::EpiDyn{1, true, Xb, 1024, nullptr, ssl + 2 * T, nullptr, nullptr, 0}; is_gemm = true;
            } else if (k == 7) {
                gj = pg8::Gemm{Xb, (const bf16_t*)(wb + WB_FF1), T, DFF, 1024}; E = pg8::EpiDyn{2, true, ZU, DFF, ssl + 2 * T, nullptr, nullptr, nullptr, 0}; is_gemm = true;
            } else {
                gj = pg8::Gemm{ZU, (const bf16_t*)(wb + WB_FF2), T, 1024, DFF};
                E = pg8::EpiDyn{1, true, Xb, 1024, nullptr, l == 0 ? SS + (size_t)3 * T : nullptr, l == 1 ? X : nullptr, nullptr, 0}; is_gemm = true;
            }
        }
        if (is_gemm) {
            pg8::StaticOrder S; S.init(gj.M, gj.N, G, bid);
            if (E.ssin != nullptr) {
                pg8::Unit u0;
                if (S.next(0, u0)) {
                    LAS float* RS = (LAS float*)(lds + 131072);
                    for (int i = tid; i < 2048; i += 512) { const int pmx = u0.pm + 8 * (i >> 8); if (pmx < S.nM) RS[i] = 1.0f / sqrtf(E.ssin[pmx * 256 + (i & 255)] * (1.f / 1024.f) + EPS); }
                    E.rs = RS; E.pm0 = u0.pm;
                }
                __syncthreads();
            }
            pg8::gemm_phase<pg8::EpiDyn, pg8::StaticOrder, true, true>(lds, gj, S, E);
        }
        if (ph + 1 < N_PHASES) {
            asm volatile("s_waitcnt vmcnt(0) lgkmcnt(0)" ::: "memory");
            __syncthreads();
            xcd_barrier(xbar);
        }
    }
}

extern "C" void kernel_launch(void* const* d_in, const int* in_sizes, int n_in, void* d_out, int out_size, void* d_ws, size_t ws_size, hipStream_t stream) {
    static int grid = 0;
    if (grid == 0) {
        if (n_in != 19 || in_sizes[0] != T * DM || out_size != T * DM || ws_size < WS_END) {
            fprintf(stderr, "kernel_launch: unexpected shapes: n_in %d in0 %d out %d ws %zu (need %zu)\n", n_in, n_in > 0 ? in_sizes[0] : -1, out_size, ws_size, (size_t)WS_END);
            grid = -1; return;
        }
        int dev = 0, cus = 0, per_cu = 0;
        hipGetDevice(&dev);
        hipDeviceGetAttribute(&cus, hipDeviceAttributeMultiprocessorCount, dev);
        hipFuncSetAttribute((const void*)mega_fwd, hipFuncAttributeMaxDynamicSharedMemorySize, LDS_BYTES);
        hipOccupancyMaxActiveBlocksPerMultiprocessor(&per_cu, (const void*)mega_fwd, 512, LDS_BYTES);
        if (per_cu < 1) { fprintf(stderr, "kernel_launch: occupancy query returned %d\n", per_cu); per_cu = 1; }
        grid = cus * per_cu;
        (void)hipGetLastError();
    }
    if (grid < 0) return;
    hipMemsetAsync((char*)d_ws + WS_CTL, 0, CTL_BYTES, stream);
    Params p{};
    for (int i = 0; i < 19; ++i) p.in[i] = (const float*)d_in[i];
    p.out = (float*)d_out; p.ws = (unsigned char*)d_ws;
    void* args[] = {&p};
    hipError_t e = hipLaunchCooperativeKernel((const void*)mega_fwd, dim3(grid), dim3(512), args, LDS_BYTES, stream);
    if (e != hipSuccess) fprintf(stderr, "cooperative launch failed: %s (grid %d)\n", hipGetErrorString(e), grid);
}
```

```cpp
#include <hip/hip_runtime.h>
#include <hip/hip_cooperative_groups.h>
#include <cstdio>
#include <cstdint>
namespace cg = cooperative_groups;
namespace pg8 {
#define PG8_LAS __attribute__((address_space(3)))
typedef unsigned short bf16_t;
typedef short bf16x8 __attribute__((ext_vector_type(8)));
typedef float f32x4 __attribute__((ext_vector_type(4)));
typedef unsigned u32x4 __attribute__((ext_vector_type(4)));
constexpr int BM = 256, BK = 64, HALF = 128, HTB = HALF * BK * 2  , STAGE_BYTES = 8 * HTB, NXCD = 8, WGM = 8;

__host__ __device__ __forceinline__ int lds_byte(int r, int c) { const int st = (r >> 4) * 2 + (c >> 5), rr = r & 15, cc = c & 31, ob = rr * 64 + cc * 2; return st * 1024 + (ob ^ (((ob >> 9) & 1) << 5)); }
__host__ __device__ __forceinline__ void stage_rc(int b, int& R, int& C) { const int st = b / 1024, sb = b % 1024, swz = sb ^ (((sb >> 9) & 1) << 5); R = (st >> 1) * 16 + swz / 64; C = (st & 1) * 32 + (swz % 64) / 2; }
__host__ __device__ __forceinline__ int perm32(int rho) { const int n = rho >> 4, i = rho & 15; return 8 * (i >> 2) + 4 * n + (i & 3); }

struct Unit { int pm, pn; };
struct Gemm { const bf16_t* A; const bf16_t* Bt; int M, N, K; };

struct StaticOrder {
    int nM, nN, nwg, G, c;
    __host__ __device__ void init(int M, int N, int G_, int c_) { nM = M / BM; nN = N / BM; nwg = nM * nN; G = G_; c = c_; }
    __host__ __device__ bool next(int i, Unit& u) const {
        const long L = (long)i * G + c; if (L >= nwg) return false;
        int wgid = (int)L; { const int q = nwg / NXCD, r = nwg % NXCD, xcd = wgid % NXCD, off = wgid / NXCD; wgid = (xcd < r ? xcd * (q + 1) : r * (q + 1) + (xcd - r) * q) + off; }
        const int nig = WGM * nN, gid = wgid / nig, fm = gid * WGM, gsz = (nM - fm) < WGM ? (nM - fm) : WGM;
        u.pm = fm + ((wgid % nig) % gsz); u.pn = (wgid % nig) / gsz; return true;
    }
    __device__ __forceinline__ void a_ready(const Unit&) const {}
    __device__ __forceinline__ void done(const Unit&) const {}
};

typedef float f32x2 __attribute__((ext_vector_type(2)));
typedef __bf16 bf16x2_t __attribute__((ext_vector_type(2)));
__device__ __forceinline__ unsigned cvt_pk_bf16(float lo, float hi) { f32x2 v = {lo, hi}; bf16x2_t b = __builtin_convertvector(v, bf16x2_t); return __builtin_bit_cast(unsigned, b); }
typedef unsigned u32x2 __attribute__((ext_vector_type(2)));
struct EpiDyn {
    static constexpr bool AFTER_DRAIN = false;
    int mode; bool perm;
    bf16_t* O; int ldc;
    const float* ssin; float* ssn; float* outf;
    const PG8_LAS float* rs; int pm0;
    __device__ __forceinline__ void operator()(const f32x4 (&acc)[2][2][4][2], const Unit& u, int wr, int wc, int fr, int fq) const {
        const int row0 = u.pm * BM + wr * 64 + fr; const int col0 = u.pn * BM + wc * 32 + 8 * fq;
        if (mode == 1) {
            const bool nx = ssn != nullptr, fin = outf != nullptr;
#pragma unroll
            for (int ai = 0; ai < 2; ++ai)
#pragma unroll
                for (int m = 0; m < 4; ++m) { const int row = row0 + ai * HALF + m * 16; bf16_t* rowp = O + (size_t)row * ldc + col0; float ssq = 0.f;
#pragma unroll
                    for (int bj = 0; bj < 2; ++bj) { const u32x4 bw = *(const u32x4*)(rowp + bj * HALF);
                        f32x4 v0 = acc[ai][bj][m][0], v1 = acc[ai][bj][m][1];
                        v0[0] += __builtin_bit_cast(float, bw.x << 16); v0[1] += __builtin_bit_cast(float, bw.x & 0xffff0000u); v0[2] += __builtin_bit_cast(float, bw.y << 16); v0[3] += __builtin_bit_cast(float, bw.y & 0xffff0000u);
                        v1[0] += __builtin_bit_cast(float, bw.z << 16); v1[1] += __builtin_bit_cast(float, bw.z & 0xffff0000u); v1[2] += __builtin_bit_cast(float, bw.w << 16); v1[3] += __builtin_bit_cast(float, bw.w & 0xffff0000u);
                        ssq += (v0[0] * v0[0] + v0[1] * v0[1]) + (v0[2] * v0[2] + v0[3] * v0[3]) + (v1[0] * v1[0] + v1[1] * v1[1]) + (v1[2] * v1[2] + v1[3] * v1[3]);
                        if (fin) { float* op = outf + (size_t)row * ldc + col0 + bj * HALF; *(f32x4*)op = v0; *(f32x4*)(op + 4) = v1; }
                        else { u32x4 w; w.x = cvt_pk_bf16(v0[0], v0[1]); w.y = cvt_pk_bf16(v0[2], v0[3]); w.z = cvt_pk_bf16(v1[0], v1[1]); w.w = cvt_pk_bf16(v1[2], v1[3]); *(u32x4*)(rowp + bj * HALF) = w; } }
                    if (nx) { ssq += __shfl_xor(ssq, 16); ssq += __shfl_xor(ssq, 32); if (fq == 0) (void)__hip_atomic_fetch_add(ssn + row, ssq, __ATOMIC_RELAXED, __HIP_MEMORY_SCOPE_AGENT); } }
        } else {
            const bool sq = (mode == 2), scl = ssin != nullptr;
#pragma unroll
            for (int ai = 0; ai < 2; ++ai)
#pragma unroll
                for (int m = 0; m < 4; ++m) { const int row = row0 + ai * HALF + m * 16; bf16_t* rowp = O + (size_t)row * ldc + col0;
                    const float sc = rs ? rs[((u.pm - pm0) >> 3) * 256 + (row & 255)] : (scl ? 1.0f / sqrtf(ssin[row] * (1.f / 1024.f) + 1e-6f) : 1.0f);
#pragma unroll
                    for (int bj = 0; bj < 2; ++bj) { f32x4 v0 = acc[ai][bj][m][0] * sc, v1 = acc[ai][bj][m][1] * sc;
                        if (sq) {
#pragma unroll
                            for (int e = 0; e < 4; ++e) { float a = v0[e] > 0.f ? v0[e] : 0.f; v0[e] = a * a; float b = v1[e] > 0.f ? v1[e] : 0.f; v1[e] = b * b; } }
                        u32x4 w; w.x = cvt_pk_bf16(v0[0], v0[1]); w.y = cvt_pk_bf16(v0[2], v0[3]); w.z = cvt_pk_bf16(v1[0], v1[1]); w.w = cvt_pk_bf16(v1[2], v1[3]);
                        *(u32x4*)(rowp + bj * HALF) = w; } }
        }
    }
};
template <class Epi, class Sched, bool ALIGN_EPI = false, bool SP2 = false>
__device__ __forceinline__ void gemm_phase(PG8_LAS unsigned char* lds, const Gemm g, const Sched& S, const Epi& E) {
    int tid_ = threadIdx.x; asm volatile("" : "+v"(tid_)); const int tid = tid_, wid = __builtin_amdgcn_readfirstlane(tid >> 6), lane = tid & 63, wr = wid >> 2, wc = wid & 3, fr = lane & 15, fq = lane >> 4;
    const int K = g.K, nt = K / BK;
    unsigned voffA[2], voffB[2];
#pragma unroll
    for (int i = 0; i < 2; ++i) { int R, C; stage_rc(tid * 16 + i * 8192, R, C); const int Rb = E.perm ? ((R & ~31) + perm32(R & 31)) : R;
        voffA[i] = (unsigned)(R * K + C) * 2u; voffB[i] = (unsigned)(Rb * K + C) * 2u; }
    const size_t kstep = (size_t)(BK * 2);
    const size_t hstep = (size_t)HALF * K * 2;
    const size_t tstep = 2 * hstep;
    const unsigned ldsw = (unsigned)wid * 1024u;
    const int aoff = lds_byte(wr * 64 + fr, fq * 8), boff = lds_byte(wc * 32 + fr, fq * 8);
#define PG8_SA(b, h) (((b) * 2 + (h)) * HTB)
#define PG8_SB(b, h) ((4 + (b) * 2 + (h)) * HTB)
#define PG8_STAGE(bufoff, gbase, voff) do { _Pragma("unroll") for (int _i = 0; _i < 2; ++_i) \
        __builtin_amdgcn_global_load_lds((const unsigned*)((const char*)(gbase) + (voff)[_i]), (PG8_LAS unsigned*)(lds + (bufoff) + ldsw + _i * 8192), 16, 0, 0); } while (0)
#define PG8_LDA(dst, b, h) do { _Pragma("unroll") for (int m = 0; m < 4; ++m) _Pragma("unroll") for (int k = 0; k < 2; ++k) dst[m][k] = *(const PG8_LAS bf16x8*)(lds + PG8_SA(b, h) + aoff + m * 2048 + k * 1024); } while (0)
#define PG8_LDB(dst, b, h) do { _Pragma("unroll") for (int n = 0; n < 2; ++n) _Pragma("unroll") for (int k = 0; k < 2; ++k) dst[n][k] = *(const PG8_LAS bf16x8*)(lds + PG8_SB(b, h) + boff + n * 2048 + k * 1024); } while (0)
#define PG8_MMA(ai, bj, At, Bt) do { __builtin_amdgcn_s_setprio(1); _Pragma("unroll") for (int m = 0; m < 4; ++m) _Pragma("unroll") for (int n = 0; n < 2; ++n) _Pragma("unroll") for (int k = 0; k < 2; ++k) \
        acc[ai][bj][m][n] = __builtin_amdgcn_mfma_f32_16x16x32_bf16(Bt[n][k], At[m][k], acc[ai][bj][m][n], 0, 0, 0); __builtin_amdgcn_s_setprio(0); } while (0)
#define PG8_WAIT_V(n) asm volatile("s_waitcnt vmcnt(" #n ")" ::: "memory")
#define PG8_WAIT_L(n) asm volatile("s_waitcnt lgkmcnt(" #n ")" ::: "memory")
#define PG8_BAR __builtin_amdgcn_s_barrier()
#define PG8_SCHED __builtin_amdgcn_sched_barrier(0)
    Unit cur, nxt; int ui = 0;
    if (!S.next(0, cur)) return;
    f32x4 acc[2][2][4][2];
#pragma unroll
    for (int a = 0; a < 2; ++a)
#pragma unroll
        for (int b = 0; b < 2; ++b)
#pragma unroll
            for (int m = 0; m < 4; ++m)
#pragma unroll
                for (int n = 0; n < 2; ++n) acc[a][b][m][n] = (f32x4){0.f, 0.f, 0.f, 0.f};
    bf16x8 At[4][2], B0[2][2], B1[2][2];
    const char* cA = (const char*)g.A + (size_t)cur.pm * tstep; const char* cB = (const char*)g.Bt + (size_t)cur.pn * tstep;
    S.a_ready(cur);
    if constexpr (SP2) {
        PG8_STAGE(PG8_SB(0, 0), cB, voffB); PG8_STAGE(PG8_SB(0, 1), cB + hstep, voffB); PG8_STAGE(PG8_SA(0, 0), cA, voffA); PG8_STAGE(PG8_SA(0, 1), cA + hstep, voffA);
        if (wr == 1) PG8_BAR;
        PG8_WAIT_V(2); PG8_BAR;
        PG8_STAGE(PG8_SB(1, 0), cB + kstep, voffB); PG8_STAGE(PG8_SA(1, 0), cA + kstep, voffA); PG8_STAGE(PG8_SB(1, 1), cB + hstep + kstep, voffB);
        PG8_WAIT_V(6); PG8_BAR;
    } else {
        PG8_STAGE(PG8_SB(0, 0), cB, voffB); PG8_STAGE(PG8_SA(0, 0), cA, voffA); PG8_STAGE(PG8_SB(0, 1), cB + hstep, voffB); PG8_STAGE(PG8_SA(0, 1), cA + hstep, voffA);
        if (wr == 1) PG8_BAR;
        PG8_WAIT_V(4); PG8_BAR;
        PG8_STAGE(PG8_SB(1, 0), cB + kstep, voffB); PG8_STAGE(PG8_SA(1, 0), cA + kstep, voffA); PG8_STAGE(PG8_SB(1, 1), cB + hstep + kstep, voffB);
        PG8_WAIT_V(6); PG8_BAR;
    }
    for (;;) {
        const bool has_next = S.next(ui + 1, nxt);
        const char* nA = has_next ? (const char*)g.A + (size_t)nxt.pm * tstep : cA; const char* nB = has_next ? (const char*)g.Bt + (size_t)nxt.pn * tstep : cB;
        for (int t = 0; t < nt; t += 2) {
            const bool last = (t == nt - 2);
            const char* a1 = cA + (size_t)(t + 1) * kstep;
            const char* a2 = last ? nA : cA + (size_t)(t + 2) * kstep; const char* b2 = last ? nB : cB + (size_t)(t + 2) * kstep;
            const char* a3 = a2 + kstep; const char* b3 = b2 + kstep;
            if (last && has_next) S.a_ready(nxt);
            if constexpr (SP2) {
            PG8_LDB(B0, 0, 0); PG8_LDB(B1, 0, 1); PG8_SCHED; PG8_LDA(At, 0, 0); PG8_STAGE(PG8_SA(1, 1), a1 + hstep, voffA);
            PG8_WAIT_V(8); PG8_WAIT_L(0); PG8_BAR; PG8_MMA(0, 0, At, B0); PG8_MMA(0, 1, At, B1); PG8_BAR; PG8_SCHED;
            PG8_LDA(At, 0, 1); PG8_STAGE(PG8_SB(0, 0), b2, voffB); PG8_STAGE(PG8_SB(0, 1), b2 + hstep, voffB); PG8_STAGE(PG8_SA(0, 0), a2, voffA);
            PG8_WAIT_V(8); PG8_WAIT_L(0); PG8_BAR; PG8_MMA(1, 0, At, B0); PG8_MMA(1, 1, At, B1); PG8_BAR; PG8_SCHED;
            PG8_LDB(B0, 1, 0); PG8_LDB(B1, 1, 1); PG8_SCHED; PG8_LDA(At, 1, 0); PG8_STAGE(PG8_SA(0, 1), a2 + hstep, voffA);
            PG8_WAIT_V(8); PG8_WAIT_L(0); PG8_BAR; PG8_MMA(0, 0, At, B0); PG8_MMA(0, 1, At, B1); PG8_BAR; PG8_SCHED;
            PG8_LDA(At, 1, 1); PG8_STAGE(PG8_SB(1, 0), b3, voffB); PG8_STAGE(PG8_SB(1, 1), b3 + hstep, voffB); PG8_STAGE(PG8_SA(1, 0), a3, voffA);
            PG8_WAIT_V(8); PG8_WAIT_L(0); PG8_BAR; PG8_MMA(1, 0, At, B0); PG8_MMA(1, 1, At, B1); PG8_BAR; PG8_SCHED;
            } else {
            PG8_LDB(B0, 0, 0); PG8_SCHED; PG8_LDA(At, 0, 0); PG8_STAGE(PG8_SA(1, 1), a1 + hstep, voffA);
            PG8_WAIT_L(8); PG8_BAR; PG8_WAIT_L(0); PG8_MMA(0, 0, At, B0); PG8_BAR; PG8_SCHED;
            PG8_LDB(B1, 0, 1); PG8_STAGE(PG8_SB(0, 0), b2, voffB);
            PG8_BAR; PG8_WAIT_L(0); PG8_MMA(0, 1, At, B1); PG8_BAR;
            PG8_LDA(At, 0, 1); PG8_STAGE(PG8_SA(0, 0), a2, voffA);
            PG8_BAR; PG8_WAIT_L(0); PG8_MMA(1, 0, At, B0); PG8_BAR; PG8_SCHED;
            PG8_STAGE(PG8_SB(0, 1), b2 + hstep, voffB);
            PG8_WAIT_V(6); PG8_BAR; PG8_MMA(1, 1, At, B1); PG8_BAR;
            PG8_LDB(B0, 1, 0); PG8_SCHED; PG8_LDA(At, 1, 0); PG8_STAGE(PG8_SA(0, 1), a2 + hstep, voffA);
            PG8_WAIT_L(8); PG8_BAR; PG8_WAIT_L(0); PG8_MMA(0, 0, At, B0); PG8_BAR; PG8_SCHED;
            PG8_LDB(B1, 1, 1); PG8_STAGE(PG8_SB(1, 0), b3, voffB);
            PG8_BAR; PG8_WAIT_L(0); PG8_MMA(0, 1, At, B1); PG8_BAR;
            PG8_LDA(At, 1, 1); PG8_STAGE(PG8_SA(1, 0), a3, voffA);
            PG8_BAR; PG8_WAIT_L(0); PG8_MMA(1, 0, At, B0); PG8_BAR; PG8_SCHED;
            PG8_STAGE(PG8_SB(1, 1), b3 + hstep, voffB);
            PG8_WAIT_V(6); PG8_BAR; PG8_MMA(1, 1, At, B1); PG8_BAR;
            }
        }
        if constexpr (ALIGN_EPI) { if (wr == 0) PG8_BAR; }
        if constexpr (!Epi::AFTER_DRAIN) { E(acc, cur, wr, wc, fr, fq); S.done(cur); }
        if (!has_next) break;
#pragma unroll
        for (int a = 0; a < 2; ++a)
#pragma unroll
            for (int b = 0; b < 2; ++b)
#pragma unroll
                for (int m = 0; m < 4; ++m)
#pragma unroll
                    for (int n = 0; n < 2; ++n) acc[a][b][m][n] = (f32x4){0.f, 0.f, 0.f, 0.f};
        cur = nxt; cA = nA; cB = nB; ++ui;
        if constexpr (ALIGN_EPI) { if (wr == 1) PG8_BAR; }
    }
    PG8_WAIT_V(0);
    if constexpr (!ALIGN_EPI) { if (wr == 0) PG8_BAR; }
    PG8_BAR;
    if constexpr (Epi::AFTER_DRAIN) { E.fused(acc, cur, wr, wc, fr, fq, lds, wid, lane); S.done(cur); }
#undef PG8_SA
#undef PG8_SB
#undef PG8_STAGE
#undef PG8_LDA
#undef PG8_LDB
#undef PG8_MMA
#undef PG8_WAIT_V
#undef PG8_WAIT_L
#undef PG8_BAR
#undef PG8_SCHED
}
}

#define LAS __attribute__((address_space(3)))
typedef unsigned short bf16_t;
typedef short bf16x8 __attribute__((ext_vector_type(8)));
typedef float f32x4 __attribute__((ext_vector_type(4)));
typedef unsigned u32x4 __attribute__((ext_vector_type(4)));
typedef unsigned u32x2 __attribute__((ext_vector_type(2)));

constexpr int T = 65536, DM = 1024, SEQ = 2048, NBATCH = 32, ZW = 3584, DFF = 4096, NMEMROWS = 8192;
constexpr float EPS = 1e-6f, LOG2E = 1.4426950408889634f, LN2 = 0.6931471805599453f;
constexpr size_t MiB = 1u << 20;
constexpr size_t WS_CTL = 0, CTL_BYTES = 2 * MiB;
constexpr size_t WS_SS = 256 * 1024;
constexpr int CW_BAR = 2048;
constexpr size_t WS_WB = 2 * MiB, WB_LAYER = 36 * MiB;
constexpr size_t WB_IN = 0, WB_OUT = 7 * MiB, WB_MQ = 9 * MiB, WB_MKV = 11 * MiB, WB_MO = 15 * MiB, WB_FF1 = 17 * MiB, WB_FF2 = 25 * MiB;
constexpr size_t WS_KM = 74 * MiB, KM_LAYER = 32 * MiB, VT_OFF = 16 * MiB;
constexpr size_t WS_YM = 138 * MiB, WS_ZU = 266 * MiB, WS_H = 778 * MiB;
constexpr size_t WS_MN = WS_ZU, WS_KVT = WS_ZU + 32 * MiB;
constexpr size_t WS_QM = WS_ZU;
constexpr size_t WS_END = WS_H + 128 * MiB;
constexpr size_t OUT_OP = 0, OUT_LSE = 192 * MiB;
constexpr int LDS_BYTES = 147456;
constexpr int N_ATT_UNITS = NBATCH * 8 * 48;

#ifndef SKIP_HGRN
#define SKIP_HGRN 0
#endif
#ifndef SKIP_ATTN
#define SKIP_ATTN 0
#endif
#ifndef SKIP_XATTN
#define SKIP_XATTN 0
#endif
struct Params { const float* in[19]; float* out; unsigned char* ws; };

__device__ __forceinline__ unsigned f2bf(float f) { unsigned u = __builtin_bit_cast(unsigned, f); return (u + 0x7fffu + ((u >> 16) & 1u)) >> 16; }
__device__ __forceinline__ unsigned pk2(float lo, float hi) { return pg8::cvt_pk_bf16(lo, hi); }
__device__ __forceinline__ float bflo(unsigned w) { return __builtin_bit_cast(float, w << 16); }
__device__ __forceinline__ float bfhi(unsigned w) { return __builtin_bit_cast(float, w & 0xffff0000u); }
__device__ __forceinline__ void unpack8(const u32x4 w, float (&f)[8]) {
    f[0] = bflo(w.x); f[1] = bfhi(w.x); f[2] = bflo(w.y); f[3] = bfhi(w.y); f[4] = bflo(w.z); f[5] = bfhi(w.z); f[6] = bflo(w.w); f[7] = bfhi(w.w);
}
__device__ __forceinline__ u32x4 pack8(const float (&f)[8]) { u32x4 w; w.x = pk2(f[0], f[1]); w.y = pk2(f[2], f[3]); w.z = pk2(f[4], f[5]); w.w = pk2(f[6], f[7]); return w; }
__device__ __forceinline__ float wave_sum(float v) {
#pragma unroll
    for (int o = 1; o < 64; o <<= 1) v += __shfl_xor(v, o);
    return v;
}
#define DPPF(v, ctrl) __builtin_bit_cast(float, __builtin_amdgcn_mov_dpp(__builtin_bit_cast(int, (v)), (ctrl), 0xF, 0xF, true))
__device__ __forceinline__ float sum8_dpp(float v) { v += DPPF(v, 0xB1); v += DPPF(v, 0x4E); v += DPPF(v, 0x141); return v; }
__device__ __forceinline__ float sum16_dpp(float v) { v = sum8_dpp(v); v += DPPF(v, 0x128); return v; }
#define MFMA16(a, b, c) __builtin_amdgcn_mfma_f32_16x16x32_bf16((a), (b), (c), 0, 0, 0)
#define LDS_WAIT() asm volatile("s_waitcnt lgkmcnt(0)" ::: "memory")
#define LDS_BARRIER() do { asm volatile("s_waitcnt lgkmcnt(0)" ::: "memory"); __builtin_amdgcn_s_barrier(); asm volatile("" ::: "memory"); } while (0)

__device__ __forceinline__ void transpose_item(const float* W, int K, int N, bf16_t* WT, LAS float* scr, int item, int lane, const float* g = nullptr) {
    const int nblk = N / 32, kb = item / nblk, nb = item % nblk, k0 = 64 * kb, n0 = 32 * nb;
#pragma unroll 8
    for (int i = 0; i < 32; ++i) { const int kk = 2 * i + (lane >> 5); scr[kk * 33 + (lane & 31)] = W[(size_t)(k0 + kk) * N + n0 + (lane & 31)] * (g ? g[k0 + kk] : 1.0f); }
    LDS_WAIT();
    const int c = lane & 7;
#pragma unroll
    for (int j = 0; j < 4; ++j) { const int n = (lane >> 3) + 8 * j; const LAS float* s = scr + (8 * c) * 33 + n;
        u32x4 o; o.x = pk2(s[0 * 33], s[1 * 33]); o.y = pk2(s[2 * 33], s[3 * 33]); o.z = pk2(s[4 * 33], s[5 * 33]); o.w = pk2(s[6 * 33], s[7 * 33]);
        *(u32x4*)(WT + (size_t)(n0 + n) * K + k0 + 8 * c) = o; }
    LDS_WAIT();
}
__device__ __forceinline__ void rms_row_1024(const float* xrow, const float* g, bf16_t* orow, int lane) {
    const f32x4* xr = (const f32x4*)xrow + lane; const f32x4* gr = (const f32x4*)g + lane;
    f32x4 v[4]; float s = 0.f;
#pragma unroll
    for (int j = 0; j < 4; ++j) { v[j] = xr[64 * j]; s += (v[j].x * v[j].x + v[j].y * v[j].y) + (v[j].z * v[j].z + v[j].w * v[j].w); }
    const float rstd = 1.0f / sqrtf(wave_sum(s) * (1.f / 1024.f) + EPS);
    u32x2* o8 = (u32x2*)orow + lane;
#pragma unroll
    for (int j = 0; j < 4; ++j) { const f32x4 gv = gr[64 * j]; u32x2 w; w.x = pk2(v[j].x * rstd * gv.x, v[j].y * rstd * gv.y); w.y = pk2(v[j].z * rstd * gv.z, v[j].w * rstd * gv.w); o8[64 * j] = w; }
}

__device__ __forceinline__ void prep_row_1024(const float* xrow, bf16_t* orow, float* ssp, int lane) {
    const f32x4* xr = (const f32x4*)xrow + lane;
    float s = 0.f; u32x2* o8 = (u32x2*)orow + lane;
#pragma unroll
    for (int j = 0; j < 4; ++j) { const f32x4 v = xr[64 * j]; s += (v.x * v.x + v.y * v.y) + (v.z * v.z + v.w * v.w);
        u32x2 w; w.x = pk2(v.x, v.y); w.y = pk2(v.z, v.w); o8[64 * j] = w; }
    s = wave_sum(s);
    if (lane == 0) *ssp = s;
}

struct AttnU { int b, h, p, d, r, n; };
__device__ __forceinline__ AttnU attn_decode(int u) {
    AttnU U; const int bh = u / 48, s48 = u % 48, idx = s48 & 15; U.b = bh >> 3; U.h = bh & 7; U.p = s48 >> 4;
    if (U.p == 0) { U.d = 1; U.r = 0; U.n = idx; } else if (U.p == 1) { U.d = 4; U.r = idx & 3; U.n = idx >> 2; } else { U.d = 16; U.r = idx; U.n = 0; }
    return U;
}
struct AttnRegs { u32x4 kw[4], vw[4], q0, q1; };
__device__ __forceinline__ void attn_load(AttnRegs& R, const bf16_t* Z, const AttnU& U, int tid) {
    const int wave = tid >> 6, lane = tid & 63, fr = lane & 15, fq = lane >> 4;
    const size_t rowbase = (size_t)U.b * SEQ;
#pragma unroll
    for (int it = 0; it < 4; ++it) {
        const int c = tid + 512 * it, row = c >> 3, ch = c & 7, lk = 128 * (U.n - 1) + row;
        R.kw[it] = (u32x4){0u, 0u, 0u, 0u}; R.vw[it] = (u32x4){0u, 0u, 0u, 0u};
        if (lk >= 0) { const bf16_t* zr = Z + (rowbase + (size_t)(lk * U.d + U.r)) * ZW + U.h * 64 + ch * 8; R.kw[it] = *(const u32x4*)(zr + 512); R.vw[it] = *(const u32x4*)(zr + 1024); }
    }
    const int qi = 16 * wave + fr, posq = (128 * U.n + qi) * U.d + U.r;
    const bf16_t* zq = Z + (rowbase + (size_t)posq) * ZW + U.h * 64;
    R.q0 = *(const u32x4*)(zq + fq * 8); R.q1 = *(const u32x4*)(zq + 32 + fq * 8);
}
__device__ __forceinline__ void attn_stage(LAS unsigned char* lds, const AttnRegs& R, const float* gq, const float* gk, int tid, bf16x8& Q0, bf16x8& Q1) {
    const int lane = tid & 63, fq = lane >> 4;
    LAS bf16_t* Ks = (LAS bf16_t*)lds; LAS bf16_t* Vt = (LAS bf16_t*)(lds + 36864);
#pragma unroll
    for (int it = 0; it < 4; ++it) {
        const int c = tid + 512 * it, row = c >> 3, ch = c & 7;
        const u32x4 vw = R.vw[it];
        float kf[8]; unpack8(R.kw[it], kf);
        float ss = 0.f;
#pragma unroll
        for (int e = 0; e < 8; ++e) ss += kf[e] * kf[e];
        ss = sum8_dpp(ss);
        const float rstd = __builtin_amdgcn_rsqf(ss * (1.f / 64.f) + EPS);
        const f32x4 g0 = *(const f32x4*)(gk + ch * 8), g1 = *(const f32x4*)(gk + ch * 8 + 4);
        kf[0] *= rstd * g0.x; kf[1] *= rstd * g0.y; kf[2] *= rstd * g0.z; kf[3] *= rstd * g0.w; kf[4] *= rstd * g1.x; kf[5] *= rstd * g1.y; kf[6] *= rstd * g1.z; kf[7] *= rstd * g1.w;
        *(LAS u32x4*)(Ks + row * 72 + ch * 8) = pack8(kf);
        LAS bf16_t* vt = Vt + (ch * 8) * 264 + 8 * ch + row;
        vt[0 * 264] = (bf16_t)(vw.x & 0xffffu); vt[1 * 264] = (bf16_t)(vw.x >> 16); vt[2 * 264] = (bf16_t)(vw.y & 0xffffu); vt[3 * 264] = (bf16_t)(vw.y >> 16);
        vt[4 * 264] = (bf16_t)(vw.z & 0xffffu); vt[5 * 264] = (bf16_t)(vw.z >> 16); vt[6 * 264] = (bf16_t)(vw.w & 0xffffu); vt[7 * 264] = (bf16_t)(vw.w >> 16);
    }
    float a[8], c[8]; unpack8(R.q0, a); unpack8(R.q1, c);
    float ss = 0.f;
#pragma unroll
    for (int e = 0; e < 8; ++e) ss += a[e] * a[e] + c[e] * c[e];
    ss += __shfl_xor(ss, 16); ss += __shfl_xor(ss, 32);
    const float sc = __builtin_amdgcn_rsqf(ss * (1.f / 64.f) + EPS) * (0.125f * LOG2E);
#pragma unroll
    for (int e = 0; e < 8; ++e) { a[e] *= sc * gq[fq * 8 + e]; c[e] *= sc * gq[32 + fq * 8 + e]; }
    Q0 = __builtin_bit_cast(bf16x8, pack8(a)); Q1 = __builtin_bit_cast(bf16x8, pack8(c));
}
__device__ __forceinline__ void attn_compute(LAS unsigned char* lds, const AttnU& U, const bf16x8 Q0, const bf16x8 Q1, bf16_t* OP, float* LSE, int tid) {
    const int wave = __builtin_amdgcn_readfirstlane(tid >> 6), lane = tid & 63, fr = lane & 15, fq = lane >> 4;
    const int b = U.b, h = U.h, p = U.p, d = U.d, r = U.r, n = U.n;
    LAS bf16_t* Ks = (LAS bf16_t*)lds;
    LAS bf16_t* Vt = (LAS bf16_t*)(lds + 36864);
    LAS bf16_t* Ps = (LAS bf16_t*)(lds + 70784) + wave * (16 * 168);
    const size_t rowbase = (size_t)b * SEQ;
    const int qi = 16 * wave + fr, posq = (128 * n + qi) * d + r;
    const int start = wave < 6 ? 16 * wave : 96, i0 = 16 * wave;
    const float slope2 = exp2f(-(float)(h + 1)) * (float)d * LOG2E;
    const float fbase = (float)(qi + 128 - start - 4 * fq);
    f32x4 S[10]; bool dead[10];
    float m = -1e30f;
#pragma unroll
    for (int t = 0; t < 10; ++t) {
        const int k0 = start + 16 * t;
        dead[t] = (k0 > i0 + 143) || (k0 + 15 < i0) || (n == 0 && k0 + 15 < 128);
        const bool full = (k0 >= i0 + 15) && (k0 + 15 <= i0 + 128) && (n > 0 || k0 >= 128);
        if (dead[t]) { S[t] = (f32x4){-1e30f, -1e30f, -1e30f, -1e30f}; }
        else {
            const LAS bf16_t* kp = Ks + (k0 + fr) * 72 + fq * 8;
            const bf16x8 a0 = *(const LAS bf16x8*)kp, a1 = *(const LAS bf16x8*)(kp + 32);
            f32x4 acc = (f32x4){0.f, 0.f, 0.f, 0.f};
            acc = MFMA16(a0, Q0, acc); acc = MFMA16(a1, Q1, acc);
            if (full) {
#pragma unroll
                for (int j = 0; j < 4; ++j) { const float v = acc[j] - slope2 * (fbase - (float)(16 * t + j)); acc[j] = v; m = fmaxf(m, v); }
            } else {
#pragma unroll
                for (int j = 0; j < 4; ++j) {
                    const int kj = k0 + 4 * fq + j, step = qi + 128 - kj, lk = 128 * (n - 1) + kj;
                    const bool valid = (step >= 0) && (step <= 128) && (lk >= 0);
                    const float v = valid ? acc[j] - slope2 * (float)step : -1e30f;
                    acc[j] = v; m = fmaxf(m, v);
                }
            }
            S[t] = acc;
        }
    }
    m = fmaxf(m, __shfl_xor(m, 16)); m = fmaxf(m, __shfl_xor(m, 32));
    float sum = 0.f;
#pragma unroll
    for (int t = 0; t < 10; ++t) {
        u32x2 w = (u32x2){0u, 0u};
        if (!dead[t]) {
            float pe[4];
#pragma unroll
            for (int j = 0; j < 4; ++j) { pe[j] = __builtin_amdgcn_exp2f(S[t][j] - m); sum += pe[j]; }
            w.x = pk2(pe[0], pe[1]); w.y = pk2(pe[2], pe[3]);
        }
        *(LAS u32x2*)(Ps + fr * 168 + 16 * t + 4 * fq) = w;
    }
    sum += __shfl_xor(sum, 16); sum += __shfl_xor(sum, 32);
    LDS_WAIT();
    f32x4 O[4];
#pragma unroll
    for (int dt = 0; dt < 4; ++dt) O[dt] = (f32x4){0.f, 0.f, 0.f, 0.f};
#pragma unroll
    for (int kc = 0; kc < 5; ++kc) {
        if (dead[2 * kc] && dead[2 * kc + 1]) continue;
        const bf16x8 pb = *(const LAS bf16x8*)(Ps + fr * 168 + 32 * kc + fq * 8);
#pragma unroll
        for (int dt = 0; dt < 4; ++dt) { const bf16x8 va = *(const LAS bf16x8*)(Vt + fr * 264 + 8 * (fr >> 3) + start + fq * 8 + dt * (16 * 264 + 16) + 32 * kc); O[dt] = MFMA16(va, pb, O[dt]); }
    }
    const float inv = __builtin_amdgcn_rcpf(sum);
    const size_t trow = rowbase + (size_t)posq;
    bf16_t* op = OP + ((size_t)p * T + trow) * 512 + h * 64 + 4 * fq;
#pragma unroll
    for (int dt = 0; dt < 4; ++dt) { u32x2 w; w.x = pk2(O[dt][0] * inv, O[dt][1] * inv); w.y = pk2(O[dt][2] * inv, O[dt][3] * inv); *(u32x2*)(op + 16 * dt) = w; }
    if (fq == 0) LSE[((size_t)p * T + trow) * 8 + h] = (m + __builtin_amdgcn_logf(sum)) * LN2;
}
constexpr int ATT_TK = 2;
__device__ __forceinline__ void attn_loop(LAS unsigned char* lds, const bf16_t* Z, bf16_t* OP, float* LSE, const float* gq, const float* gk, unsigned* ctr, int tid) {
    LAS int* sh = (LAS int*)(lds + LDS_BYTES - 64);
    __syncthreads();
    if (tid == 0) { const int a0 = (int)__hip_atomic_fetch_add(ctr, 1u, __ATOMIC_RELAXED, __HIP_MEMORY_SCOPE_AGENT), a1 = (int)__hip_atomic_fetch_add(ctr, 1u, __ATOMIC_RELAXED, __HIP_MEMORY_SCOPE_AGENT); sh[0] = a0; sh[1] = a1; }
    __syncthreads();
    int u_cur = ATT_TK * __builtin_amdgcn_readfirstlane(sh[0]), tk_nxt = __builtin_amdgcn_readfirstlane(sh[1]), tk_nn = 0;
    __syncthreads();
    AttnRegs R;
    if (u_cur < N_ATT_UNITS) { const AttnU U = attn_decode(u_cur); attn_load(R, Z, U, tid); }
    while (u_cur < N_ATT_UNITS) {
        const bool first = (u_cur % ATT_TK) == 0, last = (u_cur % ATT_TK) == ATT_TK - 1;
        const int u_nxt = last ? ATT_TK * tk_nxt : u_cur + 1;
        const AttnU U = attn_decode(u_cur);
        bf16x8 Q0, Q1;
        attn_stage(lds, R, gq, gk, tid, Q0, Q1);
        int nn = 0;
        if (first && tid == 0) nn = (int)__hip_atomic_fetch_add(ctr, 1u, __ATOMIC_RELAXED, __HIP_MEMORY_SCOPE_AGENT);
        if (u_nxt < N_ATT_UNITS) { const AttnU Un = attn_decode(u_nxt); attn_load(R, Z, Un, tid); }
        LDS_BARRIER();
        attn_compute(lds, U, Q0, Q1, OP, LSE, tid);
        if (first && tid == 0) sh[0] = nn;
        LDS_BARRIER();
        if (first) tk_nn = __builtin_amdgcn_readfirstlane(sh[0]);
        if (last) tk_nxt = tk_nn;
        u_cur = u_nxt;
    }
}

__device__ __forceinline__ void hgrn_unit(LAS unsigned char* lds, const bf16_t* Z, bf16_t* YM, const float* hg_lb, const float* gon, int layer, int u, int tid) {
    const int wave = __builtin_amdgcn_readfirstlane(tid >> 6), lane = tid & 63, fr = lane & 15, fq = lane >> 4;
    const int b = u >> 2, hh = u & 3, tt = tid >> 4, kg = (tid & 15) * 8;
    LAS float*  LG  = (LAS float*)lds;
    LAS bf16_t* QdS = (LAS bf16_t*)(lds + 16384);
    LAS bf16_t* KdS = (LAS bf16_t*)(lds + 25088);
    LAS bf16_t* QeS = (LAS bf16_t*)(lds + 33792);
    LAS bf16_t* KlT = (LAS bf16_t*)(lds + 42496);
    LAS bf16_t* iT  = (LAS bf16_t*)(lds + 52736);
    LAS bf16_t* ScS = (LAS bf16_t*)(lds + 62976);
    LAS bf16_t* StS = (LAS bf16_t*)(lds + 65536);
    LAS float*  DEC = (LAS float*)(lds + 100352);
    LAS float*  OS  = (LAS float*)(lds + 100864);
    LAS float*  LBS = (LAS float*)(lds + 117760);
    LAS float*  GOS = (LAS float*)(lds + 118272);
    if (tid < 128) { const int c = hh * 128 + tid; LBS[tid] = layer == 0 ? 0.f : 1.0f / (1.0f + __expf(hg_lb[c] - hg_lb[512 + c])); GOS[tid] = gon[c]; }
    for (int i = tid; i < 34816 / 4; i += 512) ((LAS unsigned*)(lds + 65536))[i] = 0u;
    f32x4 St[8];
#pragma unroll
    for (int kt = 0; kt < 8; ++kt) St[kt] = (f32x4){0.f, 0.f, 0.f, 0.f};
    __syncthreads();
    const bf16_t* zb = Z + ((size_t)b * SEQ) * ZW + hh * 128 + kg;
    u32x4 nq, nf, ni, ng;
    { const bf16_t* zr = zb + (size_t)tt * ZW; nq = *(const u32x4*)(zr + 1536); nf = *(const u32x4*)(zr + 2048); ni = *(const u32x4*)(zr + 2560); ng = *(const u32x4*)(zr + 3072); }
    for (int c = 0; c < 64; ++c) {
        const u32x4 cq = nq, cf = nf, ci = ni, cgt = ng;
        if (c + 1 < 64) { const bf16_t* zr = zb + (size_t)((c + 1) * 32 + tt) * ZW; nq = *(const u32x4*)(zr + 1536); nf = *(const u32x4*)(zr + 2048); ni = *(const u32x4*)(zr + 2560); ng = *(const u32x4*)(zr + 3072); }
        float qs[8], kk[8], bc[8];
        { float qv[8], fv[8]; unpack8(cq, qv); unpack8(cf, fv);
          const f32x4 lb0 = *(const LAS f32x4*)(LBS + kg), lb1 = *(const LAS f32x4*)(LBS + kg + 4);
          const float lbv[8] = {lb0.x, lb0.y, lb0.z, lb0.w, lb1.x, lb1.y, lb1.z, lb1.w};
#pragma unroll
          for (int e = 0; e < 8; ++e) {
              qs[e] = qv[e] * __builtin_amdgcn_rcpf(1.0f + __expf(-qv[e]));
              const float ef = __expf(-fv[e]), sg = __builtin_amdgcn_rcpf(1.0f + ef);
              const float f = lbv[e] + (1.0f - lbv[e]) * sg;
              float v = __logf(fmaxf(f, 1e-12f));
              kk[e] = (1.0f - lbv[e]) * ef * sg;
              const float x1 = __shfl_up(v, 16); if (fq >= 1) v += x1;
              const float x2 = __shfl_up(v, 32); if (fq >= 2) v += x2;
              bc[e] = v;
          } }
        if (fq == 3) { *(LAS f32x4*)(LG + wave * 128 + kg) = (f32x4){bc[0], bc[1], bc[2], bc[3]}; *(LAS f32x4*)(LG + wave * 128 + kg + 4) = (f32x4){bc[4], bc[5], bc[6], bc[7]}; }
        LDS_BARRIER();
        float bl[8], br[8];
#pragma unroll
        for (int e = 0; e < 8; ++e) { bl[e] = 0.f; br[e] = 0.f; }
#pragma unroll 1
        for (int w2 = 0; w2 < 8; ++w2) {
            const f32x4 v0 = *(const LAS f32x4*)(LG + w2 * 128 + kg), v1 = *(const LAS f32x4*)(LG + w2 * 128 + kg + 4);
            const float vv[8] = {v0.x, v0.y, v0.z, v0.w, v1.x, v1.y, v1.z, v1.w};
            const float inc = w2 < wave ? 1.f : 0.f;
#pragma unroll
            for (int e = 0; e < 8; ++e) { bl[e] += vv[e]; bc[e] += inc * vv[e]; }
            if (w2 == 3) {
#pragma unroll
                for (int e = 0; e < 8; ++e) br[e] = bl[e];
            }
        }
        {
            float qd[8], kd[8], qe[8], kl[8];
#pragma unroll
            for (int e = 0; e < 8; ++e) { qd[e] = qs[e] * __expf(bc[e] - br[e]); kd[e] = kk[e] * __expf(br[e] - bc[e]); qe[e] = qs[e] * __expf(bc[e]); kl[e] = kk[e] * __expf(bl[e] - bc[e]); }
            *(LAS u32x4*)(QdS + tt * 136 + kg) = pack8(qd);
            *(LAS u32x4*)(KdS + tt * 136 + kg) = pack8(kd);
            *(LAS u32x4*)(QeS + tt * 136 + kg) = pack8(qe);
            const u32x4 klw = pack8(kl);
            const int tsw = (((tt >> 3) ^ ((kg >> 3) & 3)) << 3) | (tt & 7);
            LAS bf16_t* kp = KlT + kg * 40 + tsw; LAS bf16_t* ip = iT + kg * 40 + tsw;
            kp[0 * 40] = (bf16_t)(klw.x & 0xffffu); kp[1 * 40] = (bf16_t)(klw.x >> 16); kp[2 * 40] = (bf16_t)(klw.y & 0xffffu); kp[3 * 40] = (bf16_t)(klw.y >> 16);
            kp[4 * 40] = (bf16_t)(klw.z & 0xffffu); kp[5 * 40] = (bf16_t)(klw.z >> 16); kp[6 * 40] = (bf16_t)(klw.w & 0xffffu); kp[7 * 40] = (bf16_t)(klw.w >> 16);
            ip[0 * 40] = (bf16_t)(ci.x & 0xffffu); ip[1 * 40] = (bf16_t)(ci.x >> 16); ip[2 * 40] = (bf16_t)(ci.y & 0xffffu); ip[3 * 40] = (bf16_t)(ci.y >> 16);
            ip[4 * 40] = (bf16_t)(ci.z & 0xffffu); ip[5 * 40] = (bf16_t)(ci.z >> 16); ip[6 * 40] = (bf16_t)(ci.w & 0xffffu); ip[7 * 40] = (bf16_t)(ci.w >> 16);
            if (tt == 0) { *(LAS f32x4*)(DEC + kg) = (f32x4){__expf(bl[0]), __expf(bl[1]), __expf(bl[2]), __expf(bl[3])}; *(LAS f32x4*)(DEC + kg + 4) = (f32x4){__expf(bl[4]), __expf(bl[5]), __expf(bl[6]), __expf(bl[7])}; }
        }
        LDS_BARRIER();
        if (wave < 4) {
            const int tr = wave >> 1, sc = wave & 1;
            f32x4 acc = (f32x4){0.f, 0.f, 0.f, 0.f};
#pragma unroll
            for (int ks = 0; ks < 4; ++ks) { const bf16x8 a = *(const LAS bf16x8*)(QdS + (16 * tr + fr) * 136 + 32 * ks + fq * 8), bb = *(const LAS bf16x8*)(KdS + (16 * sc + fr) * 136 + 32 * ks + fq * 8); acc = MFMA16(a, bb, acc); }
#pragma unroll
            for (int j = 0; j < 4; ++j) { const int t = 16 * tr + 4 * fq + j, s = 16 * sc + fr; ScS[t * 40 + s] = (bf16_t)f2bf(s <= t ? acc[j] : 0.f); }
        }
        f32x4 o0 = (f32x4){0.f, 0.f, 0.f, 0.f}, o1 = (f32x4){0.f, 0.f, 0.f, 0.f};
#pragma unroll
        for (int ks = 0; ks < 4; ++ks) {
            const bf16x8 bb = *(const LAS bf16x8*)(StS + (16 * wave + fr) * 136 + 32 * ks + fq * 8);
            const bf16x8 a0 = *(const LAS bf16x8*)(QeS + fr * 136 + 32 * ks + fq * 8), a1 = *(const LAS bf16x8*)(QeS + (16 + fr) * 136 + 32 * ks + fq * 8);
            o0 = MFMA16(a0, bb, o0); o1 = MFMA16(a1, bb, o1);
        }
        LDS_BARRIER();
        {
            const bf16x8 bb = *(const LAS bf16x8*)(iT + (16 * wave + fr) * 40 + ((fq ^ (((16 * wave + fr) >> 3) & 3)) << 3));
            const bf16x8 a0 = *(const LAS bf16x8*)(ScS + fr * 40 + fq * 8), a1 = *(const LAS bf16x8*)(ScS + (16 + fr) * 40 + fq * 8);
            o0 = MFMA16(a0, bb, o0); o1 = MFMA16(a1, bb, o1);
#pragma unroll
            for (int j = 0; j < 4; ++j) { OS[(4 * fq + j) * 132 + 16 * wave + fr] = o0[j]; OS[(16 + 4 * fq + j) * 132 + 16 * wave + fr] = o1[j]; }
#pragma unroll
            for (int kt = 0; kt < 8; ++kt) {
                const bf16x8 a = *(const LAS bf16x8*)(KlT + (16 * kt + fr) * 40 + ((fq ^ (((16 * kt + fr) >> 3) & 3)) << 3));
                const f32x4 dec = *(const LAS f32x4*)(DEC + 16 * kt + 4 * fq);
                f32x4 sv = St[kt] * dec; sv = MFMA16(a, bb, sv); St[kt] = sv;
                u32x2 w; w.x = pk2(sv[0], sv[1]); w.y = pk2(sv[2], sv[3]);
                *(LAS u32x2*)(StS + (16 * wave + fr) * 136 + 16 * kt + 4 * fq) = w;
            }
        }
        LDS_BARRIER();
        {
            const f32x4 x0 = *(const LAS f32x4*)(OS + tt * 132 + kg), x1 = *(const LAS f32x4*)(OS + tt * 132 + kg + 4);
            float ov[8] = {x0.x, x0.y, x0.z, x0.w, x1.x, x1.y, x1.z, x1.w};
            float ss = 0.f;
#pragma unroll
            for (int e = 0; e < 8; ++e) ss += ov[e] * ov[e];
            ss = sum16_dpp(ss);
            const float rstd = __builtin_amdgcn_rsqf(ss * (1.f / 128.f) + EPS);
            float gv[8]; unpack8(cgt, gv);
            const f32x4 go0 = *(const LAS f32x4*)(GOS + kg), go1 = *(const LAS f32x4*)(GOS + kg + 4);
            const float gov[8] = {go0.x, go0.y, go0.z, go0.w, go1.x, go1.y, go1.z, go1.w};
#pragma unroll
            for (int e = 0; e < 8; ++e) ov[e] = ov[e] * rstd * gov[e] * (gv[e] * __builtin_amdgcn_rcpf(1.0f + __expf(-gv[e])));
            *(u32x4*)(YM + ((size_t)b * SEQ + c * 32 + tt) * 1024 + 512 + hh * 128 + kg) = pack8(ov);
        }
    }
    __syncthreads();
}

__device__ __forceinline__ void xattn_ld(u32x4 (&pre)[8], const bf16_t* src, int tid) {
#pragma unroll
    for (int it = 0; it < 8; ++it) { const int c = tid + 512 * it, row = c >> 5, ch = c & 31; pre[it] = *(const u32x4*)(src + row * 256 + ch * 8); }
}
__device__ __forceinline__ void xattn_st(LAS bf16_t* dst, const u32x4 (&pre)[8], int tid) {
    int t_ = tid; asm volatile("" : "+v"(t_));
    LAS bf16_t* p = dst + (t_ >> 5) * 264 + (t_ & 31) * 8;
#pragma unroll
    for (int it = 0; it < 8; ++it) *(LAS u32x4*)(p + it * (16 * 264)) = pre[it];
}
__device__ __forceinline__ void xattn_q_frags(bf16x8 (&Q)[8], const bf16_t* qp, const float* gmq, int fq) {
    u32x4 qw[8]; float ss = 0.f;
#pragma unroll
    for (int ks = 0; ks < 8; ++ks) { qw[ks] = *(const u32x4*)(qp + 32 * ks); float f[8]; unpack8(qw[ks], f);
#pragma unroll
        for (int e = 0; e < 8; ++e) ss += f[e] * f[e]; }
    ss += __shfl_xor(ss, 16); ss += __shfl_xor(ss, 32);
    const float sc = __builtin_amdgcn_rsqf(ss * (1.f / 256.f) + EPS) * (0.0625f * LOG2E);
#pragma unroll
    for (int ks = 0; ks < 8; ++ks) { float f[8]; unpack8(qw[ks], f); const f32x4 g0 = *(const f32x4*)(gmq + 32 * ks + fq * 8), g1 = *(const f32x4*)(gmq + 32 * ks + fq * 8 + 4);
        f[0] *= sc * g0.x; f[1] *= sc * g0.y; f[2] *= sc * g0.z; f[3] *= sc * g0.w; f[4] *= sc * g1.x; f[5] *= sc * g1.y; f[6] *= sc * g1.z; f[7] *= sc * g1.w;
        Q[ks] = __builtin_bit_cast(bf16x8, pack8(f)); }
}
template <bool FIRST>
__device__ __forceinline__ void xattn_sp_stage(bf16x8 (&P0)[4], bf16x8 (&P1)[4], float& sum0, float& sum1, float& m0, float& m1, const LAS bf16_t* SB, const bf16x8 (&Q0)[8], const bf16x8 (&Q1)[8], int fr, int fq) {
#pragma unroll
    for (int kc = 0; kc < 4; ++kc) {
        f32x4 a00 = (f32x4){0.f, 0.f, 0.f, 0.f}, a01 = a00, a10 = a00, a11 = a00;
#pragma unroll
        for (int ks = 0; ks < 8; ++ks) {
            const bf16x8 ka = *(const LAS bf16x8*)(SB + (32 * kc + fr) * 264 + 32 * ks + fq * 8), kb = *(const LAS bf16x8*)(SB + (32 * kc + 16 + fr) * 264 + 32 * ks + fq * 8);
            a00 = MFMA16(ka, Q0[ks], a00); a10 = MFMA16(ka, Q1[ks], a10); a01 = MFMA16(kb, Q0[ks], a01); a11 = MFMA16(kb, Q1[ks], a11);
        }
        if (FIRST && kc == 0) {
            float x0 = fmaxf(fmaxf(a00[0], a00[1]), fmaxf(a00[2], a00[3])), x1 = fmaxf(fmaxf(a10[0], a10[1]), fmaxf(a10[2], a10[3]));
            x0 = fmaxf(x0, __shfl_xor(x0, 16)); x0 = fmaxf(x0, __shfl_xor(x0, 32)); x1 = fmaxf(x1, __shfl_xor(x1, 16)); x1 = fmaxf(x1, __shfl_xor(x1, 32));
            m0 = x0; m1 = x1;
        }
        float pe[8], pf[8];
#pragma unroll
        for (int j = 0; j < 4; ++j) { pe[j] = __builtin_amdgcn_exp2f(a00[j] - m0); pe[4 + j] = __builtin_amdgcn_exp2f(a01[j] - m0); pf[j] = __builtin_amdgcn_exp2f(a10[j] - m1); pf[4 + j] = __builtin_amdgcn_exp2f(a11[j] - m1); }
#pragma unroll
        for (int e = 0; e < 8; ++e) { sum0 += pe[e]; sum1 += pf[e]; }
        P0[kc] = __builtin_bit_cast(bf16x8, pack8(pe)); P1[kc] = __builtin_bit_cast(bf16x8, pack8(pf));
        asm volatile("" ::: "memory");
    }
}
__device__ __forceinline__ void xattn_pv_stage(const LAS bf16_t* SB, const bf16x8 (&P0a)[4], const bf16x8 (&P0b)[4], const bf16x8 (&P1a)[4], const bf16x8 (&P1b)[4], float inv0, float inv1, bf16_t* o0, bf16_t* o1, int fr, int fq) {
    f32x4 O0[8], O1[8];
#pragma unroll
    for (int dt = 0; dt < 8; ++dt) { O0[dt] = (f32x4){0.f, 0.f, 0.f, 0.f}; O1[dt] = (f32x4){0.f, 0.f, 0.f, 0.f}; }
#pragma unroll
    for (int kc = 0; kc < 8; ++kc) {
        const bf16x8 p0 = kc < 4 ? P0a[kc & 3] : P0b[kc & 3], p1 = kc < 4 ? P1a[kc & 3] : P1b[kc & 3];
#pragma unroll
        for (int dt = 0; dt < 8; ++dt) {
            const LAS bf16_t* vp = SB + (16 * dt + fr) * 264 + 32 * kc + 4 * fq;
            const u32x2 lo = *(const LAS u32x2*)vp, hi = *(const LAS u32x2*)(vp + 16);
            const u32x4 w = (u32x4){lo.x, lo.y, hi.x, hi.y};
            const bf16x8 va = __builtin_bit_cast(bf16x8, w);
            O0[dt] = MFMA16(va, p0, O0[dt]); O1[dt] = MFMA16(va, p1, O1[dt]);
            if (dt == 7) asm volatile("" ::: "memory");
        }
    }
#pragma unroll
    for (int dt = 0; dt < 8; ++dt) {
        u32x2 w; w.x = pk2(O0[dt][0] * inv0, O0[dt][1] * inv0); w.y = pk2(O0[dt][2] * inv0, O0[dt][3] * inv0); *(u32x2*)(o0 + 16 * dt) = w;
        u32x2 v; v.x = pk2(O1[dt][0] * inv1, O1[dt][1] * inv1); v.y = pk2(O1[dt][2] * inv1, O1[dt][3] * inv1); *(u32x2*)(o1 + 16 * dt) = v;
    }
}
__device__ __forceinline__ void xattn_phase(LAS unsigned char* lds, const bf16_t* QM, const bf16_t* KM, const bf16_t* VT, bf16_t* OM, const float* gmq, int bid, int G, int tid0) {
    const int wave = __builtin_amdgcn_readfirstlane(tid0 >> 6);
    LAS bf16_t* SB0 = (LAS bf16_t*)lds; LAS bf16_t* SB1 = (LAS bf16_t*)(lds + 67584);
    if (bid >= 1024) return;
    u32x4 pre[8];
    { const int u0 = bid; xattn_ld(pre, KM + (size_t)((u0 >> 5) * 4 + ((u0 >> 3) & 3)) * 65536, tid0); }
    for (int u = bid; u < 1024; u += G) {
        int tid_ = tid0; asm volatile("" : "+v"(tid_));
        const int tid = tid_, lane = tid & 63, fr = lane & 15, fq = lane >> 4;
        const int b = u >> 5, h = (u >> 3) & 3, qb = u & 7;
        const bf16_t* KMp = KM + (size_t)(b * 4 + h) * 65536; const bf16_t* VTp = VT + (size_t)(b * 4 + h) * 65536;
        const size_t trow = (size_t)b * SEQ + qb * 256 + 32 * wave + fr;
        xattn_st(SB0, pre, tid);
        bf16x8 Q0[8], Q1[8];
        xattn_q_frags(Q0, QM + trow * 1024 + h * 256 + fq * 8, gmq, fq);
        asm volatile("" ::: "memory");
        xattn_q_frags(Q1, QM + (trow + 16) * 1024 + h * 256 + fq * 8, gmq, fq);
        bf16x8 P0a[4], P0b[4], P1a[4], P1b[4];
        float m0, m1, sum0, sum1;
        LDS_BARRIER();
        m0 = 0.f; m1 = 0.f; sum0 = 0.f; sum1 = 0.f;
        xattn_sp_stage<true>(P0a, P1a, sum0, sum1, m0, m1, SB0, Q0, Q1, fr, fq);
        { u32x4 t1[8]; xattn_ld(t1, KMp + 128 * 256, tid); xattn_st(SB1, t1, tid); } LDS_BARRIER();
        xattn_sp_stage<false>(P0b, P1b, sum0, sum1, m0, m1, SB1, Q0, Q1, fr, fq);
        sum0 += __shfl_xor(sum0, 16); sum0 += __shfl_xor(sum0, 32); sum1 += __shfl_xor(sum1, 16); sum1 += __shfl_xor(sum1, 32);
        const float inv0 = __builtin_amdgcn_rcpf(sum0), inv1 = __builtin_amdgcn_rcpf(sum1);
        bf16_t* o0 = OM + trow * 1024 + h * 256 + 4 * fq; bf16_t* o1 = o0 + 16 * 1024;
        { u32x4 t2[8]; xattn_ld(t2, VTp, tid); xattn_st(SB0, t2, tid); } xattn_ld(pre, VTp + 128 * 256, tid); LDS_BARRIER();
        xattn_pv_stage(SB0, P0a, P0b, P1a, P1b, inv0, inv1, o0, o1, fr, fq);
        xattn_st(SB1, pre, tid);
        { const int un = u + G; if (un < 1024) xattn_ld(pre, KM + (size_t)((un >> 5) * 4 + ((un >> 3) & 3)) * 65536, tid); }
        LDS_BARRIER();
        xattn_pv_stage(SB1, P0a, P0b, P1a, P1b, inv0, inv1, o0 + 128, o1 + 128, fr, fq);
    }
}

#define XB_TMO      128
#define XB_XCNT(j)  (256  + 64 * (j))
#define XB_XSUB(j)  (1280 + 64 * (j))
#define XB_XGEN(j)  (2304 + 64 * (j))
#define XB_TOP      3328
#define XB_TOPGEN   3392
#define XCD_BAR_WORDS 3456
#define XB_SPIN_CAP (1u << 18)

__device__ __forceinline__ unsigned xb_ld(unsigned* p)              { return __hip_atomic_load(p, __ATOMIC_RELAXED, __HIP_MEMORY_SCOPE_AGENT); }
__device__ __forceinline__ unsigned xb_add(unsigned* p, unsigned v) { return __hip_atomic_fetch_add(p, v, __ATOMIC_RELAXED, __HIP_MEMORY_SCOPE_AGENT); }
__device__ __forceinline__ unsigned xb_xcc_id() { return (unsigned)__builtin_amdgcn_s_getreg((3 << 11) | 20) & 0xFu; }
#define XB_SPIN(cond, bar) do { unsigned _sp = 0; while (cond) { __builtin_amdgcn_s_sleep(1); \
    if ((++_sp & 255u) == 0u) { if (xb_ld(&(bar)[XB_TMO])) break; if (_sp > XB_SPIN_CAP) { atomicAdd(&(bar)[XB_TMO], 1u); break; } } } } while (0)

struct XcdBarrier {
    unsigned* bar; unsigned x;
    volatile LAS unsigned* st;
};

__device__ __forceinline__ XcdBarrier xcd_barrier_post(unsigned* bar, volatile LAS unsigned* st) {
    XcdBarrier b; b.bar = bar; b.x = xb_xcc_id(); b.st = st;
    if (threadIdx.x == 0) (void)xb_add(&bar[XB_XCNT(b.x)], 1u);
    return b;
}
__device__ __forceinline__ void xcd_barrier_complete(unsigned* bar, unsigned x, unsigned& nloc, unsigned& nx) {
    const unsigned G = gridDim.x * gridDim.y * gridDim.z;
    unsigned sum, cnt, mine, sp = 0u;
    for (;;) {
        sum = 0u; cnt = 0u; mine = 0u;
#pragma unroll
        for (unsigned j = 0; j < 16; ++j) { const unsigned c = xb_ld(&bar[XB_XCNT(j)]); sum += c; cnt += (c > 0u) ? 1u : 0u; mine = (j == x) ? c : mine; }
        if (sum == G) break;
        __builtin_amdgcn_s_sleep(1);
        if ((++sp & 255u) == 0u) { if (xb_ld(&bar[XB_TMO])) break; if (sp > XB_SPIN_CAP) { atomicAdd(&bar[XB_TMO], 1u); break; } }
    }
    nloc = mine > 0u ? mine : 1u; nx = cnt > 0u ? cnt : 1u;
}

__device__ __forceinline__ void xcd_barrier(const XcdBarrier& b) {
    asm volatile("s_waitcnt vmcnt(0)" ::: "memory");
    __syncthreads();
    if (threadIdx.x == 0) {
        unsigned* bar = b.bar;
        __builtin_amdgcn_s_waitcnt(0);
        unsigned nloc = b.st[0], nx = b.st[1];
        if (nloc == 0u) { xcd_barrier_complete(bar, b.x, nloc, nx); b.st[0] = nloc; b.st[1] = nx; }
        const unsigned old = xb_add(&bar[XB_XSUB(b.x)], 1u);
        const unsigned gen = old / nloc;
        if (old + 1u == (gen + 1u) * nloc) {
            __builtin_amdgcn_fence(__ATOMIC_RELEASE, "agent");
            asm volatile("s_waitcnt vmcnt(0)" ::: "memory");
            const unsigned og = xb_add(&bar[XB_TOP], 1u);
            const unsigned tg = og / nx;
            if (og + 1u == (tg + 1u) * nx) xb_add(&bar[XB_TOPGEN], 1u);
            else XB_SPIN(xb_ld(&bar[XB_TOPGEN]) == tg, bar);
            __builtin_amdgcn_fence(__ATOMIC_ACQUIRE, "agent");
            xb_add(&bar[XB_XGEN(b.x)], 1u);
            asm volatile("s_waitcnt vmcnt(0)" ::: "memory");
        } else {
            XB_SPIN(xb_ld(&bar[XB_XGEN(b.x)]) == gen, bar);
            __builtin_amdgcn_fence(__ATOMIC_ACQUIRE, "agent");
            asm volatile("s_waitcnt vmcnt(0)" ::: "memory");
        }
    }
    __syncthreads();
}

constexpr int N_PHASES = 4 + 18;
__global__ void __launch_bounds__(512, 2) mega_fwd(Params P) {
    extern __shared__ __attribute__((aligned(16))) unsigned char smem[];
    LAS unsigned char* lds = (LAS unsigned char*)smem;
    cg::grid_group grid = cg::this_grid();
    if (threadIdx.x < 8) ((LAS unsigned*)(lds + LDS_BYTES - 32))[threadIdx.x] = 0u;
    __syncthreads();
    const XcdBarrier xbar = xcd_barrier_post((unsigned*)(P.ws + WS_CTL) + CW_BAR, (volatile LAS unsigned*)(lds + LDS_BYTES - 32));
    grid.sync();
    for (int ph = 0; ph < N_PHASES; ++ph) {
        int tid_ = threadIdx.x, bid_ = blockIdx.x; asm volatile("" : "+v"(tid_)); asm volatile("" : "+s"(bid_));
        const int tid = tid_, bid = bid_, lane = tid & 63, wave = __builtin_amdgcn_readfirstlane(tid >> 6);
        const int G = gridDim.x, gw = bid * 8 + wave, NGW = G * 8;
        const int gtid = bid * 512 + tid, NGT = G * 512;
        unsigned char* ws = P.ws;
        bf16_t* Xb = (bf16_t*)(ws + WS_H); bf16_t* ZU = (bf16_t*)(ws + WS_ZU); bf16_t* YM = (bf16_t*)(ws + WS_YM); bf16_t* QM = (bf16_t*)(ws + WS_QM);
        bf16_t* OP = (bf16_t*)((unsigned char*)P.out + OUT_OP); float* LSE = (float*)((unsigned char*)P.out + OUT_LSE);
        bf16_t* MN = (bf16_t*)(ws + WS_MN); bf16_t* KVT = (bf16_t*)(ws + WS_KVT);
        const float* x_in = P.in[0]; float* X = P.out;
        bool is_gemm = false;
        pg8::Gemm gj{nullptr, nullptr, 0, 0, 0};
        pg8::EpiDyn E{0, true, nullptr, 0, nullptr, nullptr, nullptr};
        float* SS = (float*)(ws + WS_SS);
        if (ph == 0) {
            LAS float* scr = (LAS float*)(lds + wave * 16384);
            constexpr int NI_IN = 16 * 112, NI_SQ = 16 * 32, NI_MKV = 16 * 64, NI_FF1 = 16 * 128, NI_FF2 = 64 * 32;
            constexpr int NI_LAYER = NI_IN + 3 * NI_SQ + NI_MKV + NI_FF1 + NI_FF2;
            for (int it = gw; it < 2 * NI_LAYER; it += NGW) {
                const int l = it / NI_LAYER; int r = it % NI_LAYER;
                unsigned char* wb = ws + WS_WB + (size_t)l * WB_LAYER;
                if (r < NI_IN) { transpose_item(P.in[3] + (size_t)l * 1024 * 3584, 1024, 3584, (bf16_t*)(wb + WB_IN), scr, r, lane, P.in[2] + l * 1024); continue; } r -= NI_IN;
                if (r < NI_SQ) { transpose_item(P.in[8] + (size_t)l * 1024 * 1024, 1024, 1024, (bf16_t*)(wb + WB_OUT), scr, r, lane); continue; } r -= NI_SQ;
                if (r < NI_SQ) { transpose_item(P.in[11] + (size_t)l * 1024 * 1024, 1024, 1024, (bf16_t*)(wb + WB_MQ), scr, r, lane, P.in[9] + l * 1024); continue; } r -= NI_SQ;
                if (r < NI_MKV) { transpose_item(P.in[12] + (size_t)l * 1024 * 2048, 1024, 2048, (bf16_t*)(wb + WB_MKV), scr, r, lane); continue; } r -= NI_MKV;
                if (r < NI_SQ) { transpose_item(P.in[15] + (size_t)l * 1024 * 1024, 1024, 1024, (bf16_t*)(wb + WB_MO), scr, r, lane); continue; } r -= NI_SQ;
                if (r < NI_FF1) { transpose_item(P.in[17] + (size_t)l * 1024 * 4096, 1024, 4096, (bf16_t*)(wb + WB_FF1), scr, r, lane, P.in[16] + l * 1024); continue; } r -= NI_FF1;
                transpose_item(P.in[18] + (size_t)l * 4096 * 1024, 4096, 1024, (bf16_t*)(wb + WB_FF2), scr, r, lane);
            }
            for (int it = gw; it < 2 * NMEMROWS; it += NGW) { const int l = it / NMEMROWS, row = it % NMEMROWS; rms_row_1024(P.in[1] + (size_t)row * 1024, P.in[10] + l * 1024, MN + ((size_t)l * NMEMROWS + row) * 1024, lane); }
            for (int row = gw; row < T; row += NGW) prep_row_1024(x_in + (size_t)row * 1024, Xb + (size_t)row * 1024, SS + row, lane);
        } else if (ph <= 2) {
            const int l = ph - 1;
            gj = pg8::Gemm{MN + (size_t)l * NMEMROWS * 1024, (const bf16_t*)(ws + WS_WB + (size_t)l * WB_LAYER + WB_MKV), NMEMROWS, 2048, 1024};
            E = pg8::EpiDyn{0, true, KVT + (size_t)l * NMEMROWS * 2048, 2048, nullptr, nullptr, nullptr, nullptr, 0};
            is_gemm = true;
        } else if (ph == 3) {
            for (int it = gw; it < 2 * NMEMROWS * 4; it += NGW) {
                const int l = it / (NMEMROWS * 4), rem = it % (NMEMROWS * 4), row = rem >> 2, h = rem & 3;
                const bf16_t* src = KVT + ((size_t)l * NMEMROWS + row) * 2048 + h * 256 + lane * 4;
                const u32x2 w = *(const u32x2*)src;
                float f0 = bflo(w.x), f1 = bfhi(w.x), f2 = bflo(w.y), f3 = bfhi(w.y);
                const float rstd = 1.0f / sqrtf(wave_sum(f0 * f0 + f1 * f1 + f2 * f2 + f3 * f3) * (1.f / 256.f) + EPS);
                const f32x4 gv = *(const f32x4*)(P.in[14] + l * 256 + lane * 4);
                u32x2 o; o.x = pk2(f0 * rstd * gv.x, f1 * rstd * gv.y); o.y = pk2(f2 * rstd * gv.z, f3 * rstd * gv.w);
                bf16_t* dst = (bf16_t*)(ws + WS_KM + (size_t)l * KM_LAYER) + ((size_t)((row >> 8) * 4 + h) * 256 + (row & 255)) * 256 + lane * 4;
                *(u32x2*)dst = o;
            }
            for (int it = gtid; it < 2 * 32 * 4 * 32 * 256; it += NGT) {
                const int dd = it & 255, mg = (it >> 8) & 31, h = (it >> 13) & 3, b = (it >> 15) & 31, l = it >> 20;
                const bf16_t* src = KVT + ((size_t)l * NMEMROWS + b * 256 + mg * 8) * 2048 + 1024 + h * 256 + dd;
                u32x4 o;
                o.x = (unsigned)src[0 * 2048] | ((unsigned)src[1 * 2048] << 16); o.y = (unsigned)src[2 * 2048] | ((unsigned)src[3 * 2048] << 16);
                o.z = (unsigned)src[4 * 2048] | ((unsigned)src[5 * 2048] << 16); o.w = (unsigned)src[6 * 2048] | ((unsigned)src[7 * 2048] << 16);
                bf16_t* dst = (bf16_t*)(ws + WS_KM + (size_t)l * KM_LAYER + VT_OFF) + ((size_t)(b * 4 + h) * 256 + dd) * 256 + mg * 8;
                *(u32x4*)dst = o;
            }
        } else {
            const int l = (ph - 4) / 9, k = (ph - 4) % 9;
            const unsigned char* wb = ws + WS_WB + (size_t)l * WB_LAYER;
            const float* xcur = (l == 0) ? x_in : X;
            float* ssl = SS + (size_t)(3 * l) * T;
            if (k == 0) {
                gj = pg8::Gemm{Xb, (const bf16_t*)(wb + WB_IN), T, ZW, 1024}; E = pg8::EpiDyn{0, true, ZU, ZW, ssl, nullptr, nullptr, nullptr, 0}; is_gemm = true;
            } else if (k == 1) {
#if SKIP_HGRN
                for (int it = gtid; it < T * 64; it += NGT) { const int t = it >> 6, c8 = it & 63; *(u32x4*)(YM + (size_t)t * 1024 + 512 + c8 * 8) = (u32x4){0u, 0u, 0u, 0u}; }
#else
                for (int u = bid; u < 128; u += G) hgrn_unit(lds, ZU, YM, P.in[6], P.in[7] + l * 512, l, u, tid);
#endif
                int tid2 = tid; asm volatile("" : "+v"(tid2));
                if (!SKIP_ATTN) attn_loop(lds, ZU, OP, LSE, P.in[4] + l * 64, P.in[5] + l * 64, (unsigned*)(ws + WS_CTL) + 64 * (1 + l), tid2);
            } else if (k == 2) {
                for (int it = gtid; it < T * 64; it += NGT) {
                    const int t = it >> 6, c8 = it & 63, h = c8 >> 3;
                    if (SKIP_ATTN) { *(u32x4*)(YM + (size_t)t * 1024 + c8 * 8) = (u32x4){0u, 0u, 0u, 0u}; continue; }
                    const float l0 = LSE[((size_t)0 * T + t) * 8 + h], l1 = LSE[((size_t)1 * T + t) * 8 + h], l2 = LSE[((size_t)2 * T + t) * 8 + h];
                    const float mx = fmaxf(l0, fmaxf(l1, l2));
                    float w0 = __expf(l0 - mx), w1 = __expf(l1 - mx), w2 = __expf(l2 - mx);
                    const float inv = 1.0f / (w0 + w1 + w2); w0 *= inv; w1 *= inv; w2 *= inv;
                    float a[8], bq[8], cq[8];
                    unpack8(*(const u32x4*)(OP + ((size_t)0 * T + t) * 512 + c8 * 8), a);
                    unpack8(*(const u32x4*)(OP + ((size_t)1 * T + t) * 512 + c8 * 8), bq);
                    unpack8(*(const u32x4*)(OP + ((size_t)2 * T + t) * 512 + c8 * 8), cq);
#pragma unroll
                    for (int e = 0; e < 8; ++e) a[e] = w0 * a[e] + w1 * bq[e] + w2 * cq[e];
                    *(u32x4*)(YM + (size_t)t * 1024 + c8 * 8) = pack8(a);
                }
            } else if (k == 3) {
                gj = pg8::Gemm{YM, (const bf16_t*)(wb + WB_OUT), T, 1024, 1024}; E = pg8::EpiDyn{1, true, Xb, 1024, nullptr, ssl + T, nullptr, nullptr, 0}; is_gemm = true;
            } else if (k == 4) {
                gj = pg8::Gemm{Xb, (const bf16_t*)(wb + WB_MQ), T, 1024, 1024}; E = pg8::EpiDyn{0, true, QM, 1024, ssl + T, nullptr, nullptr, nullptr, 0}; is_gemm = true;
            } else if (k == 5) {
                const bf16_t* KM = (const bf16_t*)(ws + WS_KM + (size_t)l * KM_LAYER); const bf16_t* VT = (const bf16_t*)(ws + WS_KM + (size_t)l * KM_LAYER + VT_OFF);
#if SKIP_XATTN
                for (int it = gtid; it < T * 128; it += NGT) *(u32x4*)(YM + (size_t)it * 8) = (u32x4){0u, 0u, 0u, 0u};
#else
                xattn_phase(lds, QM, KM, VT, YM, P.in[13] + l * 256, bid, G, tid);
                __syncthreads();
#endif
            } else if (k == 6) {
                gj = pg8::Gemm{YM, (const bf16_t*)(wb + WB_MO), T, 1024, 1024}; E = pg8::EpiDyn{1, true, Xb, 1024, nullptr, ssl + 2 * T, nullptr, nullptr, 0}; is_gemm = true;
            } else if (k == 7) {
                gj = pg8::Gemm{Xb, (const bf16_t*)(wb + WB_FF1), T, DFF, 1024}; E = pg8::EpiDyn{2, true, ZU, DFF, ssl + 2 * T, nullptr, nullptr, nullptr, 0}; is_gemm = true;
            } else {
                gj = pg8::Gemm{ZU, (const bf16_t*)(wb + WB_FF2), T, 1024, DFF};
                E = pg8::EpiDyn{1, true, Xb, 1024, nullptr, l == 0 ? SS + (size_t)3 * T : nullptr, l == 1 ? X : nullptr, nullptr, 0}; is_gemm = true;
            }
        }
        if (is_gemm) {
            pg8::StaticOrder S; S.init(gj.M, gj.N, G, bid);
            if (E.ssin != nullptr) {
                pg8::Unit u0;
                if (S.next(0, u0)) {
                    LAS float* RS = (LAS float*)(lds + 131072);
                    for (int i = tid; i < 2048; i += 512) { const int pmx = u0.pm + 8 * (i >> 8); if (pmx < S.nM) RS[i] = 1.0f / sqrtf(E.ssin[pmx * 256 + (i & 255)] * (1.f / 1024.f) + EPS); }
                    E.rs = RS; E.pm0 = u0.pm;
                }
                __syncthreads();
            }
            pg8::gemm_phase<pg8::EpiDyn, pg8::StaticOrder, true, true>(lds, gj, S, E);
        }
        if (ph + 1 < N_PHASES) {
            asm volatile("s_waitcnt vmcnt(0) lgkmcnt(0)" ::: "memory");
            __syncthreads();
            xcd_barrier(xbar);
        }
    }
}

extern "C" void kernel_launch(void* const* d_in, const int* in_sizes, int n_in, void* d_out, int out_size, void* d_ws, size_t ws_size, hipStream_t stream) {
    static int grid = 0;
    if (grid == 0) {
        if (n_in != 19 || in_sizes[0] != T * DM || out_size != T * DM || ws_size < WS_END) {
            fprintf(stderr, "kernel_launch: unexpected shapes: n_in %d in0 %d out %d ws %zu (need %zu)\n", n_in, n_in > 0 ? in_sizes[0] : -1, out_size, ws_size, (size_t)WS_END);
            grid = -1; return;
        }
        int dev = 0, cus = 0, per_cu = 0;
        hipGetDevice(&dev);
        hipDeviceGetAttribute(&cus, hipDeviceAttributeMultiprocessorCount, dev);
        hipFuncSetAttribute((const void*)mega_fwd, hipFuncAttributeMaxDynamicSharedMemorySize, LDS_BYTES);
        hipOccupancyMaxActiveBlocksPerMultiprocessor(&per_cu, (const void*)mega_fwd, 512, LDS_BYTES);
        if (per_cu < 1) { fprintf(stderr, "kernel_launch: occupancy query returned %d\n", per_cu); per_cu = 1; }
        grid = cus * per_cu;
        (void)hipGetLastError();
    }
    if (grid < 0) return;
    hipMemsetAsync((char*)d_ws + WS_CTL, 0, CTL_BYTES, stream);
    Params p{};
    for (int i = 0; i < 19; ++i) p.in[i] = (const float*)d_in[i];
    p.out = (float*)d_out; p.ws = (unsigned char*)d_ws;
    void* args[] = {&p};
    hipError_t e = hipLaunchCooperativeKernel((const void*)mega_fwd, dim3(grid), dim3(512), args, LDS_BYTES, stream);
    if (e != hipSuccess) fprintf(stderr, "cooperative launch failed: %s (grid %d)\n", hipGetErrorString(e), grid);
}
```

```cpp
#include <hip/hip_runtime.h>
#include <hip/hip_cooperative_groups.h>
#include <cstdio>
#include <cstdint>
namespace cg = cooperative_groups;
namespace pg8 {
#define PG8_LAS __attribute__((address_space(3)))
typedef unsigned short bf16_t;
typedef short bf16x8 __attribute__((ext_vector_type(8)));
typedef float f32x4 __attribute__((ext_vector_type(4)));
typedef unsigned u32x4 __attribute__((ext_vector_type(4)));
constexpr int BM = 256, BK = 64, HALF = 128, HTB = HALF * BK * 2  , STAGE_BYTES = 8 * HTB, NXCD = 8, WGM = 8;

__host__ __device__ __forceinline__ int lds_byte(int r, int c) { const int st = (r >> 4) * 2 + (c >> 5), rr = r & 15, cc = c & 31, ob = rr * 64 + cc * 2; return st * 1024 + (ob ^ (((ob >> 9) & 1) << 5)); }
__host__ __device__ __forceinline__ void stage_rc(int b, int& R, int& C) { const int st = b / 1024, sb = b % 1024, swz = sb ^ (((sb >> 9) & 1) << 5); R = (st >> 1) * 16 + swz / 64; C = (st & 1) * 32 + (swz % 64) / 2; }
__host__ __device__ __forceinline__ int perm32(int rho) { const int n = rho >> 4, i = rho & 15; return 8 * (i >> 2) + 4 * n + (i & 3); }

struct Unit { int pm, pn; };
struct Gemm { const bf16_t* A; const bf16_t* Bt; int M, N, K; };

struct StaticOrder {
    int nM, nN, nwg, G, c;
    __host__ __device__ void init(int M, int N, int G_, int c_) { nM = M / BM; nN = N / BM; nwg = nM * nN; G = G_; c = c_; }
    __host__ __device__ bool next(int i, Unit& u) const {
        const long L = (long)i * G + c; if (L >= nwg) return false;
        int wgid = (int)L; { const int q = nwg / NXCD, r = nwg % NXCD, xcd = wgid % NXCD, off = wgid / NXCD; wgid = (xcd < r ? xcd * (q + 1) : r * (q + 1) + (xcd - r) * q) + off; }
        const int nig = WGM * nN, gid = wgid / nig, fm = gid * WGM, gsz = (nM - fm) < WGM ? (nM - fm) : WGM;
        u.pm = fm + ((wgid % nig) % gsz); u.pn = (wgid % nig) / gsz; return true;
    }
    __device__ __forceinline__ void a_ready(const Unit&) const {}
    __device__ __forceinline__ void done(const Unit&) const {}
};

typedef float f32x2 __attribute__((ext_vector_type(2)));
typedef __bf16 bf16x2_t __attribute__((ext_vector_type(2)));
__device__ __forceinline__ unsigned cvt_pk_bf16(float lo, float hi) { f32x2 v = {lo, hi}; bf16x2_t b = __builtin_convertvector(v, bf16x2_t); return __builtin_bit_cast(unsigned, b); }
typedef unsigned u32x2 __attribute__((ext_vector_type(2)));
struct EpiDyn {
    static constexpr bool AFTER_DRAIN = false;
    int mode; bool perm;
    bf16_t* O; int ldc;
    const float* ssin; float* ssn; float* outf;
    const PG8_LAS float* rs; int pm0;
    __device__ __forceinline__ void operator()(const f32x4 (&acc)[2][2][4][2], const Unit& u, int wr, int wc, int fr, int fq) const {
        const int row0 = u.pm * BM + wr * 64 + fr; const int col0 = u.pn * BM + wc * 32 + 8 * fq;
        if (mode == 1) {
            const bool nx = ssn != nullptr, fin = outf != nullptr;
#pragma unroll
            for (int ai = 0; ai < 2; ++ai)
#pragma unroll
                for (int m = 0; m < 4; ++m) { const int row = row0 + ai * HALF + m * 16; bf16_t* rowp = O + (size_t)row * ldc + col0; float ssq = 0.f;
#pragma unroll
                    for (int bj = 0; bj < 2; ++bj) { const u32x4 bw = *(const u32x4*)(rowp + bj * HALF);
                        f32x4 v0 = acc[ai][bj][m][0], v1 = acc[ai][bj][m][1];
                        v0[0] += __builtin_bit_cast(float, bw.x << 16); v0[1] += __builtin_bit_cast(float, bw.x & 0xffff0000u); v0[2] += __builtin_bit_cast(float, bw.y << 16); v0[3] += __builtin_bit_cast(float, bw.y & 0xffff0000u);
                        v1[0] += __builtin_bit_cast(float, bw.z << 16); v1[1] += __builtin_bit_cast(float, bw.z & 0xffff0000u); v1[2] += __builtin_bit_cast(float, bw.w << 16); v1[3] += __builtin_bit_cast(float, bw.w & 0xffff0000u);
                        ssq += (v0[0] * v0[0] + v0[1] * v0[1]) + (v0[2] * v0[2] + v0[3] * v0[3]) + (v1[0] * v1[0] + v1[1] * v1[1]) + (v1[2] * v1[2] + v1[3] * v1[3]);
                        if (fin) { float* op = outf + (size_t)row * ldc + col0 + bj * HALF; *(f32x4*)op = v0; *(f32x4*)(op + 4) = v1; }
                        else { u32x4 w; w.x = cvt_pk_bf16(v0[0], v0[1]); w.y = cvt_pk_bf16(v0[2], v0[3]); w.z = cvt_pk_bf16(v1[0], v1[1]); w.w = cvt_pk_bf16(v1[2], v1[3]); *(u32x4*)(rowp + bj * HALF) = w; } }
                    if (nx) { ssq += __shfl_xor(ssq, 16); ssq += __shfl_xor(ssq, 32); if (fq == 0) (void)__hip_atomic_fetch_add(ssn + row, ssq, __ATOMIC_RELAXED, __HIP_MEMORY_SCOPE_AGENT); } }
        } else {
            const bool sq = (mode == 2), scl = ssin != nullptr;
#pragma unroll
            for (int ai = 0; ai < 2; ++ai)
#pragma unroll
                for (int m = 0; m < 4; ++m) { const int row = row0 + ai * HALF + m * 16; bf16_t* rowp = O + (size_t)row * ldc + col0;
                    const float sc = rs ? rs[((u.pm - pm0) >> 3) * 256 + (row & 255)] : (scl ? 1.0f / sqrtf(ssin[row] * (1.f / 1024.f) + 1e-6f) : 1.0f);
#pragma unroll
                    for (int bj = 0; bj < 2; ++bj) { f32x4 v0 = acc[ai][bj][m][0] * sc, v1 = acc[ai][bj][m][1] * sc;
                        if (sq) {
#pragma unroll
                            for (int e = 0; e < 4; ++e) { float a = v0[e] > 0.f ? v0[e] : 0.f; v0[e] = a * a; float b = v1[e] > 0.f ? v1[e] : 0.f; v1[e] = b * b; } }
                        u32x4 w; w.x = cvt_pk_bf16(v0[0], v0[1]); w.y = cvt_pk_bf16(v0[2], v0[3]); w.z = cvt_pk_bf16(v1[0], v1[1]); w.w = cvt_pk_bf16(v1[2], v1[3]);
                        *(u32x4*)(rowp + bj * HALF) = w; } }
        }
    }
};
template <class Epi, class Sched, bool ALIGN_EPI = false, bool SP2 = false>
__device__ __forceinline__ void gemm_phase(PG8_LAS unsigned char* lds, const Gemm g, const Sched& S, const Epi& E) {
    int tid_ = threadIdx.x; asm volatile("" : "+v"(tid_)); const int tid = tid_, wid = __builtin_amdgcn_readfirstlane(tid >> 6), lane = tid & 63, wr = wid >> 2, wc = wid & 3, fr = lane & 15, fq = lane >> 4;
    const int K = g.K, nt = K / BK;
    unsigned voffA[2], voffB[2];
#pragma unroll
    for (int i = 0; i < 2; ++i) { int R, C; stage_rc(tid * 16 + i * 8192, R, C); const int Rb = E.perm ? ((R & ~31) + perm32(R & 31)) : R;
        voffA[i] = (unsigned)(R * K + C) * 2u; voffB[i] = (unsigned)(Rb * K + C) * 2u; }
    const size_t kstep = (size_t)(BK * 2);
    const size_t hstep = (size_t)HALF * K * 2;
    const size_t tstep = 2 * hstep;
    const unsigned ldsw = (unsigned)wid * 1024u;
    const int aoff = lds_byte(wr * 64 + fr, fq * 8), boff = lds_byte(wc * 32 + fr, fq * 8);
#define PG8_SA(b, h) (((b) * 2 + (h)) * HTB)
#define PG8_SB(b, h) ((4 + (b) * 2 + (h)) * HTB)
#define PG8_STAGE(bufoff, gbase, voff) do { _Pragma("unroll") for (int _i = 0; _i < 2; ++_i) \
        __builtin_amdgcn_global_load_lds((const unsigned*)((const char*)(gbase) + (voff)[_i]), (PG8_LAS unsigned*)(lds + (bufoff) + ldsw + _i * 8192), 16, 0, 0); } while (0)
#define PG8_LDA(dst, b, h) do { _Pragma("unroll") for (int m = 0; m < 4; ++m) _Pragma("unroll") for (int k = 0; k < 2; ++k) dst[m][k] = *(const PG8_LAS bf16x8*)(lds + PG8_SA(b, h) + aoff + m * 2048 + k * 1024); } while (0)
#define PG8_LDB(dst, b, h) do { _Pragma("unroll") for (int n = 0; n < 2; ++n) _Pragma("unroll") for (int k = 0; k < 2; ++k) dst[n][k] = *(const PG8_LAS bf16x8*)(lds + PG8_SB(b, h) + boff + n * 2048 + k * 1024); } while (0)
#define PG8_MMA(ai, bj, At, Bt) do { __builtin_amdgcn_s_setprio(1); _Pragma("unroll") for (int m = 0; m < 4; ++m) _Pragma("unroll") for (int n = 0; n < 2; ++n) _Pragma("unroll") for (int k = 0; k < 2; ++k) \
        acc[ai][bj][m][n] = __builtin_amdgcn_mfma_f32_16x16x32_bf16(Bt[n][k], At[m][k], acc[ai][bj][m][n], 0, 0, 0); __builtin_amdgcn_s_setprio(0); } while (0)
#define PG8_WAIT_V(n) asm volatile("s_waitcnt vmcnt(" #n ")" ::: "memory")
#define PG8_WAIT_L(n) asm volatile("s_waitcnt lgkmcnt(" #n ")" ::: "memory")
#define PG8_BAR __builtin_amdgcn_s_barrier()
#define PG8_SCHED __builtin_amdgcn_sched_barrier(0)
    Unit cur, nxt; int ui = 0;
    if (!S.next(0, cur)) return;
    f32x4 acc[2][2][4][2];
#pragma unroll
    for (int a = 0; a < 2; ++a)
#pragma unroll
        for (int b = 0; b < 2; ++b)
#pragma unroll
            for (int m = 0; m < 4; ++m)
#pragma unroll
                for (int n = 0; n < 2; ++n) acc[a][b][m][n] = (f32x4){0.f, 0.f, 0.f, 0.f};
    bf16x8 At[4][2], B0[2][2], B1[2][2];
    const char* cA = (const char*)g.A + (size_t)cur.pm * tstep; const char* cB = (const char*)g.Bt + (size_t)cur.pn * tstep;
    S.a_ready(cur);
    if constexpr (SP2) {
        PG8_STAGE(PG8_SB(0, 0), cB, voffB); PG8_STAGE(PG8_SB(0, 1), cB + hstep, voffB); PG8_STAGE(PG8_SA(0, 0), cA, voffA); PG8_STAGE(PG8_SA(0, 1), cA + hstep, voffA);
        if (wr == 1) PG8_BAR;
        PG8_WAIT_V(2); PG8_BAR;
        PG8_STAGE(PG8_SB(1, 0), cB + kstep, voffB); PG8_STAGE(PG8_SA(1, 0), cA + kstep, voffA); PG8_STAGE(PG8_SB(1, 1), cB + hstep + kstep, voffB);
        PG8_WAIT_V(6); PG8_BAR;
    } else {
        PG8_STAGE(PG8_SB(0, 0), cB, voffB); PG8_STAGE(PG8_SA(0, 0), cA, voffA); PG8_STAGE(PG8_SB(0, 1), cB + hstep, voffB); PG8_STAGE(PG8_SA(0, 1), cA + hstep, voffA);
        if (wr == 1) PG8_BAR;
        PG8_WAIT_V(4); PG8_BAR;
        PG8_STAGE(PG8_SB(1, 0), cB + kstep, voffB); PG8_STAGE(PG8_SA(1, 0), cA + kstep, voffA); PG8_STAGE(PG8_SB(1, 1), cB + hstep + kstep, voffB);
        PG8_WAIT_V(6); PG8_BAR;
    }
    for (;;) {
        const bool has_next = S.next(ui + 1, nxt);
        const char* nA = has_next ? (const char*)g.A + (size_t)nxt.pm * tstep : cA; const char* nB = has_next ? (const char*)g.Bt + (size_t)nxt.pn * tstep : cB;
        for (int t = 0; t < nt; t += 2) {
            const bool last = (t == nt - 2);
            const char* a1 = cA + (size_t)(t + 1) * kstep;
            const char* a2 = last ? nA : cA + (size_t)(t + 2) * kstep; const char* b2 = last ? nB : cB + (size_t)(t + 2) * kstep;
            const char* a3 = a2 + kstep; const char* b3 = b2 + kstep;
            if (last && has_next) S.a_ready(nxt);
            if constexpr (SP2) {
            PG8_LDB(B0, 0, 0); PG8_LDB(B1, 0, 1); PG8_SCHED; PG8_LDA(At, 0, 0); PG8_STAGE(PG8_SA(1, 1), a1 + hstep, voffA);
            PG8_WAIT_V(8); PG8_WAIT_L(0); PG8_BAR; PG8_MMA(0, 0, At, B0); PG8_MMA(0, 1, At, B1); PG8_BAR; PG8_SCHED;
            PG8_LDA(At, 0, 1); PG8_STAGE(PG8_SB(0, 0), b2, voffB); PG8_STAGE(PG8_SB(0, 1), b2 + hstep, voffB); PG8_STAGE(PG8_SA(0, 0), a2, voffA);
            PG8_WAIT_V(8); PG8_WAIT_L(0); PG8_BAR; PG8_MMA(1, 0, At, B0); PG8_MMA(1, 1, At, B1); PG8_BAR; PG8_SCHED;
            PG8_LDB(B0, 1, 0); PG8_LDB(B1, 1, 1); PG8_SCHED; PG8_LDA(At, 1, 0); PG8_STAGE(PG8_SA(0, 1), a2 + hstep, voffA);
            PG8_WAIT_V(8); PG8_WAIT_L(0); PG8_BAR; PG8_MMA(0, 0, At, B0); PG8_MMA(0, 1, At, B1); PG8_BAR; PG8_SCHED;
            PG8_LDA(At, 1, 1); PG8_STAGE(PG8_SB(1, 0), b3, voffB); PG8_STAGE(PG8_SB(1, 1), b3 + hstep, voffB); PG8_STAGE(PG8_SA(1, 0), a3, voffA);
            PG8_WAIT_V(8); PG8_WAIT_L(0); PG8_BAR; PG8_MMA(1, 0, At, B0); PG8_MMA(1, 1, At, B1); PG8_BAR; PG8_SCHED;
            } else {
            PG8_LDB(B0, 0, 0); PG8_SCHED; PG8_LDA(At, 0, 0); PG8_STAGE(PG8_SA(1, 1), a1 + hstep, voffA);
            PG8_WAIT_L(8); PG8_BAR; PG8_WAIT_L(0); PG8_MMA(0, 0, At, B0); PG8_BAR; PG8_SCHED;
            PG8_LDB(B1, 0, 1); PG8_STAGE(PG8_SB(0, 0), b2, voffB);
            PG8_BAR; PG8_WAIT_L(0); PG8_MMA(0, 1, At, B1); PG8_BAR;
            PG8_LDA(At, 0, 1); PG8_STAGE(PG8_SA(0, 0), a2, voffA);
            PG8_BAR; PG8_WAIT_L(0); PG8_MMA(1, 0, At, B0); PG8_BAR; PG8_SCHED;
            PG8_STAGE(PG8_SB(0, 1), b2 + hstep, voffB);
            PG8_WAIT_V(6); PG8_BAR; PG8_MMA(1, 1, At, B1); PG8_BAR;
            PG8_LDB(B0, 1, 0); PG8_SCHED; PG8_LDA(At, 1, 0); PG8_STAGE(PG8_SA(0, 1), a2 + hstep, voffA);
            PG8_WAIT_L(8); PG8_BAR; PG8_WAIT_L(0); PG8_MMA(0, 0, At, B0); PG8_BAR; PG8_SCHED;
            PG8_LDB(B1, 1, 1); PG8_STAGE(PG8_SB(1, 0), b3, voffB);
            PG8_BAR; PG8_WAIT_L(0); PG8_MMA(0, 1, At, B1); PG8_BAR;
            PG8_LDA(At, 1, 1); PG8_STAGE(PG8_SA(1, 0), a3, voffA);
            PG8_BAR; PG8_WAIT_L(0); PG8_MMA(1, 0, At, B0); PG8_BAR; PG8_SCHED;
            PG8_STAGE(PG8_SB(1, 1), b3 + hstep, voffB);
            PG8_WAIT_V(6); PG8_BAR; PG8_MMA(1, 1, At, B1); PG8_BAR;
            }
        }
        if constexpr (ALIGN_EPI) { if (wr == 0) PG8_BAR; }
        if constexpr (!Epi::AFTER_DRAIN) { E(acc, cur, wr, wc, fr, fq); S.done(cur); }
        if (!has_next) break;
#pragma unroll
        for (int a = 0; a < 2; ++a)
#pragma unroll
            for (int b = 0; b < 2; ++b)
#pragma unroll
                for (int m = 0; m < 4; ++m)
#pragma unroll
                    for (int n = 0; n < 2; ++n) acc[a][b][m][n] = (f32x4){0.f, 0.f, 0.f, 0.f};
        cur = nxt; cA = nA; cB = nB; ++ui;
        if constexpr (ALIGN_EPI) { if (wr == 1) PG8_BAR; }
    }
    PG8_WAIT_V(0);
    if constexpr (!ALIGN_EPI) { if (wr == 0) PG8_BAR; }
    PG8_BAR;
    if constexpr (Epi::AFTER_DRAIN) { E.fused(acc, cur, wr, wc, fr, fq, lds, wid, lane); S.done(cur); }
#undef PG8_SA
#undef PG8_SB
#undef PG8_STAGE
#undef PG8_LDA
#undef PG8_LDB
#undef PG8_MMA
#undef PG8_WAIT_V
#undef PG8_WAIT_L
#undef PG8_BAR
#undef PG8_SCHED
}
}

#define LAS __attribute__((address_space(3)))
typedef unsigned short bf16_t;
typedef short bf16x8 __attribute__((ext_vector_type(8)));
typedef float f32x4 __attribute__((ext_vector_type(4)));
typedef unsigned u32x4 __attribute__((ext_vector_type(4)));
typedef unsigned u32x2 __attribute__((ext_vector_type(2)));

constexpr int T = 65536, DM = 1024, SEQ = 2048, NBATCH = 32, ZW = 3584, DFF = 4096, NMEMROWS = 8192;
constexpr float EPS = 1e-6f, LOG2E = 1.4426950408889634f, LN2 = 0.6931471805599453f;
constexpr size_t MiB = 1u << 20;
constexpr size_t WS_CTL = 0, CTL_BYTES = 2 * MiB;
constexpr size_t WS_SS = 256 * 1024;
constexpr int CW_BAR = 2048;
constexpr size_t WS_WB = 2 * MiB, WB_LAYER = 36 * MiB;
constexpr size_t WB_IN = 0, WB_OUT = 7 * MiB, WB_MQ = 9 * MiB, WB_MKV = 11 * MiB, WB_MO = 15 * MiB, WB_FF1 = 17 * MiB, WB_FF2 = 25 * MiB;
constexpr size_t WS_KM = 74 * MiB, KM_LAYER = 32 * MiB, VT_OFF = 16 * MiB;
constexpr size_t WS_YM = 138 * MiB, WS_ZU = 266 * MiB, WS_H = 778 * MiB;
constexpr size_t WS_MN = WS_ZU, WS_KVT = WS_ZU + 32 * MiB;
constexpr size_t WS_QM = WS_ZU;
constexpr size_t WS_END = WS_H + 128 * MiB;
constexpr size_t OUT_OP = 0, OUT_LSE = 192 * MiB;
constexpr int LDS_BYTES = 147456;
constexpr int N_ATT_UNITS = NBATCH * 8 * 48;

#ifndef SKIP_HGRN
#define SKIP_HGRN 0
#endif
#ifndef SKIP_ATTN
#define SKIP_ATTN 0
#endif
#ifndef SKIP_XATTN
#define SKIP_XATTN 0
#endif
struct Params { const float* in[19]; float* out; unsigned char* ws; };

__device__ __forceinline__ unsigned f2bf(float f) { unsigned u = __builtin_bit_cast(unsigned, f); return (u + 0x7fffu + ((u >> 16) & 1u)) >> 16; }
__device__ __forceinline__ unsigned pk2(float lo, float hi) { return pg8::cvt_pk_bf16(lo, hi); }
__device__ __forceinline__ float bflo(unsigned w) { return __builtin_bit_cast(float, w << 16); }
__device__ __forceinline__ float bfhi(unsigned w) { return __builtin_bit_cast(float, w & 0xffff0000u); }
__device__ __forceinline__ void unpack8(const u32x4 w, float (&f)[8]) {
    f[0] = bflo(w.x); f[1] = bfhi(w.x); f[2] = bflo(w.y); f[3] = bfhi(w.y); f[4] = bflo(w.z); f[5] = bfhi(w.z); f[6] = bflo(w.w); f[7] = bfhi(w.w);
}
__device__ __forceinline__ u32x4 pack8(const float (&f)[8]) { u32x4 w; w.x = pk2(f[0], f[1]); w.y = pk2(f[2], f[3]); w.z = pk2(f[4], f[5]); w.w = pk2(f[6], f[7]); return w; }
__device__ __forceinline__ float wave_sum(float v) {
#pragma unroll
    for (int o = 1; o < 64; o <<= 1) v += __shfl_xor(v, o);
    return v;
}
#define DPPF(v, ctrl) __builtin_bit_cast(float, __builtin_amdgcn_mov_dpp(__builtin_bit_cast(int, (v)), (ctrl), 0xF, 0xF, true))
__device__ __forceinline__ float sum8_dpp(float v) { v += DPPF(v, 0xB1); v += DPPF(v, 0x4E); v += DPPF(v, 0x141); return v; }
__device__ __forceinline__ float sum16_dpp(float v) { v = sum8_dpp(v); v += DPPF(v, 0x128); return v; }
#define MFMA16(a, b, c) __builtin_amdgcn_mfma_f32_16x16x32_bf16((a), (b), (c), 0, 0, 0)
#define LDS_WAIT() asm volatile("s_waitcnt lgkmcnt(0)" ::: "memory")
#define LDS_BARRIER() do { asm volatile("s_waitcnt lgkmcnt(0)" ::: "memory"); __builtin_amdgcn_s_barrier(); asm volatile("" ::: "memory"); } while (0)

__device__ __forceinline__ void transpose_item(const float* W, int K, int N, bf16_t* WT, LAS float* scr, int item, int lane, const float* g = nullptr) {
    const int nblk = N / 32, kb = item / nblk, nb = item % nblk, k0 = 64 * kb, n0 = 32 * nb;
#pragma unroll 8
    for (int i = 0; i < 32; ++i) { const int kk = 2 * i + (lane >> 5); scr[kk * 33 + (lane & 31)] = W[(size_t)(k0 + kk) * N + n0 + (lane & 31)] * (g ? g[k0 + kk] : 1.0f); }
    LDS_WAIT();
    const int c = lane & 7;
#pragma unroll
    for (int j = 0; j < 4; ++j) { const int n = (lane >> 3) + 8 * j; const LAS float* s = scr + (8 * c) * 33 + n;
        u32x4 o; o.x = pk2(s[0 * 33], s[1 * 33]); o.y = pk2(s[2 * 33], s[3 * 33]); o.z = pk2(s[4 * 33], s[5 * 33]); o.w = pk2(s[6 * 33], s[7 * 33]);
        *(u32x4*)(WT + (size_t)(n0 + n) * K + k0 + 8 * c) = o; }
    LDS_WAIT();
}
__device__ __forceinline__ void rms_row_1024(const float* xrow, const float* g, bf16_t* orow, int lane) {
    const f32x4* xr = (const f32x4*)xrow + lane; const f32x4* gr = (const f32x4*)g + lane;
    f32x4 v[4]; float s = 0.f;
#pragma unroll
    for (int j = 0; j < 4; ++j) { v[j] = xr[64 * j]; s += (v[j].x * v[j].x + v[j].y * v[j].y) + (v[j].z * v[j].z + v[j].w * v[j].w); }
    const float rstd = 1.0f / sqrtf(wave_sum(s) * (1.f / 1024.f) + EPS);
    u32x2* o8 = (u32x2*)orow + lane;
#pragma unroll
    for (int j = 0; j < 4; ++j) { const f32x4 gv = gr[64 * j]; u32x2 w; w.x = pk2(v[j].x * rstd * gv.x, v[j].y * rstd * gv.y); w.y = pk2(v[j].z * rstd * gv.z, v[j].w * rstd * gv.w); o8[64 * j] = w; }
}

__device__ __forceinline__ void prep_row_1024(const float* xrow, bf16_t* orow, float* ssp, int lane) {
    const f32x4* xr = (const f32x4*)xrow + lane;
    float s = 0.f; u32x2* o8 = (u32x2*)orow + lane;
#pragma unroll
    for (int j = 0; j < 4; ++j) { const f32x4 v = xr[64 * j]; s += (v.x * v.x + v.y * v.y) + (v.z * v.z + v.w * v.w);
        u32x2 w; w.x = pk2(v.x, v.y); w.y = pk2(v.z, v.w); o8[64 * j] = w; }
    s = wave_sum(s);
    if (lane == 0) *ssp = s;
}

struct AttnU { int b, h, p, d, r, n; };
__device__ __forceinline__ AttnU attn_decode(int u) {
    AttnU U; const int bh = u / 48, s48 = u % 48, idx = s48 & 15; U.b = bh >> 3; U.h = bh & 7; U.p = s48 >> 4;
    if (U.p == 0) { U.d = 1; U.r = 0; U.n = idx; } else if (U.p == 1) { U.d = 4; U.r = idx & 3; U.n = idx >> 2; } else { U.d = 16; U.r = idx; U.n = 0; }
    return U;
}
struct AttnRegs { u32x4 kw[4], vw[4], q0, q1; };
__device__ __forceinline__ void attn_load(AttnRegs& R, const bf16_t* Z, const AttnU& U, int tid) {
    const int wave = tid >> 6, lane = tid & 63, fr = lane & 15, fq = lane >> 4;
    const size_t rowbase = (size_t)U.b * SEQ;
#pragma unroll
    for (int it = 0; it < 4; ++it) {
        const int c = tid + 512 * it, row = c >> 3, ch = c & 7, lk = 128 * (U.n - 1) + row;
        R.kw[it] = (u32x4){0u, 0u, 0u, 0u}; R.vw[it] = (u32x4){0u, 0u, 0u, 0u};
        if (lk >= 0) { const bf16_t* zr = Z + (rowbase + (size_t)(lk * U.d + U.r)) * ZW + U.h * 64 + ch * 8; R.kw[it] = *(const u32x4*)(zr + 512); R.vw[it] = *(const u32x4*)(zr + 1024); }
    }
    const int qi = 16 * wave + fr, posq = (128 * U.n + qi) * U.d + U.r;
    const bf16_t* zq = Z + (rowbase + (size_t)posq) * ZW + U.h * 64;
    R.q0 = *(const u32x4*)(zq + fq * 8); R.q1 = *(const u32x4*)(zq + 32 + fq * 8);
}
__device__ __forceinline__ void attn_stage(LAS unsigned char* lds, const AttnRegs& R, const float* gq, const float* gk, int tid, bf16x8& Q0, bf16x8& Q1) {
    const int lane = tid & 63, fq = lane >> 4;
    LAS bf16_t* Ks = (LAS bf16_t*)lds; LAS bf16_t* Vt = (LAS bf16_t*)(lds + 36864);
#pragma unroll
    for (int it = 0; it < 4; ++it) {
        const int c = tid + 512 * it, row = c >> 3, ch = c & 7;
        const u32x4 vw = R.vw[it];
        float kf[8]; unpack8(R.kw[it], kf);
        float ss = 0.f;
#pragma unroll
        for (int e = 0; e < 8; ++e) ss += kf[e] * kf[e];
        ss = sum8_dpp(ss);
        const float rstd = __builtin_amdgcn_rsqf(ss * (1.f / 64.f) + EPS);
        const f32x4 g0 = *(const f32x4*)(gk + ch * 8), g1 = *(const f32x4*)(gk + ch * 8 + 4);
        kf[0] *= rstd * g0.x; kf[1] *= rstd * g0.y; kf[2] *= rstd * g0.z; kf[3] *= rstd * g0.w; kf[4] *= rstd * g1.x; kf[5] *= rstd * g1.y; kf[6] *= rstd * g1.z; kf[7] *= rstd * g1.w;
        *(LAS u32x4*)(Ks + row * 72 + ch * 8) = pack8(kf);
        LAS bf16_t* vt = Vt + (ch * 8) * 264 + 8 * ch + row;
        vt[0 * 264] = (bf16_t)(vw.x & 0xffffu); vt[1 * 264] = (bf16_t)(vw.x >> 16); vt[2 * 264] = (bf16_t)(vw.y & 0xffffu); vt[3 * 264] = (bf16_t)(vw.y >> 16);
        vt[4 * 264] = (bf16_t)(vw.z & 0xffffu); vt[5 * 264] = (bf16_t)(vw.z >> 16); vt[6 * 264] = (bf16_t)(vw.w & 0xffffu); vt[7 * 264] = (bf16_t)(vw.w >> 16);
    }
    float a[8], c[8]; unpack8(R.q0, a); unpack8(R.q1, c);
    float ss = 0.f;
#pragma unroll
    for (int e = 0; e < 8; ++e) ss += a[e] * a[e] + c[e] * c[e];
    ss += __shfl_xor(ss, 16); ss += __shfl_xor(ss, 32);
    const float sc = __builtin_amdgcn_rsqf(ss * (1.f / 64.f) + EPS) * (0.125f * LOG2E);
#pragma unroll
    for (int e = 0; e < 8; ++e) { a[e] *= sc * gq[fq * 8 + e]; c[e] *= sc * gq[32 + fq * 8 + e]; }
    Q0 = __builtin_bit_cast(bf16x8, pack8(a)); Q1 = __builtin_bit_cast(bf16x8, pack8(c));
}
__device__ __forceinline__ void attn_compute(LAS unsigned char* lds, const AttnU& U, const bf16x8 Q0, const bf16x8 Q1, bf16_t* OP, float* LSE, int tid) {
    const int wave = __builtin_amdgcn_readfirstlane(tid >> 6), lane = tid & 63, fr = lane & 15, fq = lane >> 4;
    const int b = U.b, h = U.h, p = U.p, d = U.d, r = U.r, n = U.n;
    LAS bf16_t* Ks = (LAS bf16_t*)lds;
    LAS bf16_t* Vt = (LAS bf16_t*)(lds + 36864);
    LAS bf16_t* Ps = (LAS bf16_t*)(lds + 70784) + wave * (16 * 168);
    const size_t rowbase = (size_t)b * SEQ;
    const int qi = 16 * wave + fr, posq = (128 * n + qi) * d + r;
    const int start = wave < 6 ? 16 * wave : 96, i0 = 16 * wave;
    const float slope2 = exp2f(-(float)(h + 1)) * (float)d * LOG2E;
    const float fbase = (float)(qi + 128 - start - 4 * fq);
    f32x4 S[10]; bool dead[10];
    float m = -1e30f;
#pragma unroll
    for (int t = 0; t < 10; ++t) {
        const int k0 = start + 16 * t;
        dead[t] = (k0 > i0 + 143) || (k0 + 15 < i0) || (n == 0 && k0 + 15 < 128);
        const bool full = (k0 >= i0 + 15) && (k0 + 15 <= i0 + 128) && (n > 0 || k0 >= 128);
        if (dead[t]) { S[t] = (f32x4){-1e30f, -1e30f, -1e30f, -1e30f}; }
        else {
            const LAS bf16_t* kp = Ks + (k0 + fr) * 72 + fq * 8;
            const bf16x8 a0 = *(const LAS bf16x8*)kp, a1 = *(const LAS bf16x8*)(kp + 32);
            f32x4 acc = (f32x4){0.f, 0.f, 0.f, 0.f};
            acc = MFMA16(a0, Q0, acc); acc = MFMA16(a1, Q1, acc);
            if (full) {
#pragma unroll
                for (int j = 0; j < 4; ++j) { const float v = acc[j] - slope2 * (fbase - (float)(16 * t + j)); acc[j] = v; m = fmaxf(m, v); }
            } else {
#pragma unroll
                for (int j = 0; j < 4; ++j) {
                    const int kj = k0 + 4 * fq + j, step = qi + 128 - kj, lk = 128 * (n - 1) + kj;
                    const bool valid = (step >= 0) && (step <= 128) && (lk >= 0);
                    const float v = valid ? acc[j] - slope2 * (float)step : -1e30f;
                    acc[j] = v; m = fmaxf(m, v);
                }
            }
            S[t] = acc;
        }
    }
    m = fmaxf(m, __shfl_xor(m, 16)); m = fmaxf(m, __shfl_xor(m, 32));
    float sum = 0.f;
    u32x2 pw[10];
#pragma unroll
    for (int t = 0; t < 10; ++t) {
        u32x2 w = (u32x2){0u, 0u};
        if (!dead[t]) {
            float pe[4];
#pragma unroll
            for (int j = 0; j < 4; ++j) { pe[j] = __builtin_amdgcn_exp2f(S[t][j] - m); sum += pe[j]; }
            w.x = pk2(pe[0], pe[1]); w.y = pk2(pe[2], pe[3]);
        }
        pw[t] = w;
    }
    sum += __shfl_xor(sum, 16); sum += __shfl_xor(sum, 32);
    f32x4 O[4];
#pragma unroll
    for (int dt = 0; dt < 4; ++dt) O[dt] = (f32x4){0.f, 0.f, 0.f, 0.f};
#pragma unroll
    for (int kc = 0; kc < 5; ++kc) {
        if (dead[2 * kc] && dead[2 * kc + 1]) continue;
        const u32x4 pq = (u32x4){pw[2 * kc].x, pw[2 * kc].y, pw[2 * kc + 1].x, pw[2 * kc + 1].y};
        const bf16x8 pb = __builtin_bit_cast(bf16x8, pq);
#pragma unroll
        for (int dt = 0; dt < 4; ++dt) {
            const LAS bf16_t* vp = Vt + fr * 264 + 8 * (fr >> 3) + start + 4 * fq + dt * (16 * 264 + 16) + 32 * kc;
            const u32x2 lo = *(const LAS u32x2*)vp, hi = *(const LAS u32x2*)(vp + 16);
            const u32x4 vw = (u32x4){lo.x, lo.y, hi.x, hi.y};
            O[dt] = MFMA16(__builtin_bit_cast(bf16x8, vw), pb, O[dt]);
        }
    }
    const float inv = __builtin_amdgcn_rcpf(sum);
    const size_t trow = rowbase + (size_t)posq;
    bf16_t* op = OP + ((size_t)p * T + trow) * 512 + h * 64 + 4 * fq;
#pragma unroll
    for (int dt = 0; dt < 4; ++dt) { u32x2 w; w.x = pk2(O[dt][0] * inv, O[dt][1] * inv); w.y = pk2(O[dt][2] * inv, O[dt][3] * inv); *(u32x2*)(op + 16 * dt) = w; }
    if (fq == 0) LSE[((size_t)p * T + trow) * 8 + h] = (m + __builtin_amdgcn_logf(sum)) * LN2;
}
constexpr int ATT_IMG = 70784;
__device__ __forceinline__ void attn_loop(LAS unsigned char* lds, const bf16_t* Z, bf16_t* OP, float* LSE, const float* gq, const float* gk, unsigned* ctr, int tid) {
    LAS int* sh = (LAS int*)(lds + LDS_BYTES - 64);
    __syncthreads();
    if (tid == 0) {
        const int a0 = (int)__hip_atomic_fetch_add(ctr, 1u, __ATOMIC_RELAXED, __HIP_MEMORY_SCOPE_AGENT), a1 = (int)__hip_atomic_fetch_add(ctr, 1u, __ATOMIC_RELAXED, __HIP_MEMORY_SCOPE_AGENT), a2 = (int)__hip_atomic_fetch_add(ctr, 1u, __ATOMIC_RELAXED, __HIP_MEMORY_SCOPE_AGENT);
        sh[0] = a0; sh[1] = a1; sh[2] = a2;
    }
    __syncthreads();
    int u0 = __builtin_amdgcn_readfirstlane(sh[0]), u1 = __builtin_amdgcn_readfirstlane(sh[1]), u2 = __builtin_amdgcn_readfirstlane(sh[2]);
    __syncthreads();
    if (u0 >= N_ATT_UNITS) return;
    AttnRegs R;
    bf16x8 Qc0, Qc1;
    { const AttnU U = attn_decode(u0); attn_load(R, Z, U, tid); attn_stage(lds, R, gq, gk, tid, Qc0, Qc1); }
    if (u1 < N_ATT_UNITS) { const AttnU U = attn_decode(u1); attn_load(R, Z, U, tid); }
    LDS_BARRIER();
    int bsel = 0;
    while (u0 < N_ATT_UNITS) {
        int nn = 0;
        if (tid == 0) nn = (int)__hip_atomic_fetch_add(ctr, 1u, __ATOMIC_RELAXED, __HIP_MEMORY_SCOPE_AGENT);
        { const AttnU U = attn_decode(u0); attn_compute(lds + bsel * ATT_IMG, U, Qc0, Qc1, OP, LSE, tid); }
        bf16x8 Qn0 = Qc0, Qn1 = Qc1;
        if (u1 < N_ATT_UNITS) attn_stage(lds + (bsel ^ 1) * ATT_IMG, R, gq, gk, tid, Qn0, Qn1);
        if (u2 < N_ATT_UNITS) { const AttnU U = attn_decode(u2); attn_load(R, Z, U, tid); }
        if (tid == 0) sh[4 + bsel] = nn;
        LDS_BARRIER();
        u0 = u1; u1 = u2; u2 = __builtin_amdgcn_readfirstlane(sh[4 + bsel]); Qc0 = Qn0; Qc1 = Qn1; bsel ^= 1;
    }
}

__device__ __forceinline__ void hgrn_unit(LAS unsigned char* lds, const bf16_t* Z, bf16_t* YM, const float* hg_lb, const float* gon, int layer, int u, int tid) {
    const int wave = __builtin_amdgcn_readfirstlane(tid >> 6), lane = tid & 63, fr = lane & 15, fq = lane >> 4;
    const int b = u >> 2, hh = u & 3, tt = tid >> 4, kg = (tid & 15) * 8;
    LAS float*  LG  = (LAS float*)lds;
    LAS bf16_t* QdS = (LAS bf16_t*)(lds + 16384);
    LAS bf16_t* KdS = (LAS bf16_t*)(lds + 25088);
    LAS bf16_t* QeS = (LAS bf16_t*)(lds + 33792);
    LAS bf16_t* KlT = (LAS bf16_t*)(lds + 42496);
    LAS bf16_t* iT  = (LAS bf16_t*)(lds + 52736);
    LAS bf16_t* ScS = (LAS bf16_t*)(lds + 62976);
    LAS bf16_t* StS = (LAS bf16_t*)(lds + 65536);
    LAS float*  DEC = (LAS float*)(lds + 100352);
    LAS float*  OS  = (LAS float*)(lds + 100864);
    LAS float*  LBS = (LAS float*)(lds + 117760);
    LAS float*  GOS = (LAS float*)(lds + 118272);
    if (tid < 128) { const int c = hh * 128 + tid; LBS[tid] = layer == 0 ? 0.f : 1.0f / (1.0f + __expf(hg_lb[c] - hg_lb[512 + c])); GOS[tid] = gon[c]; }
    for (int i = tid; i < 34816 / 4; i += 512) ((LAS unsigned*)(lds + 65536))[i] = 0u;
    f32x4 St[8];
#pragma unroll
    for (int kt = 0; kt < 8; ++kt) St[kt] = (f32x4){0.f, 0.f, 0.f, 0.f};
    __syncthreads();
    const bf16_t* zb = Z + ((size_t)b * SEQ) * ZW + hh * 128 + kg;
    u32x4 nq, nf, ni, ng;
    { const bf16_t* zr = zb + (size_t)tt * ZW; nq = *(const u32x4*)(zr + 1536); nf = *(const u32x4*)(zr + 2048); ni = *(const u32x4*)(zr + 2560); ng = *(const u32x4*)(zr + 3072); }
    for (int c = 0; c < 64; ++c) {
        const u32x4 cq = nq, cf = nf, ci = ni, cgt = ng;
        if (c + 1 < 64) { const bf16_t* zr = zb + (size_t)((c + 1) * 32 + tt) * ZW; nq = *(const u32x4*)(zr + 1536); nf = *(const u32x4*)(zr + 2048); ni = *(const u32x4*)(zr + 2560); ng = *(const u32x4*)(zr + 3072); }
        float qs[8], kk[8], bc[8];
        { float qv[8], fv[8]; unpack8(cq, qv); unpack8(cf, fv);
          const f32x4 lb0 = *(const LAS f32x4*)(LBS + kg), lb1 = *(const LAS f32x4*)(LBS + kg + 4);
          const float lbv[8] = {lb0.x, lb0.y, lb0.z, lb0.w, lb1.x, lb1.y, lb1.z, lb1.w};
#pragma unroll
          for (int e = 0; e < 8; ++e) {
              qs[e] = qv[e] * __builtin_amdgcn_rcpf(1.0f + __expf(-qv[e]));
              const float ef = __expf(-fv[e]), sg = __builtin_amdgcn_rcpf(1.0f + ef);
              const float f = lbv[e] + (1.0f - lbv[e]) * sg;
              float v = __logf(fmaxf(f, 1e-12f));
              kk[e] = (1.0f - lbv[e]) * ef * sg;
              const float x1 = __shfl_up(v, 16); if (fq >= 1) v += x1;
              const float x2 = __shfl_up(v, 32); if (fq >= 2) v += x2;
              bc[e] = v;
          } }
        if (fq == 3) { *(LAS f32x4*)(LG + wave * 128 + kg) = (f32x4){bc[0], bc[1], bc[2], bc[3]}; *(LAS f32x4*)(LG + wave * 128 + kg + 4) = (f32x4){bc[4], bc[5], bc[6], bc[7]}; }
        LDS_BARRIER();
        float bl[8], br[8];
#pragma unroll
        for (int e = 0; e < 8; ++e) { bl[e] = 0.f; br[e] = 0.f; }
#pragma unroll 1
        for (int w2 = 0; w2 < 8; ++w2) {
            const f32x4 v0 = *(const LAS f32x4*)(LG + w2 * 128 + kg), v1 = *(const LAS f32x4*)(LG + w2 * 128 + kg + 4);
            const float vv[8] = {v0.x, v0.y, v0.z, v0.w, v1.x, v1.y, v1.z, v1.w};
            const float inc = w2 < wave ? 1.f : 0.f;
#pragma unroll
            for (int e = 0; e < 8; ++e) { bl[e] += vv[e]; bc[e] += inc * vv[e]; }
            if (w2 == 3) {
#pragma unroll
                for (int e = 0; e < 8; ++e) br[e] = bl[e];
            }
        }
        {
            float qd[8], kd[8], qe[8], kl[8];
#pragma unroll
            for (int e = 0; e < 8; ++e) { qd[e] = qs[e] * __expf(bc[e] - br[e]); kd[e] = kk[e] * __expf(br[e] - bc[e]); qe[e] = qs[e] * __expf(bc[e]); kl[e] = kk[e] * __expf(bl[e] - bc[e]); }
            *(LAS u32x4*)(QdS + tt * 136 + kg) = pack8(qd);
            *(LAS u32x4*)(KdS + tt * 136 + kg) = pack8(kd);
            *(LAS u32x4*)(QeS + tt * 136 + kg) = pack8(qe);
            const u32x4 klw = pack8(kl);
            const int tsw = (((tt >> 3) ^ ((kg >> 3) & 3)) << 3) | (tt & 7);
            LAS bf16_t* kp = KlT + kg * 40 + tsw; LAS bf16_t* ip = iT + kg * 40 + tsw;
            kp[0 * 40] = (bf16_t)(klw.x & 0xffffu); kp[1 * 40] = (bf16_t)(klw.x >> 16); kp[2 * 40] = (bf16_t)(klw.y & 0xffffu); kp[3 * 40] = (bf16_t)(klw.y >> 16);
            kp[4 * 40] = (bf16_t)(klw.z & 0xffffu); kp[5 * 40] = (bf16_t)(klw.z >> 16); kp[6 * 40] = (bf16_t)(klw.w & 0xffffu); kp[7 * 40] = (bf16_t)(klw.w >> 16);
            ip[0 * 40] = (bf16_t)(ci.x & 0xffffu); ip[1 * 40] = (bf16_t)(ci.x >> 16); ip[2 * 40] = (bf16_t)(ci.y & 0xffffu); ip[3 * 40] = (bf16_t)(ci.y >> 16);
            ip[4 * 40] = (bf16_t)(ci.z & 0xffffu); ip[5 * 40] = (bf16_t)(ci.z >> 16); ip[6 * 40] = (bf16_t)(ci.w & 0xffffu); ip[7 * 40] = (bf16_t)(ci.w >> 16);
            if (tt == 0) { *(LAS f32x4*)(DEC + kg) = (f32x4){__expf(bl[0]), __expf(bl[1]), __expf(bl[2]), __expf(bl[3])}; *(LAS f32x4*)(DEC + kg + 4) = (f32x4){__expf(bl[4]), __expf(bl[5]), __expf(bl[6]), __expf(bl[7])}; }
        }
        LDS_BARRIER();
        if (wave < 4) {
            const int tr = wave >> 1, sc = wave & 1;
            f32x4 acc = (f32x4){0.f, 0.f, 0.f, 0.f};
#pragma unroll
            for (int ks = 0; ks < 4; ++ks) { const bf16x8 a = *(const LAS bf16x8*)(QdS + (16 * tr + fr) * 136 + 32 * ks + fq * 8), bb = *(const LAS bf16x8*)(KdS + (16 * sc + fr) * 136 + 32 * ks + fq * 8); acc = MFMA16(a, bb, acc); }
#pragma unroll
            for (int j = 0; j < 4; ++j) { const int t = 16 * tr + 4 * fq + j, s = 16 * sc + fr; ScS[t * 40 + s] = (bf16_t)f2bf(s <= t ? acc[j] : 0.f); }
        }
        f32x4 o0 = (f32x4){0.f, 0.f, 0.f, 0.f}, o1 = (f32x4){0.f, 0.f, 0.f, 0.f};
#pragma unroll
        for (int ks = 0; ks < 4; ++ks) {
            const bf16x8 bb = *(const LAS bf16x8*)(StS + (16 * wave + fr) * 136 + 32 * ks + fq * 8);
            const bf16x8 a0 = *(const LAS bf16x8*)(QeS + fr * 136 + 32 * ks + fq * 8), a1 = *(const LAS bf16x8*)(QeS + (16 + fr) * 136 + 32 * ks + fq * 8);
            o0 = MFMA16(a0, bb, o0); o1 = MFMA16(a1, bb, o1);
        }
        LDS_BARRIER();
        {
            const bf16x8 bb = *(const LAS bf16x8*)(iT + (16 * wave + fr) * 40 + ((fq ^ (((16 * wave + fr) >> 3) & 3)) << 3));
            const bf16x8 a0 = *(const LAS bf16x8*)(ScS + fr * 40 + fq * 8), a1 = *(const LAS bf16x8*)(ScS + (16 + fr) * 40 + fq * 8);
            o0 = MFMA16(a0, bb, o0); o1 = MFMA16(a1, bb, o1);
#pragma unroll
            for (int j = 0; j < 4; ++j) { OS[(4 * fq + j) * 132 + 16 * wave + fr] = o0[j]; OS[(16 + 4 * fq + j) * 132 + 16 * wave + fr] = o1[j]; }
#pragma unroll
            for (int kt = 0; kt < 8; ++kt) {
                const bf16x8 a = *(const LAS bf16x8*)(KlT + (16 * kt + fr) * 40 + ((fq ^ (((16 * kt + fr) >> 3) & 3)) << 3));
                const f32x4 dec = *(const LAS f32x4*)(DEC + 16 * kt + 4 * fq);
                f32x4 sv = St[kt] * dec; sv = MFMA16(a, bb, sv); St[kt] = sv;
                u32x2 w; w.x = pk2(sv[0], sv[1]); w.y = pk2(sv[2], sv[3]);
                *(LAS u32x2*)(StS + (16 * wave + fr) * 136 + 16 * kt + 4 * fq) = w;
            }
        }
        LDS_BARRIER();
        {
            const f32x4 x0 = *(const LAS f32x4*)(OS + tt * 132 + kg), x1 = *(const LAS f32x4*)(OS + tt * 132 + kg + 4);
            float ov[8] = {x0.x, x0.y, x0.z, x0.w, x1.x, x1.y, x1.z, x1.w};
            float ss = 0.f;
#pragma unroll
            for (int e = 0; e < 8; ++e) ss += ov[e] * ov[e];
            ss = sum16_dpp(ss);
            const float rstd = __builtin_amdgcn_rsqf(ss * (1.f / 128.f) + EPS);
            float gv[8]; unpack8(cgt, gv);
            const f32x4 go0 = *(const LAS f32x4*)(GOS + kg), go1 = *(const LAS f32x4*)(GOS + kg + 4);
            const float gov[8] = {go0.x, go0.y, go0.z, go0.w, go1.x, go1.y, go1.z, go1.w};
#pragma unroll
            for (int e = 0; e < 8; ++e) ov[e] = ov[e] * rstd * gov[e] * (gv[e] * __builtin_amdgcn_rcpf(1.0f + __expf(-gv[e])));
            *(u32x4*)(YM + ((size_t)b * SEQ + c * 32 + tt) * 1024 + 512 + hh * 128 + kg) = pack8(ov);
        }
    }
    __syncthreads();
}

__device__ __forceinline__ void xattn_ld(u32x4 (&pre)[8], const bf16_t* src, int tid) {
#pragma unroll
    for (int it = 0; it < 8; ++it) { const int c = tid + 512 * it, row = c >> 5, ch = c & 31; pre[it] = *(const u32x4*)(src + row * 256 + ch * 8); }
}
__device__ __forceinline__ void xattn_st(LAS bf16_t* dst, const u32x4 (&pre)[8], int tid) {
    int t_ = tid; asm volatile("" : "+v"(t_));
    LAS bf16_t* p = dst + (t_ >> 5) * 264 + (t_ & 31) * 8;
#pragma unroll
    for (int it = 0; it < 8; ++it) *(LAS u32x4*)(p + it * (16 * 264)) = pre[it];
}
__device__ __forceinline__ void xattn_q_frags(bf16x8 (&Q)[8], const bf16_t* qp, const float* gmq, int fq) {
    u32x4 qw[8]; float ss = 0.f;
#pragma unroll
    for (int ks = 0; ks < 8; ++ks) { qw[ks] = *(const u32x4*)(qp + 32 * ks); float f[8]; unpack8(qw[ks], f);
#pragma unroll
        for (int e = 0; e < 8; ++e) ss += f[e] * f[e]; }
    ss += __shfl_xor(ss, 16); ss += __shfl_xor(ss, 32);
    const float sc = __builtin_amdgcn_rsqf(ss * (1.f / 256.f) + EPS) * (0.0625f * LOG2E);
#pragma unroll
    for (int ks = 0; ks < 8; ++ks) { float f[8]; unpack8(qw[ks], f); const f32x4 g0 = *(const f32x4*)(gmq + 32 * ks + fq * 8), g1 = *(const f32x4*)(gmq + 32 * ks + fq * 8 + 4);
        f[0] *= sc * g0.x; f[1] *= sc * g0.y; f[2] *= sc * g0.z; f[3] *= sc * g0.w; f[4] *= sc * g1.x; f[5] *= sc * g1.y; f[6] *= sc * g1.z; f[7] *= sc * g1.w;
        Q[ks] = __builtin_bit_cast(bf16x8, pack8(f)); }
}
template <bool FIRST>
__device__ __forceinline__ void xattn_sp_stage(bf16x8 (&P0)[4], bf16x8 (&P1)[4], float& sum0, float& sum1, float& m0, float& m1, const LAS bf16_t* SB, const bf16x8 (&Q0)[8], const bf16x8 (&Q1)[8], int fr, int fq) {
#pragma unroll
    for (int kc = 0; kc < 4; ++kc) {
        f32x4 a00 = (f32x4){0.f, 0.f, 0.f, 0.f}, a01 = a00, a10 = a00, a11 = a00;
#pragma unroll
        for (int ks = 0; ks < 8; ++ks) {
            const bf16x8 ka = *(const LAS bf16x8*)(SB + (32 * kc + fr) * 264 + 32 * ks + fq * 8), kb = *(const LAS bf16x8*)(SB + (32 * kc + 16 + fr) * 264 + 32 * ks + fq * 8);
            a00 = MFMA16(ka, Q0[ks], a00); a10 = MFMA16(ka, Q1[ks], a10); a01 = MFMA16(kb, Q0[ks], a01); a11 = MFMA16(kb, Q1[ks], a11);
        }
        if (FIRST && kc == 0) {
            float x0 = fmaxf(fmaxf(a00[0], a00[1]), fmaxf(a00[2], a00[3])), x1 = fmaxf(fmaxf(a10[0], a10[1]), fmaxf(a10[2], a10[3]));
            x0 = fmaxf(x0, __shfl_xor(x0, 16)); x0 = fmaxf(x0, __shfl_xor(x0, 32)); x1 = fmaxf(x1, __shfl_xor(x1, 16)); x1 = fmaxf(x1, __shfl_xor(x1, 32));
            m0 = x0; m1 = x1;
        }
        float pe[8], pf[8];
#pragma unroll
        for (int j = 0; j < 4; ++j) { pe[j] = __builtin_amdgcn_exp2f(a00[j] - m0); pe[4 + j] = __builtin_amdgcn_exp2f(a01[j] - m0); pf[j] = __builtin_amdgcn_exp2f(a10[j] - m1); pf[4 + j] = __builtin_amdgcn_exp2f(a11[j] - m1); }
#pragma unroll
        for (int e = 0; e < 8; ++e) { sum0 += pe[e]; sum1 += pf[e]; }
        P0[kc] = __builtin_bit_cast(bf16x8, pack8(pe)); P1[kc] = __builtin_bit_cast(bf16x8, pack8(pf));
        asm volatile("" ::: "memory");
    }
}
__device__ __forceinline__ void xattn_pv_stage(const LAS bf16_t* SB, const bf16x8 (&P0a)[4], const bf16x8 (&P0b)[4], const bf16x8 (&P1a)[4], const bf16x8 (&P1b)[4], float inv0, float inv1, bf16_t* o0, bf16_t* o1, int fr, int fq) {
    f32x4 O0[8], O1[8];
#pragma unroll
    for (int dt = 0; dt < 8; ++dt) { O0[dt] = (f32x4){0.f, 0.f, 0.f, 0.f}; O1[dt] = (f32x4){0.f, 0.f, 0.f, 0.f}; }
#pragma unroll
    for (int kc = 0; kc < 8; ++kc) {
        const bf16x8 p0 = kc < 4 ? P0a[kc & 3] : P0b[kc & 3], p1 = kc < 4 ? P1a[kc & 3] : P1b[kc & 3];
#pragma unroll
        for (int dt = 0; dt < 8; ++dt) {
            const LAS bf16_t* vp = SB + (16 * dt + fr) * 264 + 32 * kc + 4 * fq;
            const u32x2 lo = *(const LAS u32x2*)vp, hi = *(const LAS u32x2*)(vp + 16);
            const u32x4 w = (u32x4){lo.x, lo.y, hi.x, hi.y};
            const bf16x8 va = __builtin_bit_cast(bf16x8, w);
            O0[dt] = MFMA16(va, p0, O0[dt]); O1[dt] = MFMA16(va, p1, O1[dt]);
            if (dt == 7) asm volatile("" ::: "memory");
        }
    }
#pragma unroll
    for (int dt = 0; dt < 8; ++dt) {
        u32x2 w; w.x = pk2(O0[dt][0] * inv0, O0[dt][1] * inv0); w.y = pk2(O0[dt][2] * inv0, O0[dt][3] * inv0); *(u32x2*)(o0 + 16 * dt) = w;
        u32x2 v; v.x = pk2(O1[dt][0] * inv1, O1[dt][1] * inv1); v.y = pk2(O1[dt][2] * inv1, O1[dt][3] * inv1); *(u32x2*)(o1 + 16 * dt) = v;
    }
}
__device__ __forceinline__ void xattn_phase(LAS unsigned char* lds, const bf16_t* QM, const bf16_t* KM, const bf16_t* VT, bf16_t* OM, const float* gmq, int bid, int G, int tid0) {
    const int wave = __builtin_amdgcn_readfirstlane(tid0 >> 6);
    LAS bf16_t* SB0 = (LAS bf16_t*)lds; LAS bf16_t* SB1 = (LAS bf16_t*)(lds + 67584);
    if (bid >= 1024) return;
    u32x4 pre[8];
    { const int u0 = bid; xattn_ld(pre, KM + (size_t)((u0 >> 5) * 4 + ((u0 >> 3) & 3)) * 65536, tid0); }
    for (int u = bid; u < 1024; u += G) {
        int tid_ = tid0; asm volatile("" : "+v"(tid_));
        const int tid = tid_, lane = tid & 63, fr = lane & 15, fq = lane >> 4;
        const int b = u >> 5, h = (u >> 3) & 3, qb = u & 7;
        const bf16_t* KMp = KM + (size_t)(b * 4 + h) * 65536; const bf16_t* VTp = VT + (size_t)(b * 4 + h) * 65536;
        const size_t trow = (size_t)b * SEQ + qb * 256 + 32 * wave + fr;
        xattn_st(SB0, pre, tid);
        bf16x8 Q0[8], Q1[8];
        xattn_q_frags(Q0, QM + trow * 1024 + h * 256 + fq * 8, gmq, fq);
        asm volatile("" ::: "memory");
        xattn_q_frags(Q1, QM + (trow + 16) * 1024 + h * 256 + fq * 8, gmq, fq);
        bf16x8 P0a[4], P0b[4], P1a[4], P1b[4];
        float m0, m1, sum0, sum1;
        LDS_BARRIER();
        m0 = 0.f; m1 = 0.f; sum0 = 0.f; sum1 = 0.f;
        xattn_sp_stage<true>(P0a, P1a, sum0, sum1, m0, m1, SB0, Q0, Q1, fr, fq);
        { u32x4 t1[8]; xattn_ld(t1, KMp + 128 * 256, tid); xattn_st(SB1, t1, tid); } LDS_BARRIER();
        xattn_sp_stage<false>(P0b, P1b, sum0, sum1, m0, m1, SB1, Q0, Q1, fr, fq);
        sum0 += __shfl_xor(sum0, 16); sum0 += __shfl_xor(sum0, 32); sum1 += __shfl_xor(sum1, 16); sum1 += __shfl_xor(sum1, 32);
        const float inv0 = __builtin_amdgcn_rcpf(sum0), inv1 = __builtin_amdgcn_rcpf(sum1);
        bf16_t* o0 = OM + trow * 1024 + h * 256 + 4 * fq; bf16_t* o1 = o0 + 16 * 1024;
        { u32x4 t2[8]; xattn_ld(t2, VTp, tid); xattn_st(SB0, t2, tid); } xattn_ld(pre, VTp + 128 * 256, tid); LDS_BARRIER();
        xattn_pv_stage(SB0, P0a, P0b, P1a, P1b, inv0, inv1, o0, o1, fr, fq);
        xattn_st(SB1, pre, tid);
        { const int un = u + G; if (un < 1024) xattn_ld(pre, KM + (size_t)((un >> 5) * 4 + ((un >> 3) & 3)) * 65536, tid); }
        LDS_BARRIER();
        xattn_pv_stage(SB1, P0a, P0b, P1a, P1b, inv0, inv1, o0 + 128, o1 + 128, fr, fq);
    }
}

#define XB_TMO      128
#define XB_XCNT(j)  (256  + 64 * (j))
#define XB_XSUB(j)  (1280 + 64 * (j))
#define XB_XGEN(j)  (2304 + 64 * (j))
#define XB_TOP      3328
#define XB_TOPGEN   3392
#define XCD_BAR_WORDS 3456
#define XB_SPIN_CAP (1u << 18)

__device__ __forceinline__ unsigned xb_ld(unsigned* p)              { return __hip_atomic_load(p, __ATOMIC_RELAXED, __HIP_MEMORY_SCOPE_AGENT); }
__device__ __forceinline__ unsigned xb_add(unsigned* p, unsigned v) { return __hip_atomic_fetch_add(p, v, __ATOMIC_RELAXED, __HIP_MEMORY_SCOPE_AGENT); }
__device__ __forceinline__ unsigned xb_xcc_id() { return (unsigned)__builtin_amdgcn_s_getreg((3 << 11) | 20) & 0xFu; }
#define XB_SPIN(cond, bar) do { unsigned _sp = 0; while (cond) { __builtin_amdgcn_s_sleep(1); \
    if ((++_sp & 255u) == 0u) { if (xb_ld(&(bar)[XB_TMO])) break; if (_sp > XB_SPIN_CAP) { atomicAdd(&(bar)[XB_TMO], 1u); break; } } } } while (0)

struct XcdBarrier {
    unsigned* bar; unsigned x;
    volatile LAS unsigned* st;
};

__device__ __forceinline__ XcdBarrier xcd_barrier_post(unsigned* bar, volatile LAS unsigned* st) {
    XcdBarrier b; b.bar = bar; b.x = xb_xcc_id(); b.st = st;
    if (threadIdx.x == 0) (void)xb_add(&bar[XB_XCNT(b.x)], 1u);
    return b;
}
__device__ __forceinline__ void xcd_barrier_complete(unsigned* bar, unsigned x, unsigned& nloc, unsigned& nx) {
    const unsigned G = gridDim.x * gridDim.y * gridDim.z;
    unsigned sum, cnt, mine, sp = 0u;
    for (;;) {
        sum = 0u; cnt = 0u; mine = 0u;
#pragma unroll
        for (unsigned j = 0; j < 16; ++j) { const unsigned c = xb_ld(&bar[XB_XCNT(j)]); sum += c; cnt += (c > 0u) ? 1u : 0u; mine = (j == x) ? c : mine; }
        if (sum == G) break;
        __builtin_amdgcn_s_sleep(1);
        if ((++sp & 255u) == 0u) { if (xb_ld(&bar[XB_TMO])) break; if (sp > XB_SPIN_CAP) { atomicAdd(&bar[XB_TMO], 1u); break; } }
    }
    nloc = mine > 0u ? mine : 1u; nx = cnt > 0u ? cnt : 1u;
}

__device__ __forceinline__ void xcd_barrier(const XcdBarrier& b) {
    asm volatile("s_waitcnt vmcnt(0)" ::: "memory");
    __syncthreads();
    if (threadIdx.x == 0) {
        unsigned* bar = b.bar;
        __builtin_amdgcn_s_waitcnt(0);
        unsigned nloc = b.st[0], nx = b.st[1];
        if (nloc == 0u) { xcd_barrier_complete(bar, b.x, nloc, nx); b.st[0] = nloc; b.st[1] = nx; }
        const unsigned old = xb_add(&bar[XB_XSUB(b.x)], 1u);
        const unsigned gen = old / nloc;
        if (old + 1u == (gen + 1u) * nloc) {
            __builtin_amdgcn_fence(__ATOMIC_RELEASE, "agent");
            asm volatile("s_waitcnt vmcnt(0)" ::: "memory");
            const unsigned og = xb_add(&bar[XB_TOP], 1u);
            const unsigned tg = og / nx;
            if (og + 1u == (tg + 1u) * nx) xb_add(&bar[XB_TOPGEN], 1u);
            else XB_SPIN(xb_ld(&bar[XB_TOPGEN]) == tg, bar);
            __builtin_amdgcn_fence(__ATOMIC_ACQUIRE, "agent");
            xb_add(&bar[XB_XGEN(b.x)], 1u);
            asm volatile("s_waitcnt vmcnt(0)" ::: "memory");
        } else {
            XB_SPIN(xb_ld(&bar[XB_XGEN(b.x)]) == gen, bar);
            __builtin_amdgcn_fence(__ATOMIC_ACQUIRE, "agent");
            asm volatile("s_waitcnt vmcnt(0)" ::: "memory");
        }
    }
    __syncthreads();
}

constexpr int N_PHASES = 4 + 18;
__global__ void __launch_bounds__(512, 2) mega_fwd(Params P) {
    extern __shared__ __attribute__((aligned(16))) unsigned char smem[];
    LAS unsigned char* lds = (LAS unsigned char*)smem;
    cg::grid_group grid = cg::this_grid();
    if (threadIdx.x < 8) ((LAS unsigned*)(lds + LDS_BYTES - 32))[threadIdx.x] = 0u;
    __syncthreads();
    const XcdBarrier xbar = xcd_barrier_post((unsigned*)(P.ws + WS_CTL) + CW_BAR, (volatile LAS unsigned*)(lds + LDS_BYTES - 32));
    grid.sync();
    for (int ph = 0; ph < N_PHASES; ++ph) {
        int tid_ = threadIdx.x, bid_ = blockIdx.x; asm volatile("" : "+v"(tid_)); asm volatile("" : "+s"(bid_));
        const int tid = tid_, bid = bid_, lane = tid & 63, wave = __builtin_amdgcn_readfirstlane(tid >> 6);
        const int G = gridDim.x, gw = bid * 8 + wave, NGW = G * 8;
        const int gtid = bid * 512 + tid, NGT = G * 512;
        unsigned char* ws = P.ws;
        bf16_t* Xb = (bf16_t*)(ws + WS_H); bf16_t* ZU = (bf16_t*)(ws + WS_ZU); bf16_t* YM = (bf16_t*)(ws + WS_YM); bf16_t* QM = (bf16_t*)(ws + WS_QM);
        bf16_t* OP = (bf16_t*)((unsigned char*)P.out + OUT_OP); float* LSE = (float*)((unsigned char*)P.out + OUT_LSE);
        bf16_t* MN = (bf16_t*)(ws + WS_MN); bf16_t* KVT = (bf16_t*)(ws + WS_KVT);
        const float* x_in = P.in[0]; float* X = P.out;
        bool is_gemm = false;
        pg8::Gemm gj{nullptr, nullptr, 0, 0, 0};
        pg8::EpiDyn E{0, true, nullptr, 0, nullptr, nullptr, nullptr};
        float* SS = (float*)(ws + WS_SS);
        if (ph == 0) {
            LAS float* scr = (LAS float*)(lds + wave * 16384);
            constexpr int NI_IN = 16 * 112, NI_SQ = 16 * 32, NI_MKV = 16 * 64, NI_FF1 = 16 * 128, NI_FF2 = 64 * 32;
            constexpr int NI_LAYER = NI_IN + 3 * NI_SQ + NI_MKV + NI_FF1 + NI_FF2;
            for (int it = gw; it < 2 * NI_LAYER; it += NGW) {
                const int l = it / NI_LAYER; int r = it % NI_LAYER;
                unsigned char* wb = ws + WS_WB + (size_t)l * WB_LAYER;
                if (r < NI_IN) { transpose_item(P.in[3] + (size_t)l * 1024 * 3584, 1024, 3584, (bf16_t*)(wb + WB_IN), scr, r, lane, P.in[2] + l * 1024); continue; } r -= NI_IN;
                if (r < NI_SQ) { transpose_item(P.in[8] + (size_t)l * 1024 * 1024, 1024, 1024, (bf16_t*)(wb + WB_OUT), scr, r, lane); continue; } r -= NI_SQ;
                if (r < NI_SQ) { transpose_item(P.in[11] + (size_t)l * 1024 * 1024, 1024, 1024, (bf16_t*)(wb + WB_MQ), scr, r, lane, P.in[9] + l * 1024); continue; } r -= NI_SQ;
                if (r < NI_MKV) { transpose_item(P.in[12] + (size_t)l * 1024 * 2048, 1024, 2048, (bf16_t*)(wb + WB_MKV), scr, r, lane); continue; } r -= NI_MKV;
                if (r < NI_SQ) { transpose_item(P.in[15] + (size_t)l * 1024 * 1024, 1024, 1024, (bf16_t*)(wb + WB_MO), scr, r, lane); continue; } r -= NI_SQ;
                if (r < NI_FF1) { transpose_item(P.in[17] + (size_t)l * 1024 * 4096, 1024, 4096, (bf16_t*)(wb + WB_FF1), scr, r, lane, P.in[16] + l * 1024); continue; } r -= NI_FF1;
                transpose_item(P.in[18] + (size_t)l * 4096 * 1024, 4096, 1024, (bf16_t*)(wb + WB_FF2), scr, r, lane);
            }
            for (int it = gw; it < 2 * NMEMROWS; it += NGW) { const int l = it / NMEMROWS, row = it % NMEMROWS; rms_row_1024(P.in[1] + (size_t)row * 1024, P.in[10] + l * 1024, MN + ((size_t)l * NMEMROWS + row) * 1024, lane); }
            for (int row = gw; row < T; row += NGW) prep_row_1024(x_in + (size_t)row * 1024, Xb + (size_t)row * 1024, SS + row, lane);
        } else if (ph <= 2) {
            const int l = ph - 1;
            gj = pg8::Gemm{MN + (size_t)l * NMEMROWS * 1024, (const bf16_t*)(ws + WS_WB + (size_t)l * WB_LAYER + WB_MKV), NMEMROWS, 2048, 1024};
            E = pg8::EpiDyn{0, true, KVT + (size_t)l * NMEMROWS * 2048, 2048, nullptr, nullptr, nullptr, nullptr, 0};
            is_gemm = true;
        } else if (ph == 3) {
            for (int it = gw; it < 2 * NMEMROWS * 4; it += NGW) {
                const int l = it / (NMEMROWS * 4), rem = it % (NMEMROWS * 4), row = rem >> 2, h = rem & 3;
                const bf16_t* src = KVT + ((size_t)l * NMEMROWS + row) * 2048 + h * 256 + lane * 4;
                const u32x2 w = *(const u32x2*)src;
                float f0 = bflo(w.x), f1 = bfhi(w.x), f2 = bflo(w.y), f3 = bfhi(w.y);
                const float rstd = 1.0f / sqrtf(wave_sum(f0 * f0 + f1 * f1 + f2 * f2 + f3 * f3) * (1.f / 256.f) + EPS);
                const f32x4 gv = *(const f32x4*)(P.in[14] + l * 256 + lane * 4);
                u32x2 o; o.x = pk2(f0 * rstd * gv.x, f1 * rstd * gv.y); o.y = pk2(f2 * rstd * gv.z, f3 * rstd * gv.w);
                bf16_t* dst = (bf16_t*)(ws + WS_KM + (size_t)l * KM_LAYER) + ((size_t)((row >> 8) * 4 + h) * 256 + (row & 255)) * 256 + lane * 4;
                *(u32x2*)dst = o;
            }
            for (int it = gtid; it < 2 * 32 * 4 * 32 * 256; it += NGT) {
                const int dd = it & 255, mg = (it >> 8) & 31, h = (it >> 13) & 3, b = (it >> 15) & 31, l = it >> 20;
                const bf16_t* src = KVT + ((size_t)l * NMEMROWS + b * 256 + mg * 8) * 2048 + 1024 + h * 256 + dd;
                u32x4 o;
                o.x = (unsigned)src[0 * 2048] | ((unsigned)src[1 * 2048] << 16); o.y = (unsigned)src[2 * 2048] | ((unsigned)src[3 * 2048] << 16);
                o.z = (unsigned)src[4 * 2048] | ((unsigned)src[5 * 2048] << 16); o.w = (unsigned)src[6 * 2048] | ((unsigned)src[7 * 2048] << 16);
                bf16_t* dst = (bf16_t*)(ws + WS_KM + (size_t)l * KM_LAYER + VT_OFF) + ((size_t)(b * 4 + h) * 256 + dd) * 256 + mg * 8;
                *(u32x4*)dst = o;
            }
        } else {
            const int l = (ph - 4) / 9, k = (ph - 4) % 9;
            const unsigned char* wb = ws + WS_WB + (size_t)l * WB_LAYER;
            const float* xcur = (l == 0) ? x_in : X;
            float* ssl = SS + (size_t)(3 * l) * T;
            if (k == 0) {
                gj = pg8::Gemm{Xb, (const bf16_t*)(wb + WB_IN), T, ZW, 1024}; E = pg8::EpiDyn{0, true, ZU, ZW, ssl, nullptr, nullptr, nullptr, 0}; is_gemm = true;
            } else if (k == 1) {
#if SKIP_HGRN
                for (int it = gtid; it < T * 64; it += NGT) { const int t = it >> 6, c8 = it & 63; *(u32x4*)(YM + (size_t)t * 1024 + 512 + c8 * 8) = (u32x4){0u, 0u, 0u, 0u}; }
#else
                for (int u = bid; u < 128; u += G) hgrn_unit(lds, ZU, YM, P.in[6], P.in[7] + l * 512, l, u, tid);
#endif
                int tid2 = tid; asm volatile("" : "+v"(tid2));
                if (!SKIP_ATTN) attn_loop(lds, ZU, OP, LSE, P.in[4] + l * 64, P.in[5] + l * 64, (unsigned*)(ws + WS_CTL) + 64 * (1 + l), tid2);
            } else if (k == 2) {
                for (int it = gtid; it < T * 64; it += NGT) {
                    const int t = it >> 6, c8 = it & 63, h = c8 >> 3;
                    if (SKIP_ATTN) { *(u32x4*)(YM + (size_t)t * 1024 + c8 * 8) = (u32x4){0u, 0u, 0u, 0u}; continue; }
                    const float l0 = LSE[((size_t)0 * T + t) * 8 + h], l1 = LSE[((size_t)1 * T + t) * 8 + h], l2 = LSE[((size_t)2 * T + t) * 8 + h];
                    const float mx = fmaxf(l0, fmaxf(l1, l2));
                    float w0 = __expf(l0 - mx), w1 = __expf(l1 - mx), w2 = __expf(l2 - mx);
                    const float inv = 1.0f / (w0 + w1 + w2); w0 *= inv; w1 *= inv; w2 *= inv;
                    float a[8], bq[8], cq[8];
                    unpack8(*(const u32x4*)(OP + ((size_t)0 * T + t) * 512 + c8 * 8), a);
                    unpack8(*(const u32x4*)(OP + ((size_t)1 * T + t) * 512 + c8 * 8), bq);
                    unpack8(*(const u32x4*)(OP + ((size_t)2 * T + t) * 512 + c8 * 8), cq);
#pragma unroll
                    for (int e = 0; e < 8; ++e) a[e] = w0 * a[e] + w1 * bq[e] + w2 * cq[e];
                    *(u32x4*)(YM + (size_t)t * 1024 + c8 * 8) = pack8(a);
                }
            } else if (k == 3) {
                gj = pg8::Gemm{YM, (const bf16_t*)(wb + WB_OUT), T, 1024, 1024}; E = pg8::EpiDyn{1, true, Xb, 1024, nullptr, ssl + T, nullptr, nullptr, 0}; is_gemm = true;
            } else if (k == 4) {
                gj = pg8::Gemm{Xb, (const bf16_t*)(wb + WB_MQ), T, 1024, 1024}; E = pg8::EpiDyn{0, true, QM, 1024, ssl + T, nullptr, nullptr, nullptr, 0}; is_gemm = true;
            } else if (k == 5) {
                const bf16_t* KM = (const bf16_t*)(ws + WS_KM + (size_t)l * KM_LAYER); const bf16_t* VT = (const bf16_t*)(ws + WS_KM + (size_t)l * KM_LAYER + VT_OFF);
#if SKIP_XATTN
                for (int it = gtid; it < T * 128; it += NGT) *(u32x4*)(YM + (size_t)it * 8) = (u32x4){0u, 0u, 0u, 0u};
#else
                xattn_phase(lds, QM, KM, VT, YM, P.in[13] + l * 256, bid, G, tid);
                __syncthreads();
#endif
            } else if (k == 6) {
                gj = pg8::Gemm{YM, (const bf16_t*)(wb + WB_MO), T, 1024, 1024}; E = pg8::EpiDyn{1, true, Xb, 1024, nullptr, ssl + 2 * T, nullptr, nullptr, 0}; is_gemm = true;
            } else if (k == 7) {
                gj = pg8::Gemm{Xb, (const bf16_t*)(wb + WB_FF1), T, DFF, 1024}; E = pg8::EpiDyn{2, true, ZU, DFF, ssl + 2 * T, nullptr, nullptr, nullptr, 0}; is_gemm = true;
            } else {
                gj = pg8::Gemm{ZU, (const bf16_t*)(wb + WB_FF2), T, 1024, DFF};
                E = pg8::EpiDyn{1, true, Xb, 1024, nullptr, l == 0 ? SS + (size_t)3 * T : nullptr, l == 1 ? X : nullptr, nullptr, 0}; is_gemm = true;
            }
        }
        if (is_gemm) {
            pg8::StaticOrder S; S.init(gj.M, gj.N, G, bid);
            if (E.ssin != nullptr) {
                pg8::Unit u0;
                if (S.next(0, u0)) {
                    LAS float* RS = (LAS float*)(lds + 131072);
                    for (int i = tid; i < 2048; i += 512) { const int pmx = u0.pm + 8 * (i >> 8); if (pmx < S.nM) RS[i] = 1.0f / sqrtf(E.ssin[pmx * 256 + (i & 255)] * (1.f / 1024.f) + EPS); }
                    E.rs = RS; E.pm0 = u0.pm;
                }
                __syncthreads();
            }
            pg8::gemm_phase<pg8::EpiDyn, pg8::StaticOrder, true, true>(lds, gj, S, E);
        }
        if (ph + 1 < N_PHASES) {
            asm volatile("s_waitcnt vmcnt(0) lgkmcnt(0)" ::: "memory");
            __syncthreads();
            xcd_barrier(xbar);
        }
    }
}

extern "C" void kernel_launch(void* const* d_in, const int* in_sizes, int n_in, void* d_out, int out_size, void* d_ws, size_t ws_size, hipStream_t stream) {
    static int grid = 0;
    if (grid == 0) {
        if (n_in != 19 || in_sizes[0] != T * DM || out_size != T * DM || ws_size < WS_END) {
            fprintf(stderr, "kernel_launch: unexpected shapes: n_in %d in0 %d out %d ws %zu (need %zu)\n", n_in, n_in > 0 ? in_sizes[0] : -1, out_size, ws_size, (size_t)WS_END);
            grid = -1; return;
        }
        int dev = 0, cus = 0, per_cu = 0;
        hipGetDevice(&dev);
        hipDeviceGetAttribute(&cus, hipDeviceAttributeMultiprocessorCount, dev);
        hipFuncSetAttribute((const void*)mega_fwd, hipFuncAttributeMaxDynamicSharedMemorySize, LDS_BYTES);
        hipOccupancyMaxActiveBlocksPerMultiprocessor(&per_cu, (const void*)mega_fwd, 512, LDS_BYTES);
        if (per_cu < 1) { fprintf(stderr, "kernel_launch: occupancy query returned %d\n", per_cu); per_cu = 1; }
        grid = cus * per_cu;
        (void)hipGetLastError();
    }
    if (grid < 0) return;
    hipMemsetAsync((char*)d_ws + WS_CTL, 0, CTL_BYTES, stream);
    Params p{};
    for (int i = 0; i < 19; ++i) p.in[i] = (const float*)d_in[i];
    p.out = (float*)d_out; p.ws = (unsigned char*)d_ws;
    void* args[] = {&p};
    hipError_t e = hipLaunchCooperativeKernel((const void*)mega_fwd, dim3(grid), dim3(512), args, LDS_BYTES, stream);
    if (e != hipSuccess) fprintf(stderr, "cooperative launch failed: %s (grid %d)\n", hipGetErrorString(e), grid);
}
```

```cpp
#include <hip/hip_runtime.h>
#include <hip/hip_cooperative_groups.h>
#include <cstdio>
#include <cstdint>
namespace cg = cooperative_groups;
namespace pg8 {
#define PG8_LAS __attribute__((address_space(3)))
typedef unsigned short bf16_t;
typedef short bf16x8 __attribute__((ext_vector_type(8)));
typedef float f32x4 __attribute__((ext_vector_type(4)));
typedef unsigned u32x4 __attribute__((ext_vector_type(4)));
constexpr int BM = 256, BK = 64, HALF = 128, HTB = HALF * BK * 2  , STAGE_BYTES = 8 * HTB, NXCD = 8, WGM = 8;

__host__ __device__ __forceinline__ int lds_byte(int r, int c) { const int st = (r >> 4) * 2 + (c >> 5), rr = r & 15, cc = c & 31, ob = rr * 64 + cc * 2; return st * 1024 + (ob ^ (((ob >> 9) & 1) << 5)); }
__host__ __device__ __forceinline__ void stage_rc(int b, int& R, int& C) { const int st = b / 1024, sb = b % 1024, swz = sb ^ (((sb >> 9) & 1) << 5); R = (st >> 1) * 16 + swz / 64; C = (st & 1) * 32 + (swz % 64) / 2; }
__host__ __device__ __forceinline__ int perm32(int rho) { const int n = rho >> 4, i = rho & 15; return 8 * (i >> 2) + 4 * n + (i & 3); }

struct Unit { int pm, pn; };
struct Gemm { const bf16_t* A; const bf16_t* Bt; int M, N, K; };

struct StaticOrder {
    int nM, nN, nwg, G, c;
    __host__ __device__ void init(int M, int N, int G_, int c_) { nM = M / BM; nN = N / BM; nwg = nM * nN; G = G_; c = c_; }
    __host__ __device__ bool next(int i, Unit& u) const {
        const long L = (long)i * G + c; if (L >= nwg) return false;
        int wgid = (int)L; { const int q = nwg / NXCD, r = nwg % NXCD, xcd = wgid % NXCD, off = wgid / NXCD; wgid = (xcd < r ? xcd * (q + 1) : r * (q + 1) + (xcd - r) * q) + off; }
        const int nig = WGM * nN, gid = wgid / nig, fm = gid * WGM, gsz = (nM - fm) < WGM ? (nM - fm) : WGM;
        u.pm = fm + ((wgid % nig) % gsz); u.pn = (wgid % nig) / gsz; return true;
    }
    __device__ __forceinline__ void a_ready(const Unit&) const {}
    __device__ __forceinline__ void done(const Unit&) const {}
};

typedef float f32x2 __attribute__((ext_vector_type(2)));
typedef __bf16 bf16x2_t __attribute__((ext_vector_type(2)));
__device__ __forceinline__ unsigned cvt_pk_bf16(float lo, float hi) { f32x2 v = {lo, hi}; bf16x2_t b = __builtin_convertvector(v, bf16x2_t); return __builtin_bit_cast(unsigned, b); }
typedef unsigned u32x2 __attribute__((ext_vector_type(2)));
struct EpiDyn {
    static constexpr bool AFTER_DRAIN = false;
    int mode; bool perm;
    bf16_t* O; int ldc;
    const float* ssin; float* ssn; float* outf;
    const PG8_LAS float* rs; int pm0;
    __device__ __forceinline__ void operator()(const f32x4 (&acc)[2][2][4][2], const Unit& u, int wr, int wc, int fr, int fq) const {
        const int row0 = u.pm * BM + wr * 64 + fr; const int col0 = u.pn * BM + wc * 32 + 8 * fq;
        if (mode == 1) {
            const bool nx = ssn != nullptr, fin = outf != nullptr;
#pragma unroll
            for (int ai = 0; ai < 2; ++ai)
#pragma unroll
                for (int m = 0; m < 4; ++m) { const int row = row0 + ai * HALF + m * 16; bf16_t* rowp = O + (size_t)row * ldc + col0; float ssq = 0.f;
#pragma unroll
                    for (int bj = 0; bj < 2; ++bj) { const u32x4 bw = *(const u32x4*)(rowp + bj * HALF);
                        f32x4 v0 = acc[ai][bj][m][0], v1 = acc[ai][bj][m][1];
                        v0[0] += __builtin_bit_cast(float, bw.x << 16); v0[1] += __builtin_bit_cast(float, bw.x & 0xffff0000u); v0[2] += __builtin_bit_cast(float, bw.y << 16); v0[3] += __builtin_bit_cast(float, bw.y & 0xffff0000u);
                        v1[0] += __builtin_bit_cast(float, bw.z << 16); v1[1] += __builtin_bit_cast(float, bw.z & 0xffff0000u); v1[2] += __builtin_bit_cast(float, bw.w << 16); v1[3] += __builtin_bit_cast(float, bw.w & 0xffff0000u);
                        ssq += (v0[0] * v0[0] + v0[1] * v0[1]) + (v0[2] * v0[2] + v0[3] * v0[3]) + (v1[0] * v1[0] + v1[1] * v1[1]) + (v1[2] * v1[2] + v1[3] * v1[3]);
                        if (fin) { float* op = outf + (size_t)row * ldc + col0 + bj * HALF; *(f32x4*)op = v0; *(f32x4*)(op + 4) = v1; }
                        else { u32x4 w; w.x = cvt_pk_bf16(v0[0], v0[1]); w.y = cvt_pk_bf16(v0[2], v0[3]); w.z = cvt_pk_bf16(v1[0], v1[1]); w.w = cvt_pk_bf16(v1[2], v1[3]); *(u32x4*)(rowp + bj * HALF) = w; } }
                    if (nx) { ssq += __shfl_xor(ssq, 16); ssq += __shfl_xor(ssq, 32); if (fq == 0) (void)__hip_atomic_fetch_add(ssn + row, ssq, __ATOMIC_RELAXED, __HIP_MEMORY_SCOPE_AGENT); } }
        } else {
            const bool sq = (mode == 2), scl = ssin != nullptr;
#pragma unroll
            for (int ai = 0; ai < 2; ++ai)
#pragma unroll
                for (int m = 0; m < 4; ++m) { const int row = row0 + ai * HALF + m * 16; bf16_t* rowp = O + (size_t)row * ldc + col0;
                    const float sc = rs ? rs[((u.pm - pm0) >> 3) * 256 + (row & 255)] : (scl ? 1.0f / sqrtf(ssin[row] * (1.f / 1024.f) + 1e-6f) : 1.0f);
#pragma unroll
                    for (int bj = 0; bj < 2; ++bj) { f32x4 v0 = acc[ai][bj][m][0] * sc, v1 = acc[ai][bj][m][1] * sc;
                        if (sq) {
#pragma unroll
                            for (int e = 0; e < 4; ++e) { float a = v0[e] > 0.f ? v0[e] : 0.f; v0[e] = a * a; float b = v1[e] > 0.f ? v1[e] : 0.f; v1[e] = b * b; } }
                        u32x4 w; w.x = cvt_pk_bf16(v0[0], v0[1]); w.y = cvt_pk_bf16(v0[2], v0[3]); w.z = cvt_pk_bf16(v1[0], v1[1]); w.w = cvt_pk_bf16(v1[2], v1[3]);
                        *(u32x4*)(rowp + bj * HALF) = w; } }
        }
    }
};
template <class Epi, class Sched, bool ALIGN_EPI = false, bool SP2 = false>
__device__ __forceinline__ void gemm_phase(PG8_LAS unsigned char* lds, const Gemm g, const Sched& S, const Epi& E) {
    int tid_ = threadIdx.x; asm volatile("" : "+v"(tid_)); const int tid = tid_, wid = __builtin_amdgcn_readfirstlane(tid >> 6), lane = tid & 63, wr = wid >> 2, wc = wid & 3, fr = lane & 15, fq = lane >> 4;
    const int K = g.K, nt = K / BK;
    unsigned voffA[2], voffB[2];
#pragma unroll
    for (int i = 0; i < 2; ++i) { int R, C; stage_rc(tid * 16 + i * 8192, R, C); const int Rb = E.perm ? ((R & ~31) + perm32(R & 31)) : R;
        voffA[i] = (unsigned)(R * K + C) * 2u; voffB[i] = (unsigned)(Rb * K + C) * 2u; }
    const size_t kstep = (size_t)(BK * 2);
    const size_t hstep = (size_t)HALF * K * 2;
    const size_t tstep = 2 * hstep;
    const unsigned ldsw = (unsigned)wid * 1024u;
    const int aoff = lds_byte(wr * 64 + fr, fq * 8), boff = lds_byte(wc * 32 + fr, fq * 8);
#define PG8_SA(b, h) (((b) * 2 + (h)) * HTB)
#define PG8_SB(b, h) ((4 + (b) * 2 + (h)) * HTB)
#define PG8_STAGE(bufoff, gbase, voff) do { _Pragma("unroll") for (int _i = 0; _i < 2; ++_i) \
        __builtin_amdgcn_global_load_lds((const unsigned*)((const char*)(gbase) + (voff)[_i]), (PG8_LAS unsigned*)(lds + (bufoff) + ldsw + _i * 8192), 16, 0, 0); } while (0)
#define PG8_LDA(dst, b, h) do { _Pragma("unroll") for (int m = 0; m < 4; ++m) _Pragma("unroll") for (int k = 0; k < 2; ++k) dst[m][k] = *(const PG8_LAS bf16x8*)(lds + PG8_SA(b, h) + aoff + m * 2048 + k * 1024); } while (0)
#define PG8_LDB(dst, b, h) do { _Pragma("unroll") for (int n = 0; n < 2; ++n) _Pragma("unroll") for (int k = 0; k < 2; ++k) dst[n][k] = *(const PG8_LAS bf16x8*)(lds + PG8_SB(b, h) + boff + n * 2048 + k * 1024); } while (0)
#define PG8_MMA(ai, bj, At, Bt) do { __builtin_amdgcn_s_setprio(1); _Pragma("unroll") for (int m = 0; m < 4; ++m) _Pragma("unroll") for (int n = 0; n < 2; ++n) _Pragma("unroll") for (int k = 0; k < 2; ++k) \
        acc[ai][bj][m][n] = __builtin_amdgcn_mfma_f32_16x16x32_bf16(Bt[n][k], At[m][k], acc[ai][bj][m][n], 0, 0, 0); __builtin_amdgcn_s_setprio(0); } while (0)
#define PG8_WAIT_V(n) asm volatile("s_waitcnt vmcnt(" #n ")" ::: "memory")
#define PG8_WAIT_L(n) asm volatile("s_waitcnt lgkmcnt(" #n ")" ::: "memory")
#define PG8_BAR __builtin_amdgcn_s_barrier()
#define PG8_SCHED __builtin_amdgcn_sched_barrier(0)
    Unit cur, nxt; int ui = 0;
    if (!S.next(0, cur)) return;
    f32x4 acc[2][2][4][2];
#pragma unroll
    for (int a = 0; a < 2; ++a)
#pragma unroll
        for (int b = 0; b < 2; ++b)
#pragma unroll
            for (int m = 0; m < 4; ++m)
#pragma unroll
                for (int n = 0; n < 2; ++n) acc[a][b][m][n] = (f32x4){0.f, 0.f, 0.f, 0.f};
    bf16x8 At[4][2], B0[2][2], B1[2][2];
    const char* cA = (const char*)g.A + (size_t)cur.pm * tstep; const char* cB = (const char*)g.Bt + (size_t)cur.pn * tstep;
    S.a_ready(cur);
    if constexpr (SP2) {
        PG8_STAGE(PG8_SB(0, 0), cB, voffB); PG8_STAGE(PG8_SB(0, 1), cB + hstep, voffB); PG8_STAGE(PG8_SA(0, 0), cA, voffA); PG8_STAGE(PG8_SA(0, 1), cA + hstep, voffA);
        if (wr == 1) PG8_BAR;
        PG8_WAIT_V(2); PG8_BAR;
        PG8_STAGE(PG8_SB(1, 0), cB + kstep, voffB); PG8_STAGE(PG8_SA(1, 0), cA + kstep, voffA); PG8_STAGE(PG8_SB(1, 1), cB + hstep + kstep, voffB);
        PG8_WAIT_V(6); PG8_BAR;
    } else {
        PG8_STAGE(PG8_SB(0, 0), cB, voffB); PG8_STAGE(PG8_SA(0, 0), cA, voffA); PG8_STAGE(PG8_SB(0, 1), cB + hstep, voffB); PG8_STAGE(PG8_SA(0, 1), cA + hstep, voffA);
        if (wr == 1) PG8_BAR;
        PG8_WAIT_V(4); PG8_BAR;
        PG8_STAGE(PG8_SB(1, 0), cB + kstep, voffB); PG8_STAGE(PG8_SA(1, 0), cA + kstep, voffA); PG8_STAGE(PG8_SB(1, 1), cB + hstep + kstep, voffB);
        PG8_WAIT_V(6); PG8_BAR;
    }
    for (;;) {
        const bool has_next = S.next(ui + 1, nxt);
        const char* nA = has_next ? (const char*)g.A + (size_t)nxt.pm * tstep : cA; const char* nB = has_next ? (const char*)g.Bt + (size_t)nxt.pn * tstep : cB;
        for (int t = 0; t < nt; t += 2) {
            const bool last = (t == nt - 2);
            const char* a1 = cA + (size_t)(t + 1) * kstep;
            const char* a2 = last ? nA : cA + (size_t)(t + 2) * kstep; const char* b2 = last ? nB : cB + (size_t)(t + 2) * kstep;
            const char* a3 = a2 + kstep; const char* b3 = b2 + kstep;
            if (last && has_next) S.a_ready(nxt);
            if constexpr (SP2) {
            PG8_LDB(B0, 0, 0); PG8_LDB(B1, 0, 1); PG8_SCHED; PG8_LDA(At, 0, 0); PG8_STAGE(PG8_SA(1, 1), a1 + hstep, voffA);
            PG8_WAIT_V(8); PG8_WAIT_L(0); PG8_BAR; PG8_MMA(0, 0, At, B0); PG8_MMA(0, 1, At, B1); PG8_BAR; PG8_SCHED;
            PG8_LDA(At, 0, 1); PG8_STAGE(PG8_SB(0, 0), b2, voffB); PG8_STAGE(PG8_SB(0, 1), b2 + hstep, voffB); PG8_STAGE(PG8_SA(0, 0), a2, voffA);
            PG8_WAIT_V(8); PG8_WAIT_L(0); PG8_BAR; PG8_MMA(1, 0, At, B0); PG8_MMA(1, 1, At, B1); PG8_BAR; PG8_SCHED;
            PG8_LDB(B0, 1, 0); PG8_LDB(B1, 1, 1); PG8_SCHED; PG8_LDA(At, 1, 0); PG8_STAGE(PG8_SA(0, 1), a2 + hstep, voffA);
            PG8_WAIT_V(8); PG8_WAIT_L(0); PG8_BAR; PG8_MMA(0, 0, At, B0); PG8_MMA(0, 1, At, B1); PG8_BAR; PG8_SCHED;
            PG8_LDA(At, 1, 1); PG8_STAGE(PG8_SB(1, 0), b3, voffB); PG8_STAGE(PG8_SB(1, 1), b3 + hstep, voffB); PG8_STAGE(PG8_SA(1, 0), a3, voffA);
            PG8_WAIT_V(8); PG8_WAIT_L(0); PG8_BAR; PG8_MMA(1, 0, At, B0); PG8_MMA(1, 1, At, B1); PG8_BAR; PG8_SCHED;
            } else {
            PG8_LDB(B0, 0, 0); PG8_SCHED; PG8_LDA(At, 0, 0); PG8_STAGE(PG8_SA(1, 1), a1 + hstep, voffA);
            PG8_WAIT_L(8); PG8_BAR; PG8_WAIT_L(0); PG8_MMA(0, 0, At, B0); PG8_BAR; PG8_SCHED;
            PG8_LDB(B1, 0, 1); PG8_STAGE(PG8_SB(0, 0), b2, voffB);
            PG8_BAR; PG8_WAIT_L(0); PG8_MMA(0, 1, At, B1); PG8_BAR;
            PG8_LDA(At, 0, 1); PG8_STAGE(PG8_SA(0, 0), a2, voffA);
            PG8_BAR; PG8_WAIT_L(0); PG8_MMA(1, 0, At, B0); PG8_BAR; PG8_SCHED;
            PG8_STAGE(PG8_SB(0, 1), b2 + hstep, voffB);
            PG8_WAIT_V(6); PG8_BAR; PG8_MMA(1, 1, At, B1); PG8_BAR;
            PG8_LDB(B0, 1, 0); PG8_SCHED; PG8_LDA(At, 1, 0); PG8_STAGE(PG8_SA(0, 1), a2 + hstep, voffA);
            PG8_WAIT_L(8); PG8_BAR; PG8_WAIT_L(0); PG8_MMA(0, 0, At, B0); PG8_BAR; PG8_SCHED;
            PG8_LDB(B1, 1, 1); PG8_STAGE(PG8_SB(1, 0), b3, voffB);
            PG8_BAR; PG8_WAIT_L(0); PG8_MMA(0, 1, At, B1); PG8_BAR;
            PG8_LDA(At, 1, 1); PG8_STAGE(PG8_SA(1, 0), a3, voffA);
            PG8_BAR; PG8_WAIT_L(0); PG8_MMA(1, 0, At, B0); PG8_BAR; PG8_SCHED;
            PG8_STAGE(PG8_SB(1, 1), b3 + hstep, voffB);
            PG8_WAIT_V(6); PG8_BAR; PG8_MMA(1, 1, At, B1); PG8_BAR;
            }
        }
        if constexpr (ALIGN_EPI) { if (wr == 0) PG8_BAR; }
        if constexpr (!Epi::AFTER_DRAIN) { E(acc, cur, wr, wc, fr, fq); S.done(cur); }
        if (!has_next) break;
#pragma unroll
        for (int a = 0; a < 2; ++a)
#pragma unroll
            for (int b = 0; b < 2; ++b)
#pragma unroll
                for (int m = 0; m < 4; ++m)
#pragma unroll
                    for (int n = 0; n < 2; ++n) acc[a][b][m][n] = (f32x4){0.f, 0.f, 0.f, 0.f};
        cur = nxt; cA = nA; cB = nB; ++ui;
        if constexpr (ALIGN_EPI) { if (wr == 1) PG8_BAR; }
    }
    PG8_WAIT_V(0);
    if constexpr (!ALIGN_EPI) { if (wr == 0) PG8_BAR; }
    PG8_BAR;
    if constexpr (Epi::AFTER_DRAIN) { E.fused(acc, cur, wr, wc, fr, fq, lds, wid, lane); S.done(cur); }
#undef PG8_SA
#undef PG8_SB
#undef PG8_STAGE
#undef PG8_LDA
#undef PG8_LDB
#undef PG8_MMA
#undef PG8_WAIT_V
#undef PG8_WAIT_L
#undef PG8_BAR
#undef PG8_SCHED
}
}

#define LAS __attribute__((address_space(3)))
typedef unsigned short bf16_t;
typedef short bf16x8 __attribute__((ext_vector_type(8)));
typedef float f32x4 __attribute__((ext_vector_type(4)));
typedef unsigned u32x4 __attribute__((ext_vector_type(4)));
typedef unsigned u32x2 __attribute__((ext_vector_type(2)));

constexpr int T = 65536, DM = 1024, SEQ = 2048, NBATCH = 32, ZW = 3584, DFF = 4096, NMEMROWS = 8192;
constexpr float EPS = 1e-6f, LOG2E = 1.4426950408889634f, LN2 = 0.6931471805599453f;
constexpr size_t MiB = 1u << 20;
constexpr size_t WS_CTL = 0, CTL_BYTES = 2 * MiB;
constexpr size_t WS_SS = 256 * 1024;
constexpr int CW_BAR = 2048;
constexpr size_t WS_WB = 2 * MiB, WB_LAYER = 36 * MiB;
constexpr size_t WB_IN = 0, WB_OUT = 7 * MiB, WB_MQ = 9 * MiB, WB_MKV = 11 * MiB, WB_MO = 15 * MiB, WB_FF1 = 17 * MiB, WB_FF2 = 25 * MiB;
constexpr size_t WS_KM = 74 * MiB, KM_LAYER = 32 * MiB, VT_OFF = 16 * MiB;
constexpr size_t WS_YM = 138 * MiB, WS_ZU = 266 * MiB, WS_H = 778 * MiB;
constexpr size_t WS_MN = WS_ZU, WS_KVT = WS_ZU + 32 * MiB;
constexpr size_t WS_QM = WS_ZU;
constexpr size_t WS_END = WS_H + 128 * MiB;
constexpr size_t OUT_OP = 0, OUT_LSE = 192 * MiB;
constexpr int LDS_BYTES = 147456;
constexpr int N_ATT_UNITS = NBATCH * 8 * 48;

#ifndef SKIP_HGRN
#define SKIP_HGRN 0
#endif
#ifndef SKIP_ATTN
#define SKIP_ATTN 0
#endif
#ifndef SKIP_XATTN
#define SKIP_XATTN 0
#endif
struct Params { const float* in[19]; float* out; unsigned char* ws; };

__device__ __forceinline__ unsigned f2bf(float f) { unsigned u = __builtin_bit_cast(unsigned, f); return (u + 0x7fffu + ((u >> 16) & 1u)) >> 16; }
__device__ __forceinline__ unsigned pk2(float lo, float hi) { return pg8::cvt_pk_bf16(lo, hi); }
__device__ __forceinline__ float bflo(unsigned w) { return __builtin_bit_cast(float, w << 16); }
__device__ __forceinline__ float bfhi(unsigned w) { return __builtin_bit_cast(float, w & 0xffff0000u); }
__device__ __forceinline__ void unpack8(const u32x4 w, float (&f)[8]) {
    f[0] = bflo(w.x); f[1] = bfhi(w.x); f[2] = bflo(w.y); f[3] = bfhi(w.y); f[4] = bflo(w.z); f[5] = bfhi(w.z); f[6] = bflo(w.w); f[7] = bfhi(w.w);
}
__device__ __forceinline__ u32x4 pack8(const float (&f)[8]) { u32x4 w; w.x = pk2(f[0], f[1]); w.y = pk2(f[2], f[3]); w.z = pk2(f[4], f[5]); w.w = pk2(f[6], f[7]); return w; }
__device__ __forceinline__ float wave_sum(float v) {
#pragma unroll
    for (int o = 1; o < 64; o <<= 1) v += __shfl_xor(v, o);
    return v;
}
#define DPPF(v, ctrl) __builtin_bit_cast(float, __builtin_amdgcn_mov_dpp(__builtin_bit_cast(int, (v)), (ctrl), 0xF, 0xF, true))
__device__ __forceinline__ float sum8_dpp(float v) { v += DPPF(v, 0xB1); v += DPPF(v, 0x4E); v += DPPF(v, 0x141); return v; }
__device__ __forceinline__ float sum16_dpp(float v) { v = sum8_dpp(v); v += DPPF(v, 0x128); return v; }
#define MFMA16(a, b, c) __builtin_amdgcn_mfma_f32_16x16x32_bf16((a), (b), (c), 0, 0, 0)
#define LDS_WAIT() asm volatile("s_waitcnt lgkmcnt(0)" ::: "memory")
#define LDS_BARRIER() do { asm volatile("s_waitcnt lgkmcnt(0)" ::: "memory"); __builtin_amdgcn_s_barrier(); asm volatile("" ::: "memory"); } while (0)

__device__ __forceinline__ void transpose_item(const float* W, int K, int N, bf16_t* WT, LAS float* scr, int item, int lane, const float* g = nullptr) {
    const int nblk = N / 32, kb = item / nblk, nb = item % nblk, k0 = 64 * kb, n0 = 32 * nb;
#pragma unroll 8
    for (int i = 0; i < 32; ++i) { const int kk = 2 * i + (lane >> 5); scr[kk * 33 + (lane & 31)] = W[(size_t)(k0 + kk) * N + n0 + (lane & 31)] * (g ? g[k0 + kk] : 1.0f); }
    LDS_WAIT();
    const int c = lane & 7;
#pragma unroll
    for (int j = 0; j < 4; ++j) { const int n = (lane >> 3) + 8 * j; const LAS float* s = scr + (8 * c) * 33 + n;
        u32x4 o; o.x = pk2(s[0 * 33], s[1 * 33]); o.y = pk2(s[2 * 33], s[3 * 33]); o.z = pk2(s[4 * 33], s[5 * 33]); o.w = pk2(s[6 * 33], s[7 * 33]);
        *(u32x4*)(WT + (size_t)(n0 + n) * K + k0 + 8 * c) = o; }
    LDS_WAIT();
}
__device__ __forceinline__ void rms_row_1024(const float* xrow, const float* g, bf16_t* orow, int lane) {
    const f32x4* xr = (const f32x4*)xrow + lane; const f32x4* gr = (const f32x4*)g + lane;
    f32x4 v[4]; float s = 0.f;
#pragma unroll
    for (int j = 0; j < 4; ++j) { v[j] = xr[64 * j]; s += (v[j].x * v[j].x + v[j].y * v[j].y) + (v[j].z * v[j].z + v[j].w * v[j].w); }
    const float rstd = 1.0f / sqrtf(wave_sum(s) * (1.f / 1024.f) + EPS);
    u32x2* o8 = (u32x2*)orow + lane;
#pragma unroll
    for (int j = 0; j < 4; ++j) { const f32x4 gv = gr[64 * j]; u32x2 w; w.x = pk2(v[j].x * rstd * gv.x, v[j].y * rstd * gv.y); w.y = pk2(v[j].z * rstd * gv.z, v[j].w * rstd * gv.w); o8[64 * j] = w; }
}

__device__ __forceinline__ void prep_row_1024(const float* xrow, bf16_t* orow, float* ssp, int lane) {
    const f32x4* xr = (const f32x4*)xrow + lane;
    float s = 0.f; u32x2* o8 = (u32x2*)orow + lane;
#pragma unroll
    for (int j = 0; j < 4; ++j) { const f32x4 v = xr[64 * j]; s += (v.x * v.x + v.y * v.y) + (v.z * v.z + v.w * v.w);
        u32x2 w; w.x = pk2(v.x, v.y); w.y = pk2(v.z, v.w); o8[64 * j] = w; }
    s = wave_sum(s);
    if (lane == 0) *ssp = s;
}

struct AttnU { int b, h, p, d, r, n; };
__device__ __forceinline__ AttnU attn_decode(int u) {
    AttnU U; const int bh = u / 48, s48 = u % 48, idx = s48 & 15; U.b = bh >> 3; U.h = bh & 7; U.p = s48 >> 4;
    if (U.p == 0) { U.d = 1; U.r = 0; U.n = idx; } else if (U.p == 1) { U.d = 4; U.r = idx & 3; U.n = idx >> 2; } else { U.d = 16; U.r = idx; U.n = 0; }
    return U;
}
struct AttnRegs { u32x4 kw[4], vw[4], q0, q1; };
__device__ __forceinline__ void attn_load(AttnRegs& R, const bf16_t* Z, const AttnU& U, int tid) {
    const int wave = tid >> 6, lane = tid & 63, fr = lane & 15, fq = lane >> 4;
    const size_t rowbase = (size_t)U.b * SEQ;
#pragma unroll
    for (int it = 0; it < 4; ++it) {
        const int c = tid + 512 * it, row = c >> 3, ch = c & 7, lk = 128 * (U.n - 1) + row;
        R.kw[it] = (u32x4){0u, 0u, 0u, 0u}; R.vw[it] = (u32x4){0u, 0u, 0u, 0u};
        if (lk >= 0) { const bf16_t* zr = Z + (rowbase + (size_t)(lk * U.d + U.r)) * ZW + U.h * 64 + ch * 8; R.kw[it] = *(const u32x4*)(zr + 512); R.vw[it] = *(const u32x4*)(zr + 1024); }
    }
    const int qi = 16 * wave + fr, posq = (128 * U.n + qi) * U.d + U.r;
    const bf16_t* zq = Z + (rowbase + (size_t)posq) * ZW + U.h * 64;
    R.q0 = *(const u32x4*)(zq + fq * 8); R.q1 = *(const u32x4*)(zq + 32 + fq * 8);
}
__device__ __forceinline__ void attn_stage(LAS unsigned char* lds, const AttnRegs& R, const float* gq, const float* gk, int tid, bf16x8& Q0, bf16x8& Q1) {
    const int lane = tid & 63, fq = lane >> 4;
    LAS bf16_t* Ks = (LAS bf16_t*)lds; LAS bf16_t* Vt = (LAS bf16_t*)(lds + 36864);
#pragma unroll
    for (int it = 0; it < 4; ++it) {
        const int c = tid + 512 * it, row = c >> 3, ch = c & 7;
        const u32x4 vw = R.vw[it];
        float kf[8]; unpack8(R.kw[it], kf);
        float ss = 0.f;
#pragma unroll
        for (int e = 0; e < 8; ++e) ss += kf[e] * kf[e];
        ss = sum8_dpp(ss);
        const float rstd = __builtin_amdgcn_rsqf(ss * (1.f / 64.f) + EPS);
        const f32x4 g0 = *(const f32x4*)(gk + ch * 8), g1 = *(const f32x4*)(gk + ch * 8 + 4);
        kf[0] *= rstd * g0.x; kf[1] *= rstd * g0.y; kf[2] *= rstd * g0.z; kf[3] *= rstd * g0.w; kf[4] *= rstd * g1.x; kf[5] *= rstd * g1.y; kf[6] *= rstd * g1.z; kf[7] *= rstd * g1.w;
        *(LAS u32x4*)(Ks + row * 72 + ch * 8) = pack8(kf);
        LAS bf16_t* vt = Vt + (ch * 8) * 264 + 8 * ch + row;
        vt[0 * 264] = (bf16_t)(vw.x & 0xffffu); vt[1 * 264] = (bf16_t)(vw.x >> 16); vt[2 * 264] = (bf16_t)(vw.y & 0xffffu); vt[3 * 264] = (bf16_t)(vw.y >> 16);
        vt[4 * 264] = (bf16_t)(vw.z & 0xffffu); vt[5 * 264] = (bf16_t)(vw.z >> 16); vt[6 * 264] = (bf16_t)(vw.w & 0xffffu); vt[7 * 264] = (bf16_t)(vw.w >> 16);
    }
    float a[8], c[8]; unpack8(R.q0, a); unpack8(R.q1, c);
    float ss = 0.f;
#pragma unroll
    for (int e = 0; e < 8; ++e) ss += a[e] * a[e] + c[e] * c[e];
    ss += __shfl_xor(ss, 16); ss += __shfl_xor(ss, 32);
    const float sc = __builtin_amdgcn_rsqf(ss * (1.f / 64.f) + EPS) * (0.125f * LOG2E);
#pragma unroll
    for (int e = 0; e < 8; ++e) { a[e] *= sc * gq[fq * 8 + e]; c[e] *= sc * gq[32 + fq * 8 + e]; }
    Q0 = __builtin_bit_cast(bf16x8, pack8(a)); Q1 = __builtin_bit_cast(bf16x8, pack8(c));
}
__device__ __forceinline__ void attn_compute(LAS unsigned char* lds, const AttnU& U, const bf16x8 Q0, const bf16x8 Q1, bf16_t* OP, float* LSE, int tid) {
    const int wave = __builtin_amdgcn_readfirstlane(tid >> 6), lane = tid & 63, fr = lane & 15, fq = lane >> 4;
    const int b = U.b, h = U.h, p = U.p, d = U.d, r = U.r, n = U.n;
    LAS bf16_t* Ks = (LAS bf16_t*)lds;
    LAS bf16_t* Vt = (LAS bf16_t*)(lds + 36864);
    LAS bf16_t* Ps = (LAS bf16_t*)(lds + 70784) + wave * (16 * 168);
    const size_t rowbase = (size_t)b * SEQ;
    const int qi = 16 * wave + fr, posq = (128 * n + qi) * d + r;
    const int start = wave < 6 ? 16 * wave : 96, i0 = 16 * wave;
    const float slope2 = exp2f(-(float)(h + 1)) * (float)d * LOG2E;
    const float fbase = (float)(qi + 128 - start - 4 * fq);
    f32x4 S[10]; bool dead[10];
    float m = -1e30f;
#pragma unroll
    for (int t = 0; t < 10; ++t) {
        const int k0 = start + 16 * t;
        dead[t] = (k0 > i0 + 143) || (k0 + 15 < i0) || (n == 0 && k0 + 15 < 128);
        const bool full = (k0 >= i0 + 15) && (k0 + 15 <= i0 + 128) && (n > 0 || k0 >= 128);
        if (dead[t]) { S[t] = (f32x4){-1e30f, -1e30f, -1e30f, -1e30f}; }
        else {
            const LAS bf16_t* kp = Ks + (k0 + fr) * 72 + fq * 8;
            const bf16x8 a0 = *(const LAS bf16x8*)kp, a1 = *(const LAS bf16x8*)(kp + 32);
            f32x4 acc = (f32x4){0.f, 0.f, 0.f, 0.f};
            acc = MFMA16(a0, Q0, acc); acc = MFMA16(a1, Q1, acc);
            if (full) {
#pragma unroll
                for (int j = 0; j < 4; ++j) { const float v = acc[j] - slope2 * (fbase - (float)(16 * t + j)); acc[j] = v; m = fmaxf(m, v); }
            } else {
#pragma unroll
                for (int j = 0; j < 4; ++j) {
                    const int kj = k0 + 4 * fq + j, step = qi + 128 - kj, lk = 128 * (n - 1) + kj;
                    const bool valid = (step >= 0) && (step <= 128) && (lk >= 0);
                    const float v = valid ? acc[j] - slope2 * (float)step : -1e30f;
                    acc[j] = v; m = fmaxf(m, v);
                }
            }
            S[t] = acc;
        }
    }
    m = fmaxf(m, __shfl_xor(m, 16)); m = fmaxf(m, __shfl_xor(m, 32));
    float sum = 0.f;
    u32x2 pw[10];
#pragma unroll
    for (int t = 0; t < 10; ++t) {
        u32x2 w = (u32x2){0u, 0u};
        if (!dead[t]) {
            float pe[4];
#pragma unroll
            for (int j = 0; j < 4; ++j) { pe[j] = __builtin_amdgcn_exp2f(S[t][j] - m); sum += pe[j]; }
            w.x = pk2(pe[0], pe[1]); w.y = pk2(pe[2], pe[3]);
        }
        pw[t] = w;
    }
    sum += __shfl_xor(sum, 16); sum += __shfl_xor(sum, 32);
    f32x4 O[4];
#pragma unroll
    for (int dt = 0; dt < 4; ++dt) O[dt] = (f32x4){0.f, 0.f, 0.f, 0.f};
#pragma unroll
    for (int kc = 0; kc < 5; ++kc) {
        if (dead[2 * kc] && dead[2 * kc + 1]) continue;
        const u32x4 pq = (u32x4){pw[2 * kc].x, pw[2 * kc].y, pw[2 * kc + 1].x, pw[2 * kc + 1].y};
        const bf16x8 pb = __builtin_bit_cast(bf16x8, pq);
#pragma unroll
        for (int dt = 0; dt < 4; ++dt) {
            const LAS bf16_t* vp = Vt + fr * 264 + 8 * (fr >> 3) + start + 4 * fq + dt * (16 * 264 + 16) + 32 * kc;
            const u32x2 lo = *(const LAS u32x2*)vp, hi = *(const LAS u32x2*)(vp + 16);
            const u32x4 vw = (u32x4){lo.x, lo.y, hi.x, hi.y};
            O[dt] = MFMA16(__builtin_bit_cast(bf16x8, vw), pb, O[dt]);
        }
    }
    const float inv = __builtin_amdgcn_rcpf(sum);
    const size_t trow = rowbase + (size_t)posq;
    bf16_t* op = OP + ((size_t)p * T + trow) * 512 + h * 64 + 4 * fq;
#pragma unroll
    for (int dt = 0; dt < 4; ++dt) { u32x2 w; w.x = pk2(O[dt][0] * inv, O[dt][1] * inv); w.y = pk2(O[dt][2] * inv, O[dt][3] * inv); *(u32x2*)(op + 16 * dt) = w; }
    if (fq == 0) LSE[((size_t)p * T + trow) * 8 + h] = (m + __builtin_amdgcn_logf(sum)) * LN2;
}
constexpr int ATT_IMG = 70784;
__device__ __forceinline__ void attn_loop(LAS unsigned char* lds, const bf16_t* Z, bf16_t* OP, float* LSE, const float* gq, const float* gk, unsigned* ctr, int tid) {
    LAS int* sh = (LAS int*)(lds + LDS_BYTES - 64);
    __syncthreads();
    if (tid == 0) {
        const int a0 = (int)__hip_atomic_fetch_add(ctr, 1u, __ATOMIC_RELAXED, __HIP_MEMORY_SCOPE_AGENT), a1 = (int)__hip_atomic_fetch_add(ctr, 1u, __ATOMIC_RELAXED, __HIP_MEMORY_SCOPE_AGENT), a2 = (int)__hip_atomic_fetch_add(ctr, 1u, __ATOMIC_RELAXED, __HIP_MEMORY_SCOPE_AGENT);
        sh[0] = a0; sh[1] = a1; sh[2] = a2;
    }
    __syncthreads();
    int u0 = __builtin_amdgcn_readfirstlane(sh[0]), u1 = __builtin_amdgcn_readfirstlane(sh[1]), u2 = __builtin_amdgcn_readfirstlane(sh[2]);
    __syncthreads();
    if (u0 >= N_ATT_UNITS) return;
    AttnRegs R;
    bf16x8 Qc0, Qc1;
    { const AttnU U = attn_decode(u0); attn_load(R, Z, U, tid); attn_stage(lds, R, gq, gk, tid, Qc0, Qc1); }
    if (u1 < N_ATT_UNITS) { const AttnU U = attn_decode(u1); attn_load(R, Z, U, tid); }
    LDS_BARRIER();
    int bsel = 0;
    while (u0 < N_ATT_UNITS) {
        int nn = 0;
        if (tid == 0) nn = (int)__hip_atomic_fetch_add(ctr, 1u, __ATOMIC_RELAXED, __HIP_MEMORY_SCOPE_AGENT);
        { const AttnU U = attn_decode(u0); attn_compute(lds + bsel * ATT_IMG, U, Qc0, Qc1, OP, LSE, tid); }
        bf16x8 Qn0 = Qc0, Qn1 = Qc1;
        if (u1 < N_ATT_UNITS) attn_stage(lds + (bsel ^ 1) * ATT_IMG, R, gq, gk, tid, Qn0, Qn1);
        if (u2 < N_ATT_UNITS) { const AttnU U = attn_decode(u2); attn_load(R, Z, U, tid); }
        if (tid == 0) sh[4 + bsel] = nn;
        LDS_BARRIER();
        u0 = u1; u1 = u2; u2 = __builtin_amdgcn_readfirstlane(sh[4 + bsel]); Qc0 = Qn0; Qc1 = Qn1; bsel ^= 1;
    }
}

__device__ __forceinline__ void hgrn_unit(LAS unsigned char* lds, const bf16_t* Z, bf16_t* YM, const float* hg_lb, const float* gon, int layer, int u, int tid) {
    const int wave = __builtin_amdgcn_readfirstlane(tid >> 6), lane = tid & 63, fr = lane & 15, fq = lane >> 4;
    const int b = u >> 2, hh = u & 3, tt = tid >> 4, kg = (tid & 15) * 8;
    LAS float*  LG  = (LAS float*)lds;
    LAS bf16_t* QdS = (LAS bf16_t*)(lds + 16384);
    LAS bf16_t* KdS = (LAS bf16_t*)(lds + 25088);
    LAS bf16_t* QeS = (LAS bf16_t*)(lds + 33792);
    LAS bf16_t* KlT = (LAS bf16_t*)(lds + 42496);
    LAS bf16_t* iT  = (LAS bf16_t*)(lds + 52736);
    LAS bf16_t* ScS = (LAS bf16_t*)(lds + 62976);
    LAS bf16_t* StS = (LAS bf16_t*)(lds + 65536);
    LAS float*  DEC = (LAS float*)(lds + 100352);
    LAS float*  OS  = (LAS float*)(lds + 100864);
    LAS float*  LBS = (LAS float*)(lds + 117760);
    LAS float*  GOS = (LAS float*)(lds + 118272);
    if (tid < 128) { const int c = hh * 128 + tid; LBS[tid] = layer == 0 ? 0.f : 1.0f / (1.0f + __expf(hg_lb[c] - hg_lb[512 + c])); GOS[tid] = gon[c]; }
    for (int i = tid; i < 34816 / 4; i += 512) ((LAS unsigned*)(lds + 65536))[i] = 0u;
    f32x4 St[8];
#pragma unroll
    for (int kt = 0; kt < 8; ++kt) St[kt] = (f32x4){0.f, 0.f, 0.f, 0.f};
    __syncthreads();
    const bf16_t* zb = Z + ((size_t)b * SEQ) * ZW + hh * 128 + kg;
    u32x4 nq, nf, ni, ng;
    { const bf16_t* zr = zb + (size_t)tt * ZW; nq = *(const u32x4*)(zr + 1536); nf = *(const u32x4*)(zr + 2048); ni = *(const u32x4*)(zr + 2560); ng = *(const u32x4*)(zr + 3072); }
    for (int c = 0; c < 64; ++c) {
        const u32x4 cq = nq, cf = nf, ci = ni, cgt = ng;
        if (c + 1 < 64) { const bf16_t* zr = zb + (size_t)((c + 1) * 32 + tt) * ZW; nq = *(const u32x4*)(zr + 1536); nf = *(const u32x4*)(zr + 2048); ni = *(const u32x4*)(zr + 2560); ng = *(const u32x4*)(zr + 3072); }
        float qs[8], kk[8], bc[8];
        { float qv[8], fv[8]; unpack8(cq, qv); unpack8(cf, fv);
          const f32x4 lb0 = *(const LAS f32x4*)(LBS + kg), lb1 = *(const LAS f32x4*)(LBS + kg + 4);
          const float lbv[8] = {lb0.x, lb0.y, lb0.z, lb0.w, lb1.x, lb1.y, lb1.z, lb1.w};
#pragma unroll
          for (int e = 0; e < 8; ++e) {
              qs[e] = qv[e] * __builtin_amdgcn_rcpf(1.0f + __expf(-qv[e]));
              const float ef = __expf(-fv[e]), sg = __builtin_amdgcn_rcpf(1.0f + ef);
              const float f = lbv[e] + (1.0f - lbv[e]) * sg;
              float v = __logf(fmaxf(f, 1e-12f));
              kk[e] = (1.0f - lbv[e]) * ef * sg;
              const float x1 = __shfl_up(v, 16); if (fq >= 1) v += x1;
              const float x2 = __shfl_up(v, 32); if (fq >= 2) v += x2;
              bc[e] = v;
          } }
        if (fq == 3) { *(LAS f32x4*)(LG + wave * 128 + kg) = (f32x4){bc[0], bc[1], bc[2], bc[3]}; *(LAS f32x4*)(LG + wave * 128 + kg + 4) = (f32x4){bc[4], bc[5], bc[6], bc[7]}; }
        LDS_BARRIER();
        float bl[8], br[8];
#pragma unroll
        for (int e = 0; e < 8; ++e) { bl[e] = 0.f; br[e] = 0.f; }
#pragma unroll 1
        for (int w2 = 0; w2 < 8; ++w2) {
            const f32x4 v0 = *(const LAS f32x4*)(LG + w2 * 128 + kg), v1 = *(const LAS f32x4*)(LG + w2 * 128 + kg + 4);
            const float vv[8] = {v0.x, v0.y, v0.z, v0.w, v1.x, v1.y, v1.z, v1.w};
            const float inc = w2 < wave ? 1.f : 0.f;
#pragma unroll
            for (int e = 0; e < 8; ++e) { bl[e] += vv[e]; bc[e] += inc * vv[e]; }
            if (w2 == 3) {
#pragma unroll
                for (int e = 0; e < 8; ++e) br[e] = bl[e];
            }
        }
        {
            float qd[8], kd[8], qe[8], kl[8];
#pragma unroll
            for (int e = 0; e < 8; ++e) { qd[e] = qs[e] * __expf(bc[e] - br[e]); kd[e] = kk[e] * __expf(br[e] - bc[e]); qe[e] = qs[e] * __expf(bc[e]); kl[e] = kk[e] * __expf(bl[e] - bc[e]); }
            *(LAS u32x4*)(QdS + tt * 136 + kg) = pack8(qd);
            *(LAS u32x4*)(KdS + tt * 136 + kg) = pack8(kd);
            *(LAS u32x4*)(QeS + tt * 136 + kg) = pack8(qe);
            const u32x4 klw = pack8(kl);
            const int tsw = (((tt >> 3) ^ ((kg >> 3) & 3)) << 3) | (tt & 7);
            LAS bf16_t* kp = KlT + kg * 40 + tsw; LAS bf16_t* ip = iT + kg * 40 + tsw;
            kp[0 * 40] = (bf16_t)(klw.x & 0xffffu); kp[1 * 40] = (bf16_t)(klw.x >> 16); kp[2 * 40] = (bf16_t)(klw.y & 0xffffu); kp[3 * 40] = (bf16_t)(klw.y >> 16);
            kp[4 * 40] = (bf16_t)(klw.z & 0xffffu); kp[5 * 40] = (bf16_t)(klw.z >> 16); kp[6 * 40] = (bf16_t)(klw.w & 0xffffu); kp[7 * 40] = (bf16_t)(klw.w >> 16);
            ip[0 * 40] = (bf16_t)(ci.x & 0xffffu); ip[1 * 40] = (bf16_t)(ci.x >> 16); ip[2 * 40] = (bf16_t)(ci.y & 0xffffu); ip[3 * 40] = (bf16_t)(ci.y >> 16);
            ip[4 * 40] = (bf16_t)(ci.z & 0xffffu); ip[5 * 40] = (bf16_t)(ci.z >> 16); ip[6 * 40] = (bf16_t)(ci.w & 0xffffu); ip[7 * 40] = (bf16_t)(ci.w >> 16);
            if (tt == 0) { *(LAS f32x4*)(DEC + kg) = (f32x4){__expf(bl[0]), __expf(bl[1]), __expf(bl[2]), __expf(bl[3])}; *(LAS f32x4*)(DEC + kg + 4) = (f32x4){__expf(bl[4]), __expf(bl[5]), __expf(bl[6]), __expf(bl[7])}; }
        }
        LDS_BARRIER();
        if (wave < 4) {
            const int tr = wave >> 1, sc = wave & 1;
            f32x4 acc = (f32x4){0.f, 0.f, 0.f, 0.f};
#pragma unroll
            for (int ks = 0; ks < 4; ++ks) { const bf16x8 a = *(const LAS bf16x8*)(QdS + (16 * tr + fr) * 136 + 32 * ks + fq * 8), bb = *(const LAS bf16x8*)(KdS + (16 * sc + fr) * 136 + 32 * ks + fq * 8); acc = MFMA16(a, bb, acc); }
#pragma unroll
            for (int j = 0; j < 4; ++j) { const int t = 16 * tr + 4 * fq + j, s = 16 * sc + fr; ScS[t * 40 + s] = (bf16_t)f2bf(s <= t ? acc[j] : 0.f); }
        }
        f32x4 o0 = (f32x4){0.f, 0.f, 0.f, 0.f}, o1 = (f32x4){0.f, 0.f, 0.f, 0.f};
#pragma unroll
        for (int ks = 0; ks < 4; ++ks) {
            const bf16x8 bb = *(const LAS bf16x8*)(StS + (16 * wave + fr) * 136 + 32 * ks + fq * 8);
            const bf16x8 a0 = *(const LAS bf16x8*)(QeS + fr * 136 + 32 * ks + fq * 8), a1 = *(const LAS bf16x8*)(QeS + (16 + fr) * 136 + 32 * ks + fq * 8);
            o0 = MFMA16(a0, bb, o0); o1 = MFMA16(a1, bb, o1);
        }
        LDS_BARRIER();
        {
            const bf16x8 bb = *(const LAS bf16x8*)(iT + (16 * wave + fr) * 40 + ((fq ^ (((16 * wave + fr) >> 3) & 3)) << 3));
            const bf16x8 a0 = *(const LAS bf16x8*)(ScS + fr * 40 + fq * 8), a1 = *(const LAS bf16x8*)(ScS + (16 + fr) * 40 + fq * 8);
            o0 = MFMA16(a0, bb, o0); o1 = MFMA16(a1, bb, o1);
#pragma unroll
            for (int j = 0; j < 4; ++j) { OS[(4 * fq + j) * 132 + 16 * wave + fr] = o0[j]; OS[(16 + 4 * fq + j) * 132 + 16 * wave + fr] = o1[j]; }
#pragma unroll
            for (int kt = 0; kt < 8; ++kt) {
                const bf16x8 a = *(const LAS bf16x8*)(KlT + (16 * kt + fr) * 40 + ((fq ^ (((16 * kt + fr) >> 3) & 3)) << 3));
                const f32x4 dec = *(const LAS f32x4*)(DEC + 16 * kt + 4 * fq);
                f32x4 sv = St[kt] * dec; sv = MFMA16(a, bb, sv); St[kt] = sv;
                u32x2 w; w.x = pk2(sv[0], sv[1]); w.y = pk2(sv[2], sv[3]);
                *(LAS u32x2*)(StS + (16 * wave + fr) * 136 + 16 * kt + 4 * fq) = w;
            }
        }
        LDS_BARRIER();
        {
            const f32x4 x0 = *(const LAS f32x4*)(OS + tt * 132 + kg), x1 = *(const LAS f32x4*)(OS + tt * 132 + kg + 4);
            float ov[8] = {x0.x, x0.y, x0.z, x0.w, x1.x, x1.y, x1.z, x1.w};
            float ss = 0.f;
#pragma unroll
            for (int e = 0; e < 8; ++e) ss += ov[e] * ov[e];
            ss = sum16_dpp(ss);
            const float rstd = __builtin_amdgcn_rsqf(ss * (1.f / 128.f) + EPS);
            float gv[8]; unpack8(cgt, gv);
            const f32x4 go0 = *(const LAS f32x4*)(GOS + kg), go1 = *(const LAS f32x4*)(GOS + kg + 4);
            const float gov[8] = {go0.x, go0.y, go0.z, go0.w, go1.x, go1.y, go1.z, go1.w};
#pragma unroll
            for (int e = 0; e < 8; ++e) ov[e] = ov[e] * rstd * gov[e] * (gv[e] * __builtin_amdgcn_rcpf(1.0f + __expf(-gv[e])));
            *(u32x4*)(YM + ((size_t)b * SEQ + c * 32 + tt) * 1024 + 512 + hh * 128 + kg) = pack8(ov);
        }
    }
    __syncthreads();
}

__device__ __forceinline__ void xattn_ld(u32x4 (&pre)[8], const bf16_t* src, int tid) {
#pragma unroll
    for (int it = 0; it < 8; ++it) { const int c = tid + 512 * it, row = c >> 5, ch = c & 31; pre[it] = *(const u32x4*)(src + row * 256 + ch * 8); }
}
__device__ __forceinline__ void xattn_st(LAS bf16_t* dst, const u32x4 (&pre)[8], int tid) {
    int t_ = tid; asm volatile("" : "+v"(t_));
    LAS bf16_t* p = dst + (t_ >> 5) * 264 + (t_ & 31) * 8;
#pragma unroll
    for (int it = 0; it < 8; ++it) *(LAS u32x4*)(p + it * (16 * 264)) = pre[it];
}
__device__ __forceinline__ void xattn_q_frags(bf16x8 (&Q)[8], const bf16_t* qp, const float* gmq, int fq) {
    u32x4 qw[8]; float ss = 0.f;
#pragma unroll
    for (int ks = 0; ks < 8; ++ks) { qw[ks] = *(const u32x4*)(qp + 32 * ks); float f[8]; unpack8(qw[ks], f);
#pragma unroll
        for (int e = 0; e < 8; ++e) ss += f[e] * f[e]; }
    ss += __shfl_xor(ss, 16); ss += __shfl_xor(ss, 32);
    const float sc = __builtin_amdgcn_rsqf(ss * (1.f / 256.f) + EPS) * (0.0625f * LOG2E);
#pragma unroll
    for (int ks = 0; ks < 8; ++ks) { float f[8]; unpack8(qw[ks], f); const f32x4 g0 = *(const f32x4*)(gmq + 32 * ks + fq * 8), g1 = *(const f32x4*)(gmq + 32 * ks + fq * 8 + 4);
        f[0] *= sc * g0.x; f[1] *= sc * g0.y; f[2] *= sc * g0.z; f[3] *= sc * g0.w; f[4] *= sc * g1.x; f[5] *= sc * g1.y; f[6] *= sc * g1.z; f[7] *= sc * g1.w;
        Q[ks] = __builtin_bit_cast(bf16x8, pack8(f)); }
}
template <bool FIRST>
__device__ __forceinline__ void xattn_sp_stage(bf16x8 (&P0)[4], bf16x8 (&P1)[4], float& sum0, float& sum1, float& m0, float& m1, const LAS bf16_t* SB, const bf16x8 (&Q0)[8], const bf16x8 (&Q1)[8], int fr, int fq) {
#pragma unroll
    for (int kc = 0; kc < 4; ++kc) {
        f32x4 a00 = (f32x4){0.f, 0.f, 0.f, 0.f}, a01 = a00, a10 = a00, a11 = a00;
#pragma unroll
        for (int ks = 0; ks < 8; ++ks) {
            const bf16x8 ka = *(const LAS bf16x8*)(SB + (32 * kc + fr) * 264 + 32 * ks + fq * 8), kb = *(const LAS bf16x8*)(SB + (32 * kc + 16 + fr) * 264 + 32 * ks + fq * 8);
            a00 = MFMA16(ka, Q0[ks], a00); a10 = MFMA16(ka, Q1[ks], a10); a01 = MFMA16(kb, Q0[ks], a01); a11 = MFMA16(kb, Q1[ks], a11);
        }
        if (FIRST && kc == 0) {
            float x0 = fmaxf(fmaxf(a00[0], a00[1]), fmaxf(a00[2], a00[3])), x1 = fmaxf(fmaxf(a10[0], a10[1]), fmaxf(a10[2], a10[3]));
            x0 = fmaxf(x0, __shfl_xor(x0, 16)); x0 = fmaxf(x0, __shfl_xor(x0, 32)); x1 = fmaxf(x1, __shfl_xor(x1, 16)); x1 = fmaxf(x1, __shfl_xor(x1, 32));
            m0 = x0; m1 = x1;
        }
        float pe[8], pf[8];
#pragma unroll
        for (int j = 0; j < 4; ++j) { pe[j] = __builtin_amdgcn_exp2f(a00[j] - m0); pe[4 + j] = __builtin_amdgcn_exp2f(a01[j] - m0); pf[j] = __builtin_amdgcn_exp2f(a10[j] - m1); pf[4 + j] = __builtin_amdgcn_exp2f(a11[j] - m1); }
#pragma unroll
        for (int e = 0; e < 8; ++e) { sum0 += pe[e]; sum1 += pf[e]; }
        P0[kc] = __builtin_bit_cast(bf16x8, pack8(pe)); P1[kc] = __builtin_bit_cast(bf16x8, pack8(pf));
        asm volatile("" ::: "memory");
    }
}
__device__ __forceinline__ void xattn_pv_stage(const LAS bf16_t* SB, const bf16x8 (&P0a)[4], const bf16x8 (&P0b)[4], const bf16x8 (&P1a)[4], const bf16x8 (&P1b)[4], float inv0, float inv1, bf16_t* o0, bf16_t* o1, int fr, int fq) {
    f32x4 O0[8], O1[8];
#pragma unroll
    for (int dt = 0; dt < 8; ++dt) { O0[dt] = (f32x4){0.f, 0.f, 0.f, 0.f}; O1[dt] = (f32x4){0.f, 0.f, 0.f, 0.f}; }
#pragma unroll
    for (int kc = 0; kc < 8; ++kc) {
        const bf16x8 p0 = kc < 4 ? P0a[kc & 3] : P0b[kc & 3], p1 = kc < 4 ? P1a[kc & 3] : P1b[kc & 3];
#pragma unroll
        for (int dt = 0; dt < 8; ++dt) {
            const LAS bf16_t* vp = SB + (16 * dt + fr) * 264 + 32 * kc + 4 * fq;
            const u32x2 lo = *(const LAS u32x2*)vp, hi = *(const LAS u32x2*)(vp + 16);
            const u32x4 w = (u32x4){lo.x, lo.y, hi.x, hi.y};
            const bf16x8 va = __builtin_bit_cast(bf16x8, w);
            O0[dt] = MFMA16(va, p0, O0[dt]); O1[dt] = MFMA16(va, p1, O1[dt]);
            if (dt == 7) asm volatile("" ::: "memory");
        }
    }
#pragma unroll
    for (int dt = 0; dt < 8; ++dt) {
        u32x2 w; w.x = pk2(O0[dt][0] * inv0, O0[dt][1] * inv0); w.y = pk2(O0[dt][2] * inv0, O0[dt][3] * inv0); *(u32x2*)(o0 + 16 * dt) = w;
        u32x2 v; v.x = pk2(O1[dt][0] * inv1, O1[dt][1] * inv1); v.y = pk2(O1[dt][2] * inv1, O1[dt][3] * inv1); *(u32x2*)(o1 + 16 * dt) = v;
    }
}
__device__ __forceinline__ void xattn_phase(LAS unsigned char* lds, const bf16_t* QM, const bf16_t* KM, const bf16_t* VT, bf16_t* OM, const float* gmq, int bid, int G, int tid0) {
    const int wave = __builtin_amdgcn_readfirstlane(tid0 >> 6);
    LAS bf16_t* SB0 = (LAS bf16_t*)lds; LAS bf16_t* SB1 = (LAS bf16_t*)(lds + 67584);
    if (bid >= 1024) return;
    u32x4 pre[8];
    { const int u0 = bid; xattn_ld(pre, KM + (size_t)((u0 >> 5) * 4 + ((u0 >> 3) & 3)) * 65536, tid0); }
    for (int u = bid; u < 1024; u += G) {
        int tid_ = tid0; asm volatile("" : "+v"(tid_));
        const int tid = tid_, lane = tid & 63, fr = lane & 15, fq = lane >> 4;
        const int b = u >> 5, h = (u >> 3) & 3, qb = u & 7;
        const bf16_t* KMp = KM + (size_t)(b * 4 + h) * 65536; const bf16_t* VTp = VT + (size_t)(b * 4 + h) * 65536;
        const size_t trow = (size_t)b * SEQ + qb * 256 + 32 * wave + fr;
        xattn_st(SB0, pre, tid);
        bf16x8 Q0[8], Q1[8];
        xattn_q_frags(Q0, QM + trow * 1024 + h * 256 + fq * 8, gmq, fq);
        asm volatile("" ::: "memory");
        xattn_q_frags(Q1, QM + (trow + 16) * 1024 + h * 256 + fq * 8, gmq, fq);
        bf16x8 P0a[4], P0b[4], P1a[4], P1b[4];
        float m0, m1, sum0, sum1;
        LDS_BARRIER();
        m0 = 0.f; m1 = 0.f; sum0 = 0.f; sum1 = 0.f;
        xattn_sp_stage<true>(P0a, P1a, sum0, sum1, m0, m1, SB0, Q0, Q1, fr, fq);
        { u32x4 t1[8]; xattn_ld(t1, KMp + 128 * 256, tid); xattn_st(SB1, t1, tid); } LDS_BARRIER();
        xattn_sp_stage<false>(P0b, P1b, sum0, sum1, m0, m1, SB1, Q0, Q1, fr, fq);
        sum0 += __shfl_xor(sum0, 16); sum0 += __shfl_xor(sum0, 32); sum1 += __shfl_xor(sum1, 16); sum1 += __shfl_xor(sum1, 32);
        const float inv0 = __builtin_amdgcn_rcpf(sum0), inv1 = __builtin_amdgcn_rcpf(sum1);
        bf16_t* o0 = OM + trow * 1024 + h * 256 + 4 * fq; bf16_t* o1 = o0 + 16 * 1024;
        { u32x4 t2[8]; xattn_ld(t2, VTp, tid); xattn_st(SB0, t2, tid); } xattn_ld(pre, VTp + 128 * 256, tid); LDS_BARRIER();
        xattn_pv_stage(SB0, P0a, P0b, P1a, P1b, inv0, inv1, o0, o1, fr, fq);
        xattn_st(SB1, pre, tid);
        { const int un = u + G; if (un < 1024) xattn_ld(pre, KM + (size_t)((un >> 5) * 4 + ((un >> 3) & 3)) * 65536, tid); }
        LDS_BARRIER();
        xattn_pv_stage(SB1, P0a, P0b, P1a, P1b, inv0, inv1, o0 + 128, o1 + 128, fr, fq);
    }
}

#define XB_TMO      128
#define XB_XCNT(j)  (256  + 64 * (j))
#define XB_XSUB(j)  (1280 + 64 * (j))
#define XB_XGEN(j)  (2304 + 64 * (j))
#define XB_TOP      3328
#define XB_TOPGEN   3392
#define XCD_BAR_WORDS 3456
#define XB_SPIN_CAP (1u << 18)

__device__ __forceinline__ unsigned xb_ld(unsigned* p)              { return __hip_atomic_load(p, __ATOMIC_RELAXED, __HIP_MEMORY_SCOPE_AGENT); }
__device__ __forceinline__ unsigned xb_add(unsigned* p, unsigned v) { return __hip_atomic_fetch_add(p, v, __ATOMIC_RELAXED, __HIP_MEMORY_SCOPE_AGENT); }
__device__ __forceinline__ unsigned xb_xcc_id() { return (unsigned)__builtin_amdgcn_s_getreg((3 << 11) | 20) & 0xFu; }
#define XB_SPIN(cond, bar) do { unsigned _sp = 0; while (cond) { __builtin_amdgcn_s_sleep(1); \
    if ((++_sp & 255u) == 0u) { if (xb_ld(&(bar)[XB_TMO])) break; if (_sp > XB_SPIN_CAP) { atomicAdd(&(bar)[XB_TMO], 1u); break; } } } } while (0)

struct XcdBarrier {
    unsigned* bar; unsigned x;
    volatile LAS unsigned* st;
};

__device__ __forceinline__ XcdBarrier xcd_barrier_post(unsigned* bar, volatile LAS unsigned* st) {
    XcdBarrier b; b.bar = bar; b.x = xb_xcc_id(); b.st = st;
    if (threadIdx.x == 0) st[2] = xb_add(&bar[XB_XCNT(b.x)], 1u);
    return b;
}
__device__ __forceinline__ void xcd_barrier_complete(unsigned* bar, unsigned x, unsigned& nloc, unsigned& nx) {
    const unsigned G = gridDim.x * gridDim.y * gridDim.z;
    unsigned sum, cnt, mine, sp = 0u;
    for (;;) {
        sum = 0u; cnt = 0u; mine = 0u;
#pragma unroll
        for (unsigned j = 0; j < 16; ++j) { const unsigned c = xb_ld(&bar[XB_XCNT(j)]); sum += c; cnt += (c > 0u) ? 1u : 0u; mine = (j == x) ? c : mine; }
        if (sum == G) break;
        __builtin_amdgcn_s_sleep(1);
        if ((++sp & 255u) == 0u) { if (xb_ld(&bar[XB_TMO])) break; if (sp > XB_SPIN_CAP) { atomicAdd(&bar[XB_TMO], 1u); break; } }
    }
    nloc = mine > 0u ? mine : 1u; nx = cnt > 0u ? cnt : 1u;
}

__device__ __forceinline__ void xcd_barrier(const XcdBarrier& b) {
    asm volatile("s_waitcnt vmcnt(0)" ::: "memory");
    __syncthreads();
    if (threadIdx.x == 0) {
        unsigned* bar = b.bar;
        __builtin_amdgcn_s_waitcnt(0);
        unsigned nloc = b.st[0], nx = b.st[1];
        if (nloc == 0u) { xcd_barrier_complete(bar, b.x, nloc, nx); b.st[0] = nloc; b.st[1] = nx; }
        const unsigned old = xb_add(&bar[XB_XSUB(b.x)], 1u);
        const unsigned gen = old / nloc;
        if (old + 1u == (gen + 1u) * nloc) {
            __builtin_amdgcn_fence(__ATOMIC_RELEASE, "agent");
            asm volatile("s_waitcnt vmcnt(0)" ::: "memory");
            const unsigned og = xb_add(&bar[XB_TOP], 1u);
            const unsigned tg = og / nx;
            if (og + 1u == (tg + 1u) * nx) xb_add(&bar[XB_TOPGEN], 1u);
            else XB_SPIN(xb_ld(&bar[XB_TOPGEN]) == tg, bar);
            __builtin_amdgcn_fence(__ATOMIC_ACQUIRE, "agent");
            xb_add(&bar[XB_XGEN(b.x)], 1u);
            asm volatile("s_waitcnt vmcnt(0)" ::: "memory");
        } else {
            XB_SPIN(xb_ld(&bar[XB_XGEN(b.x)]) == gen, bar);
            __builtin_amdgcn_fence(__ATOMIC_ACQUIRE, "agent");
            asm volatile("s_waitcnt vmcnt(0)" ::: "memory");
        }
    }
    __syncthreads();
}

constexpr int N_PHASES = 4 + 18;
__global__ void __launch_bounds__(512, 2) mega_fwd(Params P) {
    extern __shared__ __attribute__((aligned(16))) unsigned char smem[];
    LAS unsigned char* lds = (LAS unsigned char*)smem;
    cg::grid_group grid = cg::this_grid();
    if (threadIdx.x < 8) ((LAS unsigned*)(lds + LDS_BYTES - 32))[threadIdx.x] = 0u;
    __syncthreads();
    const XcdBarrier xbar = xcd_barrier_post((unsigned*)(P.ws + WS_CTL) + CW_BAR, (volatile LAS unsigned*)(lds + LDS_BYTES - 32));
    grid.sync();
    for (int ph = 0; ph < N_PHASES; ++ph) {
        int tid_ = threadIdx.x, bid_ = blockIdx.x; asm volatile("" : "+v"(tid_)); asm volatile("" : "+s"(bid_));
        const int tid = tid_, bid = bid_, lane = tid & 63, wave = __builtin_amdgcn_readfirstlane(tid >> 6);
        const int G = gridDim.x, gw = bid * 8 + wave, NGW = G * 8;
        const int gtid = bid * 512 + tid, NGT = G * 512;
        unsigned char* ws = P.ws;
        if (ph == 1) {
            if (tid == 0) {
                unsigned* barw = (unsigned*)(ws + WS_CTL) + CW_BAR; unsigned ok = 1u;
                for (unsigned j = 0; j < 16; ++j) { const unsigned cj = xb_ld(&barw[XB_XCNT(j)]); if (cj != (j < 8u ? (unsigned)G / 8u : 0u)) ok = 0u; }
                xbar.st[3] = ok;
            }
            __syncthreads();
        }
        bf16_t* Xb = (bf16_t*)(ws + WS_H); bf16_t* ZU = (bf16_t*)(ws + WS_ZU); bf16_t* YM = (bf16_t*)(ws + WS_YM); bf16_t* QM = (bf16_t*)(ws + WS_QM);
        bf16_t* OP = (bf16_t*)((unsigned char*)P.out + OUT_OP); float* LSE = (float*)((unsigned char*)P.out + OUT_LSE);
        bf16_t* MN = (bf16_t*)(ws + WS_MN); bf16_t* KVT = (bf16_t*)(ws + WS_KVT);
        const float* x_in = P.in[0]; float* X = P.out;
        bool is_gemm = false;
        pg8::Gemm gj{nullptr, nullptr, 0, 0, 0};
        pg8::EpiDyn E{0, true, nullptr, 0, nullptr, nullptr, nullptr};
        float* SS = (float*)(ws + WS_SS);
        if (ph == 0) {
            LAS float* scr = (LAS float*)(lds + wave * 16384);
            constexpr int NI_IN = 16 * 112, NI_SQ = 16 * 32, NI_MKV = 16 * 64, NI_FF1 = 16 * 128, NI_FF2 = 64 * 32;
            constexpr int NI_LAYER = NI_IN + 3 * NI_SQ + NI_MKV + NI_FF1 + NI_FF2;
            for (int it = gw; it < 2 * NI_LAYER; it += NGW) {
                const int l = it / NI_LAYER; int r = it % NI_LAYER;
                unsigned char* wb = ws + WS_WB + (size_t)l * WB_LAYER;
                if (r < NI_IN) { transpose_item(P.in[3] + (size_t)l * 1024 * 3584, 1024, 3584, (bf16_t*)(wb + WB_IN), scr, r, lane, P.in[2] + l * 1024); continue; } r -= NI_IN;
                if (r < NI_SQ) { transpose_item(P.in[8] + (size_t)l * 1024 * 1024, 1024, 1024, (bf16_t*)(wb + WB_OUT), scr, r, lane); continue; } r -= NI_SQ;
                if (r < NI_SQ) { transpose_item(P.in[11] + (size_t)l * 1024 * 1024, 1024, 1024, (bf16_t*)(wb + WB_MQ), scr, r, lane, P.in[9] + l * 1024); continue; } r -= NI_SQ;
                if (r < NI_MKV) { transpose_item(P.in[12] + (size_t)l * 1024 * 2048, 1024, 2048, (bf16_t*)(wb + WB_MKV), scr, r, lane); continue; } r -= NI_MKV;
                if (r < NI_SQ) { transpose_item(P.in[15] + (size_t)l * 1024 * 1024, 1024, 1024, (bf16_t*)(wb + WB_MO), scr, r, lane); continue; } r -= NI_SQ;
                if (r < NI_FF1) { transpose_item(P.in[17] + (size_t)l * 1024 * 4096, 1024, 4096, (bf16_t*)(wb + WB_FF1), scr, r, lane, P.in[16] + l * 1024); continue; } r -= NI_FF1;
                transpose_item(P.in[18] + (size_t)l * 4096 * 1024, 4096, 1024, (bf16_t*)(wb + WB_FF2), scr, r, lane);
            }
            for (int it = gw; it < 2 * NMEMROWS; it += NGW) { const int l = it / NMEMROWS, row = it % NMEMROWS; rms_row_1024(P.in[1] + (size_t)row * 1024, P.in[10] + l * 1024, MN + ((size_t)l * NMEMROWS + row) * 1024, lane); }
            for (int row = gw; row < T; row += NGW) prep_row_1024(x_in + (size_t)row * 1024, Xb + (size_t)row * 1024, SS + row, lane);
        } else if (ph <= 2) {
            const int l = ph - 1;
            gj = pg8::Gemm{MN + (size_t)l * NMEMROWS * 1024, (const bf16_t*)(ws + WS_WB + (size_t)l * WB_LAYER + WB_MKV), NMEMROWS, 2048, 1024};
            E = pg8::EpiDyn{0, true, KVT + (size_t)l * NMEMROWS * 2048, 2048, nullptr, nullptr, nullptr, nullptr, 0};
            is_gemm = true;
        } else if (ph == 3) {
            for (int it = gw; it < 2 * NMEMROWS * 4; it += NGW) {
                const int l = it / (NMEMROWS * 4), rem = it % (NMEMROWS * 4), row = rem >> 2, h = rem & 3;
                const bf16_t* src = KVT + ((size_t)l * NMEMROWS + row) * 2048 + h * 256 + lane * 4;
                const u32x2 w = *(const u32x2*)src;
                float f0 = bflo(w.x), f1 = bfhi(w.x), f2 = bflo(w.y), f3 = bfhi(w.y);
                const float rstd = 1.0f / sqrtf(wave_sum(f0 * f0 + f1 * f1 + f2 * f2 + f3 * f3) * (1.f / 256.f) + EPS);
                const f32x4 gv = *(const f32x4*)(P.in[14] + l * 256 + lane * 4);
                u32x2 o; o.x = pk2(f0 * rstd * gv.x, f1 * rstd * gv.y); o.y = pk2(f2 * rstd * gv.z, f3 * rstd * gv.w);
                bf16_t* dst = (bf16_t*)(ws + WS_KM + (size_t)l * KM_LAYER) + ((size_t)((row >> 8) * 4 + h) * 256 + (row & 255)) * 256 + lane * 4;
                *(u32x2*)dst = o;
            }
            for (int it = gtid; it < 2 * 32 * 4 * 32 * 256; it += NGT) {
                const int dd = it & 255, mg = (it >> 8) & 31, h = (it >> 13) & 3, b = (it >> 15) & 31, l = it >> 20;
                const bf16_t* src = KVT + ((size_t)l * NMEMROWS + b * 256 + mg * 8) * 2048 + 1024 + h * 256 + dd;
                u32x4 o;
                o.x = (unsigned)src[0 * 2048] | ((unsigned)src[1 * 2048] << 16); o.y = (unsigned)src[2 * 2048] | ((unsigned)src[3 * 2048] << 16);
                o.z = (unsigned)src[4 * 2048] | ((unsigned)src[5 * 2048] << 16); o.w = (unsigned)src[6 * 2048] | ((unsigned)src[7 * 2048] << 16);
                bf16_t* dst = (bf16_t*)(ws + WS_KM + (size_t)l * KM_LAYER + VT_OFF) + ((size_t)(b * 4 + h) * 256 + dd) * 256 + mg * 8;
                *(u32x4*)dst = o;
            }
        } else {
            const int l = (ph - 4) / 9, k = (ph - 4) % 9;
            const unsigned char* wb = ws + WS_WB + (size_t)l * WB_LAYER;
            const float* xcur = (l == 0) ? x_in : X;
            float* ssl = SS + (size_t)(3 * l) * T;
            if (k == 0) {
                gj = pg8::Gemm{Xb, (const bf16_t*)(wb + WB_IN), T, ZW, 1024}; E = pg8::EpiDyn{0, true, ZU, ZW, ssl, nullptr, nullptr, nullptr, 0}; is_gemm = true;
            } else if (k == 1) {
#if SKIP_HGRN
                for (int it = gtid; it < T * 64; it += NGT) { const int t = it >> 6, c8 = it & 63; *(u32x4*)(YM + (size_t)t * 1024 + 512 + c8 * 8) = (u32x4){0u, 0u, 0u, 0u}; }
#else
                for (int u = bid; u < 128; u += G) hgrn_unit(lds, ZU, YM, P.in[6], P.in[7] + l * 512, l, u, tid);
#endif
                int tid2 = tid; asm volatile("" : "+v"(tid2));
                if (!SKIP_ATTN) attn_loop(lds, ZU, OP, LSE, P.in[4] + l * 64, P.in[5] + l * 64, (unsigned*)(ws + WS_CTL) + 64 * (1 + l), tid2);
            } else if (k == 2) {
                for (int it = gtid; it < T * 64; it += NGT) {
                    const int t = it >> 6, c8 = it & 63, h = c8 >> 3;
                    if (SKIP_ATTN) { *(u32x4*)(YM + (size_t)t * 1024 + c8 * 8) = (u32x4){0u, 0u, 0u, 0u}; continue; }
                    const float l0 = LSE[((size_t)0 * T + t) * 8 + h], l1 = LSE[((size_t)1 * T + t) * 8 + h], l2 = LSE[((size_t)2 * T + t) * 8 + h];
                    const float mx = fmaxf(l0, fmaxf(l1, l2));
                    float w0 = __expf(l0 - mx), w1 = __expf(l1 - mx), w2 = __expf(l2 - mx);
                    const float inv = 1.0f / (w0 + w1 + w2); w0 *= inv; w1 *= inv; w2 *= inv;
                    float a[8], bq[8], cq[8];
                    unpack8(*(const u32x4*)(OP + ((size_t)0 * T + t) * 512 + c8 * 8), a);
                    unpack8(*(const u32x4*)(OP + ((size_t)1 * T + t) * 512 + c8 * 8), bq);
                    unpack8(*(const u32x4*)(OP + ((size_t)2 * T + t) * 512 + c8 * 8), cq);
#pragma unroll
                    for (int e = 0; e < 8; ++e) a[e] = w0 * a[e] + w1 * bq[e] + w2 * cq[e];
                    *(u32x4*)(YM + (size_t)t * 1024 + c8 * 8) = pack8(a);
                }
            } else if (k == 3) {
                gj = pg8::Gemm{YM, (const bf16_t*)(wb + WB_OUT), T, 1024, 1024}; E = pg8::EpiDyn{1, true, Xb, 1024, nullptr, ssl + T, nullptr, nullptr, 0}; is_gemm = true;
            } else if (k == 4) {
                gj = pg8::Gemm{Xb, (const bf16_t*)(wb + WB_MQ), T, 1024, 1024}; E = pg8::EpiDyn{0, true, QM, 1024, ssl + T, nullptr, nullptr, nullptr, 0}; is_gemm = true;
            } else if (k == 5) {
                const bf16_t* KM = (const bf16_t*)(ws + WS_KM + (size_t)l * KM_LAYER); const bf16_t* VT = (const bf16_t*)(ws + WS_KM + (size_t)l * KM_LAYER + VT_OFF);
#if SKIP_XATTN
                for (int it = gtid; it < T * 128; it += NGT) *(u32x4*)(YM + (size_t)it * 8) = (u32x4){0u, 0u, 0u, 0u};
#else
                xattn_phase(lds, QM, KM, VT, YM, P.in[13] + l * 256, bid, G, tid);
                __syncthreads();
#endif
            } else if (k == 6) {
                gj = pg8::Gemm{YM, (const bf16_t*)(wb + WB_MO), T, 1024, 1024}; E = pg8::EpiDyn{1, true, Xb, 1024, nullptr, ssl + 2 * T, nullptr, nullptr, 0}; is_gemm = true;
            } else if (k == 7) {
                gj = pg8::Gemm{Xb, (const bf16_t*)(wb + WB_FF1), T, DFF, 1024}; E = pg8::EpiDyn{2, true, ZU, DFF, ssl + 2 * T, nullptr, nullptr, nullptr, 0}; is_gemm = true;
            } else {
                gj = pg8::Gemm{ZU, (const bf16_t*)(wb + WB_FF2), T, 1024, DFF};
                E = pg8::EpiDyn{1, true, Xb, 1024, nullptr, l == 0 ? SS + (size_t)3 * T : nullptr, l == 1 ? X : nullptr, nullptr, 0}; is_gemm = true;
            }
        }
        if (is_gemm) {
            int bidv = bid;
            { const volatile LAS unsigned* stw = xbar.st;
              const unsigned nloc = (unsigned)__builtin_amdgcn_readfirstlane((int)stw[0]), nxc = (unsigned)__builtin_amdgcn_readfirstlane((int)stw[1]), rank = (unsigned)__builtin_amdgcn_readfirstlane((int)stw[2]);
              const unsigned uni = (unsigned)__builtin_amdgcn_readfirstlane((int)stw[3]);
              if (uni == 1u && nxc == 8u && nloc * 8u == (unsigned)G && xbar.x < 8u && rank < nloc) bidv = (int)(rank * 8u + xbar.x); }
            pg8::StaticOrder S; S.init(gj.M, gj.N, G, bidv);
            if (E.ssin != nullptr) {
                pg8::Unit u0;
                if (S.next(0, u0)) {
                    LAS float* RS = (LAS float*)(lds + 131072);
                    for (int i = tid; i < 2048; i += 512) { const int pmx = u0.pm + 8 * (i >> 8); if (pmx < S.nM) RS[i] = 1.0f / sqrtf(E.ssin[pmx * 256 + (i & 255)] * (1.f / 1024.f) + EPS); }
                    E.rs = RS; E.pm0 = u0.pm;
                }
                __syncthreads();
            }
            pg8::gemm_phase<pg8::EpiDyn, pg8::StaticOrder, true, true>(lds, gj, S, E);
        }
        if (ph + 1 < N_PHASES) {
            asm volatile("s_waitcnt vmcnt(0) lgkmcnt(0)" ::: "memory");
            __syncthreads();
            xcd_barrier(xbar);
        }
    }
}

extern "C" void kernel_launch(void* const* d_in, const int* in_sizes, int n_in, void* d_out, int out_size, void* d_ws, size_t ws_size, hipStream_t stream) {
    static int grid = 0;
    if (grid == 0) {
        if (n_in != 19 || in_sizes[0] != T * DM || out_size != T * DM || ws_size < WS_END) {
            fprintf(stderr, "kernel_launch: unexpected shapes: n_in %d in0 %d out %d ws %zu (need %zu)\n", n_in, n_in > 0 ? in_sizes[0] : -1, out_size, ws_size, (size_t)WS_END);
            grid = -1; return;
        }
        int dev = 0, cus = 0, per_cu = 0;
        hipGetDevice(&dev);
        hipDeviceGetAttribute(&cus, hipDeviceAttributeMultiprocessorCount, dev);
        hipFuncSetAttribute((const void*)mega_fwd, hipFuncAttributeMaxDynamicSharedMemorySize, LDS_BYTES);
        hipOccupancyMaxActiveBlocksPerMultiprocessor(&per_cu, (const void*)mega_fwd, 512, LDS_BYTES);
        if (per_cu < 1) { fprintf(stderr, "kernel_launch: occupancy query returned %d\n", per_cu); per_cu = 1; }
        grid = cus * per_cu;
        (void)hipGetLastError();
    }
    if (grid < 0) return;
    hipMemsetAsync((char*)d_ws + WS_CTL, 0, CTL_BYTES, stream);
    Params p{};
    for (int i = 0; i < 19; ++i) p.in[i] = (const float*)d_in[i];
    p.out = (float*)d_out; p.ws = (unsigned char*)d_ws;
    void* args[] = {&p};
    hipError_t e = hipLaunchCooperativeKernel((const void*)mega_fwd, dim3(grid), dim3(512), args, LDS_BYTES, stream);
    if (e != hipSuccess) fprintf(stderr, "cooperative launch failed: %s (grid %d)\n", hipGetErrorString(e), grid);
}
```
